# Optimizing an MI355X kernel written in HIP

```python
import jax, jax.numpy as jnp
from jax import lax
import numpy as np

D_MODEL = 4096
BATCH = 1
SEQ = 16384
DEPTH = 4

CTX_LEN = 256
GRID_W = 64
N_HEADS = 16
N_KV_HEADS = 4
HEAD_DIM = 128
GROUP = N_HEADS // N_KV_HEADS
Q_WIDTH = N_HEADS * HEAD_DIM
KV_WIDTH = N_KV_HEADS * HEAD_DIM
WINDOW = 128
BLOCK = 128
N_FGROUPS = 4
F_DIM = 512
F_WIDTH = N_FGROUPS * F_DIM
IN_WIDTH = Q_WIDTH + 2 * KV_WIDTH + F_WIDTH
MIX_WIDTH = Q_WIDTH + F_WIDTH
D_FF = 4 * D_MODEL
ADA_RANK = 512
N_MOD = 6
ROPE_THETA = 10000.0
EPS = 1e-6
NEG_INF = -1e30

kernel_name = "hymba_style_window_gqa_fnet_dit_trunk"


def rmsnorm(x, g):
    xf = x.astype(jnp.float32)
    y = xf * lax.rsqrt(jnp.mean(xf * xf, axis=-1, keepdims=True) + EPS)
    return (y * g.astype(jnp.float32)).astype(x.dtype)


def adaln(cvec, a, b, bias):
    m = (jax.nn.silu(cvec) @ a) @ b + bias
    return jnp.split(m, N_MOD, axis=-1)


def modulate(h, shift, scale):
    return h * (1.0 + scale[:, None, :]) + shift[:, None, :]


def axial_rope(x, rows, cols):
    half = HEAD_DIM // 2
    quarter = half // 2
    inv = ROPE_THETA ** (-jnp.arange(quarter, dtype=jnp.float32) / quarter)

    def rot(xs, pos):
        ang = pos.astype(jnp.float32)[:, None] * inv[None, :]
        cos = jnp.cos(ang)[None, :, None, :]
        sin = jnp.sin(ang)[None, :, None, :]
        x1 = xs[..., :quarter].astype(jnp.float32)
        x2 = xs[..., quarter:].astype(jnp.float32)
        return jnp.concatenate([x1 * cos - x2 * sin, x2 * cos + x1 * sin], axis=-1)

    out = jnp.concatenate([rot(x[..., :half], rows), rot(x[..., half:], cols)], axis=-1)
    return out.astype(x.dtype)


def latent_attention(q, k, v, k_ctx, v_ctx, sink):
    B, L = q.shape[0], q.shape[1]
    C = k_ctx.shape[1]
    nb = L // BLOCK
    scale = HEAD_DIM ** -0.5
    qb = q.reshape(B, nb, BLOCK, N_KV_HEADS, GROUP, HEAD_DIM)

    def band(t):
        tp = jnp.pad(t, ((0, 0), (BLOCK, BLOCK), (0, 0), (0, 0)))
        tp = tp.reshape(B, nb + 2, BLOCK, N_KV_HEADS, HEAD_DIM)
        return jnp.concatenate([tp[:, :-2], tp[:, 1:-1], tp[:, 2:]], axis=2)

    kw, vw = band(k), band(v)
    s_win = jnp.einsum('bnqhgd,bnkhd->bnhgqk', qb, kw).astype(jnp.float32) * scale
    s_ctx = jnp.einsum('bnqhgd,bchd->bnhgqc', qb, k_ctx).astype(jnp.float32) * scale
    q_off = jnp.arange(BLOCK)[:, None]
    k_off = jnp.arange(3 * BLOCK)[None, :] - BLOCK
    rel_ok = jnp.abs(k_off - q_off) <= WINDOW
    abs_k = jnp.arange(nb)[:, None] * BLOCK + k_off
    in_range = (abs_k >= 0) & (abs_k < L)
    mask = rel_ok[None, :, :] & in_range[:, None, :]
    s_win = jnp.where(mask[None, :, None, None, :, :], s_win, NEG_INF)
    sink_col = jnp.broadcast_to(
        sink.reshape(N_KV_HEADS, GROUP).astype(jnp.float32)[None, None, :, :, None, None],
        s_win.shape[:-1] + (1,))
    p = jax.nn.softmax(jnp.concatenate([sink_col, s_ctx, s_win], axis=-1), axis=-1)
    p_ctx = p[..., 1:1 + C].astype(v.dtype)
    p_win = p[..., 1 + C:].astype(v.dtype)
    o = (jnp.einsum('bnhgqc,bchd->bnqhgd', p_ctx, v_ctx)
         + jnp.einsum('bnhgqk,bnkhd->bnqhgd', p_win, vw))
    return o.reshape(B, L, Q_WIDTH)


def context_attention(q, k, v, sink):
    B, C = q.shape[0], q.shape[1]
    scale = HEAD_DIM ** -0.5
    qg = q.reshape(B, C, N_KV_HEADS, GROUP, HEAD_DIM)
    s = jnp.einsum('bqhgd,bkhd->bhgqk', qg, k).astype(jnp.float32) * scale
    sink_col = jnp.broadcast_to(
        sink.reshape(N_KV_HEADS, GROUP).astype(jnp.float32)[None, :, :, None, None],
        s.shape[:-1] + (1,))
    p = jax.nn.softmax(jnp.concatenate([sink_col, s], axis=-1), axis=-1)[..., 1:]
    o = jnp.einsum('bhgqk,bkhd->bqhgd', p.astype(v.dtype), v)
    return o.reshape(B, C, Q_WIDTH)


def fourier_mix(u, w_f):
    B, L = u.shape[0], u.shape[1]
    ug = u.reshape(B, L, N_FGROUPS, F_DIM).astype(jnp.float32)
    f = jnp.real(jnp.fft.fft2(ug, axes=(1, 3), norm='ortho')).astype(u.dtype)
    return jnp.einsum('blgc,gcd->blgd', f, w_f).reshape(B, L, F_WIDTH)


def merge_groups(attn_out, four_out, g_a, g_f, w_o):
    return jnp.concatenate([rmsnorm(attn_out, g_a), rmsnorm(four_out, g_f)], axis=-1) @ w_o


def sq_relu_mlp(h, w1, w2):
    return jnp.square(jax.nn.relu(h @ w1)) @ w2


def setup_inputs(seed: int = 0) -> dict:
    key = jax.random.key(seed)
    ks = jax.random.split(key, 18)

    def nrm(k, shape, s):
        return jax.random.normal(k, shape, jnp.float32) * s

    def gain(k, shape):
        return 1.0 + 0.02 * jax.random.normal(k, shape, jnp.float32)

    return {
        "x": nrm(ks[0], (BATCH, SEQ, D_MODEL), 1.0),
        "c": nrm(ks[1], (BATCH, D_MODEL), 1.0),
        "ctx": nrm(ks[2], (BATCH, CTX_LEN, D_MODEL), 1.0),
        "c_ctx": nrm(ks[3], (D_MODEL,), 1.0),
        "ada_a": nrm(ks[4], (DEPTH, D_MODEL, ADA_RANK), D_MODEL ** -0.5),
        "ada_b": nrm(ks[5], (DEPTH, ADA_RANK, N_MOD * D_MODEL), 0.2 * ADA_RANK ** -0.5),
        "ada_bias": nrm(ks[6], (DEPTH, N_MOD * D_MODEL), 0.01),
        "g_mix": gain(ks[7], (DEPTH, D_MODEL)),
        "w_in": nrm(ks[8], (DEPTH, D_MODEL, IN_WIDTH), D_MODEL ** -0.5),
        "sink": nrm(ks[9], (DEPTH, N_HEADS), 0.5),
        "w_f": nrm(ks[10], (DEPTH, N_FGROUPS, F_DIM, F_DIM), F_DIM ** -0.5),
        "g_attn_out": gain(ks[11], (DEPTH, Q_WIDTH)),
        "g_four_out": gain(ks[12], (DEPTH, F_WIDTH)),
        "w_out": nrm(ks[13], (DEPTH, MIX_WIDTH, D_MODEL), MIX_WIDTH ** -0.5),
        "g_mlp": gain(ks[14], (DEPTH, D_MODEL)),
        "w1": nrm(ks[15], (DEPTH, D_MODEL, D_FF), D_MODEL ** -0.5),
        "w2": nrm(ks[16], (DEPTH, D_FF, D_MODEL), D_FF ** -0.5),
        "g_final": gain(ks[17], (D_MODEL,)),
    }


def reference(x, c, ctx, c_ctx, ada_a, ada_b, ada_bias, g_mix, w_in, sink, w_f,
              g_attn_out, g_four_out, w_out, g_mlp, w1, w2, g_final):
    B, L = x.shape[0], x.shape[1]
    C = ctx.shape[1]
    ROWS = L // GRID_W
    rows = jnp.broadcast_to(jnp.arange(ROWS)[:, None], (ROWS, GRID_W)).reshape(L)
    cols = jnp.broadcast_to(jnp.arange(GRID_W)[None, :], (ROWS, GRID_W)).reshape(L)
    cc = c_ctx[None, :]
    k_lo, v_lo, f_lo = Q_WIDTH, Q_WIDTH + KV_WIDTH, Q_WIDTH + 2 * KV_WIDTH

    for l in range(DEPTH):
        last = l == DEPTH - 1
        w = w_in[l]
        sh_a, sc_a, ga_a, sh_m, sc_m, ga_m = adaln(c, ada_a[l], ada_b[l], ada_bias[l])
        csh_a, csc_a, cga_a, csh_m, csc_m, cga_m = adaln(cc, ada_a[l], ada_b[l], ada_bias[l])

        hc = modulate(rmsnorm(ctx, g_mix[l]), csh_a, csc_a)
        kc = (hc @ w[:, k_lo:v_lo]).reshape(B, C, N_KV_HEADS, HEAD_DIM)
        vc = (hc @ w[:, v_lo:f_lo]).reshape(B, C, N_KV_HEADS, HEAD_DIM)

        hx = modulate(rmsnorm(x, g_mix[l]), sh_a, sc_a)
        px = hx @ w
        qx = axial_rope(px[..., :k_lo].reshape(B, L, N_HEADS, HEAD_DIM), rows, cols)
        kx = axial_rope(px[..., k_lo:v_lo].reshape(B, L, N_KV_HEADS, HEAD_DIM), rows, cols)
        vx = px[..., v_lo:f_lo].reshape(B, L, N_KV_HEADS, HEAD_DIM)
        fx = px[..., f_lo:]
        ax = latent_attention(qx, kx, vx, kc, vc, sink[l])
        fo = fourier_mix(fx, w_f[l])
        x_new = x + ga_a[:, None, :] * merge_groups(ax, fo, g_attn_out[l], g_four_out[l], w_out[l])
        hm = modulate(rmsnorm(x_new, g_mlp[l]), sh_m, sc_m)
        x_new = x_new + ga_m[:, None, :] * sq_relu_mlp(hm, w1[l], w2[l])

        if not last:
            qc = (hc @ w[:, :k_lo]).reshape(B, C, N_HEADS, HEAD_DIM)
            fc = hc @ w[:, f_lo:]
            acx = context_attention(qc, kc, vc, sink[l])
            fco = fourier_mix(fc, w_f[l])
            ctx_new = ctx + cga_a[:, None, :] * merge_groups(acx, fco, g_attn_out[l], g_four_out[l], w_out[l])
            hcm = modulate(rmsnorm(ctx_new, g_mlp[l]), csh_m, csc_m)
            ctx = ctx_new + cga_m[:, None, :] * sq_relu_mlp(hcm, w1[l], w2[l])
        x = x_new

    return rmsnorm(x, g_final)
```

```cpp
#include <hip/hip_runtime.h>
#include <cstdio>
#include <cstdint>

#ifndef MK_PER_PHASE
#define MK_PER_PHASE 0
#endif

#define LAS __attribute__((address_space(3)))
typedef unsigned short bf16_t;
typedef short bf16x8 __attribute__((ext_vector_type(8)));
typedef short s16x4 __attribute__((ext_vector_type(4)));
typedef float f32x2 __attribute__((ext_vector_type(2)));
typedef float f32x4 __attribute__((ext_vector_type(4)));
typedef float f32x16 __attribute__((ext_vector_type(16)));
typedef unsigned u32x2 __attribute__((ext_vector_type(2)));
typedef unsigned u32x4 __attribute__((ext_vector_type(4)));

constexpr int DM = 4096, SEQ = 16384, CTX = 256, MT = SEQ + CTX, DEPTH = 4;
constexpr int NHEAD = 16, NKVH = 4, HD = 128, QW = 2048, FW = 2048, INW = 5120, DFF = 16384, ARANK = 512, NMOD = 6;
constexpr int K_LO = 2048, V_LO = 2560, F_LO = 3072;
constexpr float EPS = 1e-6f;

constexpr size_t MiB = 1u << 20;
constexpr size_t WS_CTL = 0, CTL_ZERO_BYTES = 1 * MiB;
constexpr size_t WS_MOD = 1 * MiB;
constexpr size_t WS_TPART = 2 * MiB;
constexpr size_t WS_ROPE = 2 * MiB + 256 * 1024;
constexpr size_t WS_TW = 2 * MiB + 512 * 1024;
constexpr size_t WS_FM1 = 3 * MiB, WS_FM2 = 3 * MiB + 128 * 1024, WS_FC = 3 * MiB + 256 * 1024, WS_CS = 3 * MiB + 512 * 1024;
constexpr size_t WS_WFRAW = 5 * MiB;
constexpr size_t WS_WFT = 13 * MiB;
constexpr size_t WS_WIN = 32 * MiB;
constexpr size_t WS_WOUT = 192 * MiB;
constexpr size_t WS_W1 = 320 * MiB;
constexpr size_t WS_W2 = 832 * MiB;
constexpr size_t WS_XW = 1344 * MiB;
constexpr size_t WS_HX = 1604 * MiB;
constexpr size_t WS_PX = 1734 * MiB;
constexpr size_t WS_MIX = 1897 * MiB;
constexpr size_t WS_ZT2 = 2027 * MiB;
constexpr size_t WS_Y2 = 2155 * MiB;
constexpr size_t WS_ZTC = 2283 * MiB;
constexpr size_t WS_H = 2285 * MiB;
constexpr size_t WS_END = 2805 * MiB;
static_assert(WS_XW + (size_t)MT * DM * 4 <= WS_HX && WS_HX + (size_t)MT * DM * 2 <= WS_PX && WS_PX + (size_t)MT * INW * 2 <= WS_MIX && WS_MIX + (size_t)MT * DM * 2 <= WS_ZT2 && WS_H + (size_t)MT * DFF * 2 <= WS_END, "ws map");

constexpr int CW_BAR = 4096;

constexpr int RING_BYTES = 131072, LDSCTL_OFF = RING_BYTES, MISC_OFF = LDSCTL_OFF + 320, LDS_BYTES = 147456;
constexpr int NWAVES = 8;

__device__ __forceinline__ unsigned cvt_pk_bf16(float lo, float hi) { unsigned r; asm volatile("v_cvt_pk_bf16_f32 %0, %1, %2" : "=v"(r) : "v"(lo), "v"(hi)); return r; }
__device__ __forceinline__ unsigned f2bf(float f) { unsigned u = __builtin_bit_cast(unsigned, f); return (u + 0x7fffu + ((u >> 16) & 1u)) >> 16; }
__device__ __forceinline__ unsigned pk2(float lo, float hi) { return f2bf(lo) | (f2bf(hi) << 16); }
__device__ __forceinline__ float bf2f(unsigned short b) { return __builtin_bit_cast(float, ((unsigned)b) << 16); }
__device__ __forceinline__ float wave_sum(float v) {
#pragma unroll
    for (int o = 1; o < 64; o <<= 1) v += __shfl_xor(v, o);
    return v;
}
__device__ __forceinline__ float cos_rev(float x) { return __builtin_amdgcn_cosf(x); }
__device__ __forceinline__ float sin_rev(float x) { return __builtin_amdgcn_sinf(x); }

namespace pg8 {
constexpr int BM = 256, BK = 64, HALF = 128, HTB = HALF * BK * 2, STAGE_BYTES = 8 * HTB, NXCD = 8, WGM = 8;
__host__ __device__ __forceinline__ int lds_byte(int r, int c) { const int st = (r >> 4) * 2 + (c >> 5), rr = r & 15, cc = c & 31, ob = rr * 64 + cc * 2; return st * 1024 + (ob ^ (((ob >> 9) & 1) << 5)); }
__host__ __device__ __forceinline__ void stage_rc(int b, int& R, int& C) { const int st = b / 1024, sb = b % 1024, swz = sb ^ (((sb >> 9) & 1) << 5); R = (st >> 1) * 16 + swz / 64; C = (st & 1) * 32 + (swz % 64) / 2; }
__host__ __device__ __forceinline__ int perm32(int rho) { const int n = rho >> 4, i = rho & 15; return 8 * (i >> 2) + 4 * n + (i & 3); }

struct Unit { int pm, pn, g; };
struct Gemm { int K; unsigned rsA, rsB; size_t hsA, hsB; };

template <class Epi, class Sched>
__device__ __forceinline__ void gemm_phase(LAS unsigned char* lds, const Gemm g, const Sched& S, const Epi& E) {
    int tid = threadIdx.x; asm volatile("" : "+v"(tid));
    const int wid = __builtin_amdgcn_readfirstlane(tid >> 6), lane = tid & 63, wr = wid >> 2, wc = wid & 3, fr = lane & 15, fq = lane >> 4;
    const int K = g.K, nt = K / BK;
    unsigned voffA[2], voffB[2];
#pragma unroll
    for (int i = 0; i < 2; ++i) { int R, C; stage_rc(tid * 16 + i * 8192, R, C); const int Rb = Epi::PERM ? ((R & ~31) + perm32(R & 31)) : R;
        voffA[i] = (unsigned)R * g.rsA + (unsigned)C * 2u; voffB[i] = (unsigned)Rb * g.rsB + (unsigned)C * 2u; }
    const size_t kstep = (size_t)(BK * 2);
    const size_t hA = g.hsA, hB = g.hsB;
    const unsigned ldsw = (unsigned)wid * 1024u;
    const int aoff = lds_byte(wr * 64 + fr, fq * 8), boff = lds_byte(wc * 32 + fr, fq * 8);
#define PG8_SA(b, h) (((b) * 2 + (h)) * HTB)
#define PG8_SB(b, h) ((4 + (b) * 2 + (h)) * HTB)
#define PG8_STAGE(bufoff, gbase, voff) do { _Pragma("unroll") for (int _i = 0; _i < 2; ++_i) \
        __builtin_amdgcn_global_load_lds((const unsigned*)((const char*)(gbase) + (voff)[_i]), (LAS unsigned*)(lds + (bufoff) + ldsw + _i * 8192), 16, 0, 0); } while (0)
#define PG8_LDA(dst, b, h) do { _Pragma("unroll") for (int m = 0; m < 4; ++m) _Pragma("unroll") for (int k = 0; k < 2; ++k) dst[m][k] = *(const LAS bf16x8*)(lds + PG8_SA(b, h) + aoff + m * 2048 + k * 1024); } while (0)
#define PG8_LDB(dst, b, h) do { _Pragma("unroll") for (int n = 0; n < 2; ++n) _Pragma("unroll") for (int k = 0; k < 2; ++k) dst[n][k] = *(const LAS bf16x8*)(lds + PG8_SB(b, h) + boff + n * 2048 + k * 1024); } while (0)
#define PG8_MMA(ai, bj, At, Bt) do { __builtin_amdgcn_s_setprio(1); _Pragma("unroll") for (int m = 0; m < 4; ++m) _Pragma("unroll") for (int n = 0; n < 2; ++n) _Pragma("unroll") for (int k = 0; k < 2; ++k) \
        acc[ai][bj][m][n] = __builtin_amdgcn_mfma_f32_16x16x32_bf16(Bt[n][k], At[m][k], acc[ai][bj][m][n], 0, 0, 0); __builtin_amdgcn_s_setprio(0); } while (0)
#define PG8_WAIT_V(n) asm volatile("s_waitcnt vmcnt(" #n ")" ::: "memory")
#define PG8_WAIT_L(n) asm volatile("s_waitcnt lgkmcnt(" #n ")" ::: "memory")
#define PG8_BAR __builtin_amdgcn_s_barrier()
#define PG8_SCHED __builtin_amdgcn_sched_barrier(0)
    Unit cur, nxt; int ui = 0;
    if (!S.next(0, cur)) return;
    f32x4 acc[2][2][4][2];
#pragma unroll
    for (int a = 0; a < 2; ++a)
#pragma unroll
        for (int b = 0; b < 2; ++b)
#pragma unroll
            for (int m = 0; m < 4; ++m)
#pragma unroll
                for (int n = 0; n < 2; ++n) acc[a][b][m][n] = (f32x4){0.f, 0.f, 0.f, 0.f};
    bf16x8 At[4][2], B0[2][2], B1[2][2];
    const char* cA = S.abase(cur); const char* cB = S.bbase(cur);
    PG8_STAGE(PG8_SB(0, 0), cB, voffB); PG8_STAGE(PG8_SB(0, 1), cB + hB, voffB); PG8_STAGE(PG8_SA(0, 0), cA, voffA); PG8_STAGE(PG8_SA(0, 1), cA + hA, voffA);
    if (wr == 1) PG8_BAR;
    PG8_WAIT_V(2); PG8_BAR;
    PG8_STAGE(PG8_SB(1, 0), cB + kstep, voffB); PG8_STAGE(PG8_SA(1, 0), cA + kstep, voffA); PG8_STAGE(PG8_SB(1, 1), cB + hB + kstep, voffB);
    PG8_WAIT_V(6); PG8_BAR;
    for (;;) {
        const bool has_next = S.next(ui + 1, nxt);
        const char* nA = has_next ? S.abase(nxt) : cA; const char* nB = has_next ? S.bbase(nxt) : cB;
#pragma nounroll
        for (int t = 0; t < nt; t += 2) {
            const bool last = (t == nt - 2);
            const char* a1 = cA + (size_t)(t + 1) * kstep;
            const char* a2 = last ? nA : cA + (size_t)(t + 2) * kstep; const char* b2 = last ? nB : cB + (size_t)(t + 2) * kstep;
            const char* a3 = a2 + kstep; const char* b3 = b2 + kstep;
            PG8_LDB(B0, 0, 0); PG8_LDB(B1, 0, 1); PG8_SCHED; PG8_LDA(At, 0, 0); PG8_STAGE(PG8_SA(1, 1), a1 + hA, voffA);
            PG8_WAIT_V(8); PG8_WAIT_L(0); PG8_BAR; PG8_MMA(0, 0, At, B0); PG8_MMA(0, 1, At, B1); PG8_BAR; PG8_SCHED;
            PG8_LDA(At, 0, 1); PG8_STAGE(PG8_SB(0, 0), b2, voffB); PG8_STAGE(PG8_SB(0, 1), b2 + hB, voffB); PG8_STAGE(PG8_SA(0, 0), a2, voffA);
            PG8_WAIT_V(8); PG8_WAIT_L(0); PG8_BAR; PG8_MMA(1, 0, At, B0); PG8_MMA(1, 1, At, B1); PG8_BAR; PG8_SCHED;
            PG8_LDB(B0, 1, 0); PG8_LDB(B1, 1, 1); PG8_SCHED; PG8_LDA(At, 1, 0); PG8_STAGE(PG8_SA(0, 1), a2 + hA, voffA);
            PG8_WAIT_V(8); PG8_WAIT_L(0); PG8_BAR; PG8_MMA(0, 0, At, B0); PG8_MMA(0, 1, At, B1); PG8_BAR; PG8_SCHED;
            PG8_LDA(At, 1, 1); PG8_STAGE(PG8_SB(1, 0), b3, voffB); PG8_STAGE(PG8_SB(1, 1), b3 + hB, voffB); PG8_STAGE(PG8_SA(1, 0), a3, voffA);
            PG8_WAIT_V(8); PG8_WAIT_L(0); PG8_BAR; PG8_MMA(1, 0, At, B0); PG8_MMA(1, 1, At, B1); PG8_BAR; PG8_SCHED;
        }
        if (wr == 0) PG8_BAR;
        { int efr = fr, efq = fq; asm volatile("" : "+v"(efr), "+v"(efq));
          E(acc, cur, wr, wc, efr, efq); }
        if (!has_next) break;
#pragma unroll
        for (int a = 0; a < 2; ++a)
#pragma unroll
            for (int b = 0; b < 2; ++b)
#pragma unroll
                for (int m = 0; m < 4; ++m)
#pragma unroll
                    for (int n = 0; n < 2; ++n) acc[a][b][m][n] = (f32x4){0.f, 0.f, 0.f, 0.f};
        cur = nxt; cA = nA; cB = nB; ++ui;
        if (wr == 1) PG8_BAR;
    }
    PG8_WAIT_V(0);
    PG8_BAR;
#undef PG8_SA
#undef PG8_SB
#undef PG8_STAGE
#undef PG8_LDA
#undef PG8_LDB
#undef PG8_MMA
#undef PG8_WAIT_V
#undef PG8_WAIT_L
#undef PG8_BAR
#undef PG8_SCHED
}

struct SchedStd {
    int nM, nN, nwg, G, c; const char* A; const char* B; size_t tsA, tsB;
    __device__ __forceinline__ void init(int nM_, int nN_, int G_, int c_, const void* A_, size_t tsA_, const void* B_, size_t tsB_) { nM = nM_; nN = nN_; nwg = nM * nN; G = G_; c = c_; A = (const char*)A_; B = (const char*)B_; tsA = tsA_; tsB = tsB_; }
    __device__ __forceinline__ bool next(int i, Unit& u) const {
        const long L = (long)i * G + c; if (L >= nwg) return false;
        int wgid = (int)L; { const int q = nwg / NXCD, r = nwg % NXCD, xcd = wgid % NXCD, off = wgid / NXCD; wgid = (xcd < r ? xcd * (q + 1) : r * (q + 1) + (xcd - r) * q) + off; }
        const int nig = WGM * nN, gid = wgid / nig, fm = gid * WGM, gsz = (nM - fm) < WGM ? (nM - fm) : WGM;
        u.pm = fm + ((wgid % nig) % gsz); u.pn = (wgid % nig) / gsz; u.g = 0; return true;
    }
    __device__ __forceinline__ const char* abase(const Unit& u) const { return A + (size_t)u.pm * tsA; }
    __device__ __forceinline__ const char* bbase(const Unit& u) const { return B + (size_t)u.pn * tsB; }
};
struct SchedGa {
    int G, c; const char* WfT; const char* PXf;
    __device__ __forceinline__ bool next(int i, Unit& u) const { const int L = i * G + c; if (L >= 1024) return false; u.pn = L >> 4; u.g = (L >> 2) & 3; u.pm = L & 3; return true; }
    __device__ __forceinline__ const char* abase(const Unit& u) const { return WfT + (size_t)u.g * (512 * 1024 * 2) + ((size_t)(u.pm & 1) * 256 * 1024 + (size_t)(u.pm >> 1) * 512) * 2; }
    __device__ __forceinline__ const char* bbase(const Unit& u) const { return PXf + ((size_t)(2 * u.pn) * INW + 512 * u.g) * 2; }
};
struct SchedGaCtx {
    int G, c; const char* WfT; const char* PXf;
    __device__ __forceinline__ bool next(int i, Unit& u) const { const int L = i * G + c; if (L >= 16) return false; u.pn = 0; u.g = L >> 2; u.pm = L & 3; return true; }
    __device__ __forceinline__ const char* abase(const Unit& u) const { return WfT + (size_t)u.g * (512 * 1024 * 2) + ((size_t)(u.pm & 1) * 256 * 1024 + (size_t)(u.pm >> 1) * 512) * 2; }
    __device__ __forceinline__ const char* bbase(const Unit& u) const { return PXf + ((size_t)SEQ * INW + 512 * u.g) * 2; }
};
struct SchedN {
    int G, c, ntile; const char* A; const char* B; size_t tsB;
    __device__ __forceinline__ bool next(int i, Unit& u) const { const int L = i * G + c; if (L >= ntile) return false; u.pn = L; u.pm = 0; u.g = 0; return true; }
    __device__ __forceinline__ const char* abase(const Unit&) const { return A; }
    __device__ __forceinline__ const char* bbase(const Unit& u) const { return B + (size_t)u.pn * tsB; }
};
struct SchedWf {
    int G, c; const char* WfRaw; const char* CS;
    __device__ __forceinline__ bool next(int i, Unit& u) const { const int L = i * G + c; if (L >= 128) return false; u.g = L >> 3; u.pm = (L >> 2) & 1; u.pn = L & 3; return true; }
    __device__ __forceinline__ const char* abase(const Unit& u) const { return WfRaw + (size_t)u.g * (512 * 512 * 2) + (size_t)u.pm * 256 * 1024; }
    __device__ __forceinline__ const char* bbase(const Unit& u) const { return CS + (size_t)u.pn * 256 * 1024; }
};

#define ACC_T const f32x4 (&acc)[2][2][4][2]
__device__ __forceinline__ u32x4 pack8(const f32x4 a, const f32x4 b) { u32x4 w; w.x = cvt_pk_bf16(a[0], a[1]); w.y = cvt_pk_bf16(a[2], a[3]); w.z = cvt_pk_bf16(b[0], b[1]); w.w = cvt_pk_bf16(b[2], b[3]); return w; }
__device__ __forceinline__ u32x2 pack4(const f32x4 a) { u32x2 w; w.x = cvt_pk_bf16(a[0], a[1]); w.y = cvt_pk_bf16(a[2], a[3]); return w; }

struct EpiInproj {
    static constexpr bool PERM = true;
    bf16_t* PX; const float* COS; const float* SIN;
    __device__ __forceinline__ void operator()(ACC_T, const Unit& u, int wr, int wc, int fr, int fq) const {
        const int row0 = u.pm * BM + wr * 64 + fr;
        if (u.pn < 10) {
            const int a = wc >> 1, b = wc & 1, jj = 16 * b + 4 * fq, dcol = 64 * a + jj;
            const bool rot = u.pm < 64;
#pragma unroll
            for (int ai = 0; ai < 2; ++ai)
#pragma unroll
                for (int m = 0; m < 4; ++m) {
                    const int row = row0 + ai * HALF + m * 16; const int pos = a ? (row & 63) : ((row >> 6) & 255);
                    f32x4 cs = (f32x4){1.f, 1.f, 1.f, 1.f}, sn = (f32x4){0.f, 0.f, 0.f, 0.f};
                    if (rot) { cs = *(const f32x4*)(COS + pos * 32 + jj); sn = *(const f32x4*)(SIN + pos * 32 + jj); }
                    bf16_t* rowp = PX + (size_t)row * INW + u.pn * BM + dcol;
#pragma unroll
                    for (int bj = 0; bj < 2; ++bj) { const f32x4 x1 = acc[ai][bj][m][0], x2 = acc[ai][bj][m][1];
                        const f32x4 o1 = x1 * cs - x2 * sn, o2 = x2 * cs + x1 * sn;
                        *(u32x2*)(rowp + bj * HALF) = pack4(o1); *(u32x2*)(rowp + bj * HALF + 32) = pack4(o2); }
                }
        } else {
            const int col0 = u.pn * BM + wc * 32 + 8 * fq;
#pragma unroll
            for (int ai = 0; ai < 2; ++ai)
#pragma unroll
                for (int m = 0; m < 4; ++m) { bf16_t* rowp = PX + (size_t)(row0 + ai * HALF + m * 16) * INW + col0;
#pragma unroll
                    for (int bj = 0; bj < 2; ++bj) *(u32x4*)(rowp + bj * HALF) = pack8(acc[ai][bj][m][0], acc[ai][bj][m][1]); }
        }
    }
};
struct EpiResid {
    static constexpr bool PERM = false;
    const float* xlat; const float* xctx; float* XW; const float* gate_lat; const float* gate_ctx;
    __device__ __forceinline__ void operator()(ACC_T, const Unit& u, int wr, int wc, int fr, int fq) const {
        const int row0 = u.pm * BM + wr * 64 + fr, col0 = u.pn * BM + wc * 32 + 4 * fq;
        const bool isctx = (u.pm == 64);
        const float* gate = isctx ? gate_ctx : gate_lat;
        const float* base = isctx ? (xctx - (size_t)SEQ * DM) : xlat;
        f32x4 gv[2][2];
#pragma unroll
        for (int bj = 0; bj < 2; ++bj)
#pragma unroll
            for (int n = 0; n < 2; ++n) gv[bj][n] = *(const f32x4*)(gate + col0 + bj * HALF + n * 16);
#pragma unroll
        for (int ai = 0; ai < 2; ++ai)
#pragma unroll
            for (int m = 0; m < 4; ++m) { const size_t off = (size_t)(row0 + ai * HALF + m * 16) * DM + col0;
#pragma unroll
                for (int bj = 0; bj < 2; ++bj)
#pragma unroll
                    for (int n = 0; n < 2; ++n) { const f32x4 bs = *(const f32x4*)(base + off + bj * HALF + n * 16);
                        *(f32x4*)(XW + off + bj * HALF + n * 16) = bs + gv[bj][n] * acc[ai][bj][m][n]; } }
    }
};
struct EpiRelu2 {
    static constexpr bool PERM = true;
    bf16_t* H;
    __device__ __forceinline__ void operator()(ACC_T, const Unit& u, int wr, int wc, int fr, int fq) const {
        const int row0 = u.pm * BM + wr * 64 + fr, col0 = u.pn * BM + wc * 32 + 8 * fq;
#pragma unroll
        for (int ai = 0; ai < 2; ++ai)
#pragma unroll
            for (int m = 0; m < 4; ++m) { bf16_t* rowp = H + (size_t)(row0 + ai * HALF + m * 16) * DFF + col0;
#pragma unroll
                for (int bj = 0; bj < 2; ++bj) { f32x4 v0 = acc[ai][bj][m][0], v1 = acc[ai][bj][m][1];
#pragma unroll
                    for (int e = 0; e < 4; ++e) { const float a0 = fmaxf(v0[e], 0.f), a1 = fmaxf(v1[e], 0.f); v0[e] = a0 * a0; v1[e] = a1 * a1; }
                    *(u32x4*)(rowp + bj * HALF) = pack8(v0, v1); } }
    }
};
struct EpiWf {
    static constexpr bool PERM = true;
    bf16_t* WfT;
    __device__ __forceinline__ void operator()(ACC_T, const Unit& u, int wr, int wc, int fr, int fq) const {
        const int row0 = u.pm * BM + wr * 64 + fr, col0 = u.pn * BM + wc * 32 + 8 * fq;
        bf16_t* base = WfT + (size_t)u.g * (512 * 1024);
#pragma unroll
        for (int ai = 0; ai < 2; ++ai)
#pragma unroll
            for (int m = 0; m < 4; ++m) { bf16_t* rowp = base + (size_t)(row0 + ai * HALF + m * 16) * 1024 + col0;
#pragma unroll
                for (int bj = 0; bj < 2; ++bj) *(u32x4*)(rowp + bj * HALF) = pack8(acc[ai][bj][m][0], acc[ai][bj][m][1]); }
    }
};
struct EpiGa {
    static constexpr bool PERM = true;
    bf16_t* ZT2;
    __device__ __forceinline__ void operator()(ACC_T, const Unit& u, int wr, int wc, int fr, int fq) const {
        const int reim = u.pm >> 1, d0 = (u.pm & 1) * 256 + wr * 64 + fr, l1 = wc * 32 + 8 * fq;
#pragma unroll
        for (int ai = 0; ai < 2; ++ai)
#pragma unroll
            for (int m = 0; m < 4; ++m) { const int j = u.g * 512 + d0 + ai * HALF + m * 16;
#pragma unroll
                for (int bj = 0; bj < 2; ++bj) { const int l2 = 2 * u.pn + bj;
                    *(u32x4*)(ZT2 + ((size_t)(j * 128 + l2) * 256 + reim * 128 + l1)) = pack8(acc[ai][bj][m][0], acc[ai][bj][m][1]); } }
    }
};
struct EpiGaCtx {
    static constexpr bool PERM = true;
    bf16_t* ZTc;
    __device__ __forceinline__ void operator()(ACC_T, const Unit& u, int wr, int wc, int fr, int fq) const {
        const int reim = u.pm >> 1, d0 = (u.pm & 1) * 256 + wr * 64 + fr, l0 = wc * 32 + 8 * fq;
#pragma unroll
        for (int ai = 0; ai < 2; ++ai)
#pragma unroll
            for (int m = 0; m < 4; ++m) { const int j = u.g * 512 + d0 + ai * HALF + m * 16;
#pragma unroll
                for (int bj = 0; bj < 2; ++bj)
                    *(u32x4*)(ZTc + ((size_t)j * 512 + reim * 256 + bj * HALF + l0)) = pack8(acc[ai][bj][m][0], acc[ai][bj][m][1]); }
    }
};
struct EpiGb {
    static constexpr bool PERM = true;
    bf16_t* Y2; const f32x2* TW;
    __device__ __forceinline__ void operator()(ACC_T, const Unit& u, int wr, int wc, int fr, int fq) const {
        const int l2b = wc * 32 + 8 * fq;
#pragma unroll
        for (int m = 0; m < 4; ++m) { const int k1 = wr * 64 + m * 16 + fr;
            f32x2 t[8];
#pragma unroll
            for (int e = 0; e < 8; ++e) t[e] = TW[(unsigned)(k1 * (l2b + e))];
#pragma unroll
            for (int bj = 0; bj < 2; ++bj) { const int j = 2 * u.pn + bj;
                f32x4 r0, r1, i0, i1;
#pragma unroll
                for (int e = 0; e < 4; ++e) {
                    const float yr0 = acc[0][bj][m][0][e], yi0 = acc[1][bj][m][0][e], yr1 = acc[0][bj][m][1][e], yi1 = acc[1][bj][m][1][e];
                    r0[e] = yr0 * t[e].x + yi0 * t[e].y; i0[e] = yi0 * t[e].x - yr0 * t[e].y;
                    r1[e] = yr1 * t[4 + e].x + yi1 * t[4 + e].y; i1[e] = yi1 * t[4 + e].x - yr1 * t[4 + e].y; }
                bf16_t* p = Y2 + ((size_t)(k1 * 2048 + j) * 256 + l2b);
                *(u32x4*)p = pack8(r0, r1); *(u32x4*)(p + 128) = pack8(i0, i1); }
            asm volatile("" ::: "memory"); }
    }
};
struct EpiGc {
    static constexpr bool PERM = true;
    bf16_t* MIX;
    __device__ __forceinline__ void operator()(ACC_T, const Unit& u, int wr, int wc, int fr, int fq) const {
        const int k1 = u.pn >> 3, j0 = (u.pn & 7) * 256 + wc * 32 + 8 * fq;
#pragma unroll
        for (int m = 0; m < 4; ++m) { const int k2 = wr * 64 + m * 16 + fr; const int pos = k1 + 128 * k2;
#pragma unroll
            for (int bj = 0; bj < 2; ++bj) *(u32x4*)(MIX + (size_t)pos * DM + QW + j0 + bj * HALF) = pack8(acc[0][bj][m][0], acc[0][bj][m][1]); }
    }
};
struct EpiGctx {
    static constexpr bool PERM = true;
    bf16_t* MIX;
    __device__ __forceinline__ void operator()(ACC_T, const Unit& u, int wr, int wc, int fr, int fq) const {
        const int j0 = u.pn * 256 + wc * 32 + 8 * fq;
#pragma unroll
        for (int ai = 0; ai < 2; ++ai)
#pragma unroll
            for (int m = 0; m < 4; ++m) { const int k = ai * HALF + wr * 64 + m * 16 + fr;
#pragma unroll
                for (int bj = 0; bj < 2; ++bj) *(u32x4*)(MIX + (size_t)(SEQ + k) * DM + QW + j0 + bj * HALF) = pack8(acc[ai][bj][m][0], acc[ai][bj][m][1]); }
    }
};
#undef ACC_T
}

namespace att {
constexpr float SCALE = 0.08838834764831845f;
constexpr float THR = 0.f;
constexpr int SHM_K = 16384, SHM_V = 16384, OFF_V = 0, OFF_K = 2 * SHM_V, OFF_WS = 2 * SHM_V + 2 * SHM_K;
#define KSWZ(row, colB) ((row) * 256 + ((colB) ^ (((row) & 7) << 4)))
#define SBAR() __builtin_amdgcn_sched_barrier(0)
__device__ __forceinline__ int v_st(int k, int c) { const int kk = (k & ~0xC) | ((k & 4) << 1) | ((k & 8) >> 1); return ((kk >> 3) * 4 + (c >> 5)) * 512 + ((kk & 7) * 32 + (c & 31)) * 2; }
__device__ __forceinline__ int v_rd_base(int lane) { return ((lane & 3) << 3) | (((lane >> 2) & 3) << 6) | (((lane >> 4) & 1) << 5) | (((lane >> 5) & 1) << 8); }
constexpr int v_rd_off(int d0, int ks, int half) { return d0 * 512 + ks * 4096 + half * 2048; }
__device__ __forceinline__ int crow(int r, int hi) { return (r & 3) + 8 * (r >> 2) + 4 * hi; }
__device__ __forceinline__ unsigned cvtpk(float lo, float hi) { unsigned r; asm volatile("v_cvt_pk_bf16_f32 %0, %1, %2" : "=v"(r) : "v"(lo), "v"(hi)); return r; }
__device__ __forceinline__ void mask_tile(f32x16& p0, f32x16& p1, int dq, unsigned W) {
    const float NEG = -__builtin_inff();
#pragma unroll
    for (int r = 0; r < 16; ++r) {
        const int c = (r & 3) + 8 * (r >> 2);
        if ((unsigned)(dq - c) >= W) p0[r] = NEG;
        if ((unsigned)(dq - c - 32) >= W) p1[r] = NEG;
    }
}
__device__ __forceinline__ void partialSM(f32x16& p0, f32x16& p1, float& m_reg, float& mn, float& alpha) {
    float pmax = p0[0];
#pragma unroll
    for (int r = 1; r < 16; ++r) pmax = fmaxf(pmax, p0[r]);
#pragma unroll
    for (int r = 0; r < 16; ++r) pmax = fmaxf(pmax, p1[r]);
    { auto rr = __builtin_amdgcn_permlane32_swap(__float_as_uint(pmax), __float_as_uint(pmax), false, false);
      pmax = fmaxf(__uint_as_float(rr[0]), __uint_as_float(rr[1])); }
    constexpr float C2 = 1.4426950408889634f * SCALE;
    if (__all((pmax - m_reg) * SCALE <= THR)) { mn = m_reg; alpha = 1.f; }
    else { mn = fmaxf(m_reg, pmax); alpha = __builtin_amdgcn_exp2f((m_reg - mn) * C2); m_reg = mn; }
    const float mnL = -mn * C2;
#pragma unroll
    for (int r = 0; r < 16; ++r) p0[r] = fmaf(p0[r], C2, mnL);
#pragma unroll
    for (int r = 0; r < 16; ++r) p1[r] = fmaf(p1[r], C2, mnL);
#pragma unroll
    for (int r = 0; r < 16; ++r) p0[r] = __builtin_amdgcn_exp2f(p0[r]);
}
__device__ __forceinline__ void finishSM(f32x16& p0, f32x16& p1, float alpha, float& l_reg, bf16x8& pa0, bf16x8& pa1, bf16x8& pa2, bf16x8& pa3) {
#pragma unroll
    for (int r = 0; r < 16; ++r) p1[r] = __builtin_amdgcn_exp2f(p1[r]);
    float ps = 0;
#pragma unroll
    for (int r = 0; r < 16; ++r) ps += p0[r];
#pragma unroll
    for (int r = 0; r < 16; ++r) ps += p1[r];
    { auto rr = __builtin_amdgcn_permlane32_swap(__float_as_uint(ps), __float_as_uint(ps), false, false);
      ps = __uint_as_float(rr[0]) + __uint_as_float(rr[1]); }
    l_reg = l_reg * alpha + ps;
#define PK4(P, B_, OUT) do { unsigned a0 = cvtpk(P[B_+0], P[B_+1]), a1 = cvtpk(P[B_+2], P[B_+3]);                          \
        unsigned b0 = cvtpk(P[B_+4], P[B_+5]), b1 = cvtpk(P[B_+6], P[B_+7]);                                             \
        auto r0 = __builtin_amdgcn_permlane32_swap(a0, b0, false, false); auto r1 = __builtin_amdgcn_permlane32_swap(a1, b1, false, false); \
        u32x4 w = {r0[0], r1[0], r0[1], r1[1]}; OUT = __builtin_bit_cast(bf16x8, w); } while (0)
    PK4(p0, 0, pa0); PK4(p0, 8, pa1); PK4(p1, 0, pa2); PK4(p1, 8, pa3);
#undef PK4
}
template <int KB>
__device__ __forceinline__ void qkt(f32x16& p0, f32x16& p1, const LAS char* K_lds, int r32, int hi, const bf16x8* qr) {
    p0 = f32x16{}; p1 = f32x16{};
    const LAS char* kb[4];
#pragma unroll
    for (int dd = 0; dd < 4; ++dd) kb[dd] = K_lds + KB * SHM_K + KSWZ(r32, (dd * 16 + hi * 8) * 2);
#pragma unroll
    for (int d0 = 0; d0 < 8; ++d0) { const LAS char* a = kb[d0 & 3] + (d0 >> 2) * 128;
        bf16x8 b0 = *(const LAS bf16x8*)(a);
        bf16x8 b1 = *(const LAS bf16x8*)(a + 32 * 256);
        p0 = __builtin_amdgcn_mfma_f32_32x32x16_bf16(b0, qr[d0], p0, 0, 0, 0);
        p1 = __builtin_amdgcn_mfma_f32_32x32x16_bf16(b1, qr[d0], p1, 0, 0, 0); }
}
template <int VB>
__device__ __forceinline__ void pv_tile(f32x16* o, int vb0, bf16x8 pa0, bf16x8 pa1, bf16x8 pa2, bf16x8 pa3) {
#define TRRD(dst, off) asm volatile("ds_read_b64_tr_b16 %0, %1 offset:%2" : "=&v"(dst) : "v"(vb0), "i"(off) : "memory")
#define PV_D0(d0) do { s16x4 l0, l1, l2, l3, h0, h1, h2, h3; constexpr int b_ = VB * SHM_V + v_rd_off(d0, 0, 0); \
        TRRD(l0, b_); TRRD(h0, b_ + 2048); TRRD(l1, b_ + 4096); TRRD(h1, b_ + 6144); TRRD(l2, b_ + 8192); TRRD(h2, b_ + 10240); TRRD(l3, b_ + 12288); TRRD(h3, b_ + 14336); \
        asm volatile("s_waitcnt lgkmcnt(0)" ::: "memory"); SBAR();   \
        o[d0] = __builtin_amdgcn_mfma_f32_32x32x16_bf16(pa0, (bf16x8){l0[0], l0[1], l0[2], l0[3], h0[0], h0[1], h0[2], h0[3]}, o[d0], 0, 0, 0);   \
        o[d0] = __builtin_amdgcn_mfma_f32_32x32x16_bf16(pa1, (bf16x8){l1[0], l1[1], l1[2], l1[3], h1[0], h1[1], h1[2], h1[3]}, o[d0], 0, 0, 0);   \
        o[d0] = __builtin_amdgcn_mfma_f32_32x32x16_bf16(pa2, (bf16x8){l2[0], l2[1], l2[2], l2[3], h2[0], h2[1], h2[2], h2[3]}, o[d0], 0, 0, 0);   \
        o[d0] = __builtin_amdgcn_mfma_f32_32x32x16_bf16(pa3, (bf16x8){l3[0], l3[1], l3[2], l3[3], h3[0], h3[1], h3[2], h3[3]}, o[d0], 0, 0, 0); } while (0)
    PV_D0(0); PV_D0(1); PV_D0(2); PV_D0(3);
#undef PV_D0
#undef TRRD
}

__device__ __forceinline__ void attn_item(LAS char* lds, const bf16_t* PX, bf16_t* MIX, const float* sink, int qrow0, int kvh, int hp, int nt, int wstart) {
    int tid = threadIdx.x; asm volatile("" : "+v"(tid));
    const int wid = __builtin_amdgcn_readfirstlane(tid >> 6), lane = tid & 63, r32 = lane & 31, hi = lane >> 5;
    const int hq = 4 * kvh + 2 * hp + (wid >> 2);
    const int qw0 = qrow0 + 32 * (wid & 3), qrow = qw0 + r32;
    LAS char* V_lds = lds + OFF_V; LAS char* K_lds = lds + OFF_K;
    LAS float* ws = (LAS float*)(lds + OFF_WS) + wid * 64; LAS float* li_l = ws; LAS float* al_l = ws + 32;
    bf16x8 qr[8];
    { const bf16_t* qp = PX + (size_t)qrow * INW + hq * HD + hi * 8;
#pragma unroll
      for (int d0 = 0; d0 < 8; ++d0) qr[d0] = *(const bf16x8*)(qp + d0 * 16); }
    const int sr = tid >> 4, sc = (tid & 15) * 8, vst0 = v_st(sr, sc), vst1 = v_st(32 + sr, sc), kws = KSWZ(sr, sc * 2);
    const int vb0 = (int)(unsigned)(size_t)V_lds + v_rd_base(lane);
    const bf16_t* Kg = PX + K_LO + kvh * HD + sc; const bf16_t* Vg = PX + V_LO + kvh * HD + sc;
    float m_reg = sink[hq] * (1.0f / SCALE), l_reg = 1.f; f32x16 o[4] = {};
    bf16x8 st_k0, st_k1, st_v0, st_v1;
#define TROW(t_) ((t_) < 4 ? SEQ + 64 * (t_) : wstart + 64 * ((t_) - 4))
#define LOADT(t_) do { const size_t rb_ = (size_t)(TROW(t_) + sr); st_k0 = *(const bf16x8*)(Kg + rb_ * INW); st_k1 = *(const bf16x8*)(Kg + (rb_ + 32) * INW); \
                       st_v0 = *(const bf16x8*)(Vg + rb_ * INW); st_v1 = *(const bf16x8*)(Vg + (rb_ + 32) * INW); } while (0)
#define WRITET(b_) do { *(LAS bf16x8*)(K_lds + (b_) * SHM_K + kws) = st_k0; *(LAS bf16x8*)(K_lds + (b_) * SHM_K + kws + 32 * 256) = st_k1; \
                        *(LAS bf16x8*)(V_lds + (b_) * SHM_V + vst0) = st_v0; *(LAS bf16x8*)(V_lds + (b_) * SHM_V + vst1) = st_v1; } while (0)
#define RESC(a) do { if (__any((a) < 1.f)) { if (hi == 0) al_l[r32] = (a); asm volatile("s_waitcnt lgkmcnt(0)" ::: "memory"); \
        _Pragma("unroll") for (int d_ = 0; d_ < 4; ++d_) _Pragma("unroll") for (int r = 0; r < 16; ++r) o[d_][r] *= al_l[crow(r, hi)]; } } while (0)
#define STEP(B_, t_) do { const int tt_ = (t_); f32x16 p0, p1; float mn, alpha; bf16x8 pa0, pa1, pa2, pa3; \
        if (tt_ + 1 < nt) LOADT(tt_ + 1); \
        SBAR(); qkt<B_>(p0, p1, K_lds, r32, hi, qr); \
        if (tt_ >= 4) mask_tile(p0, p1, qrow + 128 - TROW(tt_) - 4 * hi, 257u); \
        partialSM(p0, p1, m_reg, mn, alpha); RESC(alpha); \
        finishSM(p0, p1, alpha, l_reg, pa0, pa1, pa2, pa3); SBAR(); \
        pv_tile<B_>(o, vb0, pa0, pa1, pa2, pa3); \
        if (tt_ + 1 < nt) WRITET((B_) ^ 1); \
        __syncthreads(); } while (0)
    LOADT(0); WRITET(0); __syncthreads();
    for (int t = 0; t < nt; t += 2) { STEP(0, t); STEP(1, t + 1); }
    if (hi == 0) li_l[r32] = l_reg;
    asm volatile("s_waitcnt lgkmcnt(0)" ::: "memory");
    float rli[16];
#pragma unroll
    for (int r = 0; r < 16; ++r) rli[r] = 1.0f / li_l[crow(r, hi)];
    bf16_t* Ow = MIX + (size_t)qw0 * DM + hq * HD;
#pragma unroll
    for (int r = 0; r < 16; ++r) { const int orow = crow(r, hi);
#pragma unroll
        for (int d0 = 0; d0 < 4; ++d0) { const float v = o[d0][r] * rli[r]; const float vn = __shfl_xor(v, 1);
            if ((r32 & 1) == 0) *(unsigned*)(Ow + (size_t)orow * DM + d0 * 32 + r32) = cvtpk(v, vn); } }
    __syncthreads();
#undef TROW
#undef LOADT
#undef WRITET
#undef RESC
#undef STEP
}
}

#define XB_TMO      128
#define XB_XCNT(j)  (256  + 64 * (j))
#define XB_XSUB(j)  (1280 + 64 * (j))
#define XB_XGEN(j)  (2304 + 64 * (j))
#define XB_TOP      3328
#define XB_TOPGEN   3392
#define XCD_BAR_WORDS 3456
#define XB_SPIN_CAP (1u << 22)
__device__ __forceinline__ unsigned xb_ld(unsigned* p)              { return __hip_atomic_load(p, __ATOMIC_RELAXED, __HIP_MEMORY_SCOPE_AGENT); }
__device__ __forceinline__ unsigned xb_add(unsigned* p, unsigned v) { return __hip_atomic_fetch_add(p, v, __ATOMIC_RELAXED, __HIP_MEMORY_SCOPE_AGENT); }
__device__ __forceinline__ unsigned xb_xcc_id() { return (unsigned)__builtin_amdgcn_s_getreg((3 << 11) | 20) & 0xFu; }
#define XB_SPIN(cond, bar) do { unsigned _sp = 0; while (cond) { __builtin_amdgcn_s_sleep(1); \
    if ((++_sp & 255u) == 0u) { if (xb_ld(&(bar)[XB_TMO])) break; if (_sp > XB_SPIN_CAP) { atomicAdd(&(bar)[XB_TMO], 1u); break; } } } } while (0)
struct XcdBarrier { unsigned* bar; unsigned x; volatile LAS unsigned* st; };
__device__ __forceinline__ XcdBarrier xcd_barrier_post(unsigned* bar, volatile LAS unsigned* st) {
    XcdBarrier b; b.bar = bar; b.x = xb_xcc_id(); b.st = st;
    if (threadIdx.x == 0) (void)xb_add(&bar[XB_XCNT(b.x)], 1u);
    return b;
}
__device__ __forceinline__ void xcd_barrier_complete(unsigned* bar, unsigned x, unsigned& nloc, unsigned& nx) {
    const unsigned G = gridDim.x * gridDim.y * gridDim.z;
    unsigned sum, cnt, mine, sp = 0u;
    for (;;) {
        sum = 0u; cnt = 0u; mine = 0u;
#pragma unroll
        for (unsigned j = 0; j < 16; ++j) { const unsigned c = xb_ld(&bar[XB_XCNT(j)]); sum += c; cnt += (c > 0u) ? 1u : 0u; mine = (j == x) ? c : mine; }
        if (sum == G) break;
        __builtin_amdgcn_s_sleep(1);
        if ((++sp & 255u) == 0u) { if (xb_ld(&bar[XB_TMO])) break; if (sp > XB_SPIN_CAP) { atomicAdd(&bar[XB_TMO], 1u); break; } }
    }
    nloc = mine > 0u ? mine : 1u; nx = cnt > 0u ? cnt : 1u;
}
__device__ __forceinline__ void xcd_barrier(const XcdBarrier& b) {
    asm volatile("s_waitcnt vmcnt(0)" ::: "memory");
    __syncthreads();
    if (threadIdx.x == 0) {
        unsigned* bar = b.bar;
        __builtin_amdgcn_s_waitcnt(0);
        unsigned nloc = b.st[0], nx = b.st[1];
        if (nloc == 0u) { xcd_barrier_complete(bar, b.x, nloc, nx); b.st[0] = nloc; b.st[1] = nx; }
        const unsigned old = xb_add(&bar[XB_XSUB(b.x)], 1u);
        const unsigned gen = old / nloc;
        if (old + 1u == (gen + 1u) * nloc) {
            __builtin_amdgcn_fence(__ATOMIC_RELEASE, "agent");
            asm volatile("s_waitcnt vmcnt(0)" ::: "memory");
            const unsigned og = xb_add(&bar[XB_TOP], 1u);
            const unsigned tg = og / nx;
            if (og + 1u == (tg + 1u) * nx) xb_add(&bar[XB_TOPGEN], 1u);
            else XB_SPIN(xb_ld(&bar[XB_TOPGEN]) == tg, bar);
            __builtin_amdgcn_fence(__ATOMIC_ACQUIRE, "agent");
            xb_add(&bar[XB_XGEN(b.x)], 1u);
            asm volatile("s_waitcnt vmcnt(0)" ::: "memory");
        } else {
            XB_SPIN(xb_ld(&bar[XB_XGEN(b.x)]) == gen, bar);
            __builtin_amdgcn_fence(__ATOMIC_ACQUIRE, "agent");
            asm volatile("s_waitcnt vmcnt(0)" ::: "memory");
        }
    }
    __syncthreads();
}

template <bool PERMQK>
__device__ __forceinline__ void transpose_item(const float* W, int K, int N, bf16_t* WT, LAS float* scr, int item, int lane) {
    const int nblk = N / 32, kb = item / nblk, nb = item % nblk, k0 = 64 * kb, n0 = 32 * nb;
#pragma unroll 8
    for (int i = 0; i < 32; ++i) { const int kk = 2 * i + (lane >> 5); scr[kk * 33 + (lane & 31)] = W[(size_t)(k0 + kk) * N + n0 + (lane & 31)]; }
    asm volatile("s_waitcnt lgkmcnt(0)" ::: "memory");
    const int c = lane & 7;
#pragma unroll
    for (int j = 0; j < 4; ++j) { const int n = (lane >> 3) + 8 * j; const LAS float* s = scr + (8 * c) * 33 + n;
        u32x4 o; o.x = pk2(s[0 * 33], s[1 * 33]); o.y = pk2(s[2 * 33], s[3 * 33]); o.z = pk2(s[4 * 33], s[5 * 33]); o.w = pk2(s[6 * 33], s[7 * 33]);
        int nt = n0 + n;
        if (PERMQK && nt < K_LO + 512) {
            const int d = nt & 127, a = d >> 6, nn = (d >> 5) & 1, b = (d >> 4) & 1, fq = (d >> 2) & 3, e = d & 3;
            nt = (nt & ~127) + 32 * (2 * a + b) + 8 * fq + 4 * nn + e; }
        *(u32x4*)(WT + (size_t)nt * K + k0 + 8 * c) = o; }
    asm volatile("s_waitcnt lgkmcnt(0)" ::: "memory");
}

__device__ __forceinline__ void norm_mod_row(const float* xrow, const float* g, const float* sc, const float* sh, bf16_t* orow, int lane) {
    const f32x4* xr = (const f32x4*)xrow + lane;
    f32x4 v[16]; float s = 0.f;
#pragma unroll
    for (int j = 0; j < 16; ++j) { v[j] = xr[64 * j]; s += (v[j].x * v[j].x + v[j].y * v[j].y) + (v[j].z * v[j].z + v[j].w * v[j].w); }
    const float rstd = 1.0f / sqrtf(wave_sum(s) * (1.0f / DM) + EPS);
    u32x2* o8 = (u32x2*)orow + lane;
#pragma unroll
    for (int j = 0; j < 16; ++j) { const f32x4 gg = ((const f32x4*)g)[lane + 64 * j], ss = ((const f32x4*)sc)[lane + 64 * j], hh = ((const f32x4*)sh)[lane + 64 * j];
        const f32x4 y = (v[j] * rstd) * gg * (ss + 1.0f) + hh; o8[64 * j] = pg8::pack4(y); }
}
__device__ __forceinline__ void norm_final_row(const float* xrow, const float* g, float* orow, int lane) {
    const f32x4* xr = (const f32x4*)xrow + lane;
    f32x4 v[16]; float s = 0.f;
#pragma unroll
    for (int j = 0; j < 16; ++j) { v[j] = xr[64 * j]; s += (v[j].x * v[j].x + v[j].y * v[j].y) + (v[j].z * v[j].z + v[j].w * v[j].w); }
    const float rstd = 1.0f / sqrtf(wave_sum(s) * (1.0f / DM) + EPS);
    f32x4* o = (f32x4*)orow + lane;
#pragma unroll
    for (int j = 0; j < 16; ++j) { const f32x4 gg = ((const f32x4*)g)[lane + 64 * j]; o[64 * j] = (v[j] * rstd) * gg; }
}
__device__ __forceinline__ void mixnorm_row(bf16_t* row, const float* ga, const float* gf, int lane) {
    u32x4* p = (u32x4*)row + lane;
    u32x4 w[8]; float sa = 0.f, sf = 0.f;
#pragma unroll
    for (int i = 0; i < 8; ++i) { w[i] = p[64 * i];
        float s = 0.f;
#pragma unroll
        for (int e = 0; e < 4; ++e) { const float lo = __builtin_bit_cast(float, w[i][e] << 16), hi = __builtin_bit_cast(float, w[i][e] & 0xffff0000u); s += lo * lo + hi * hi; }
        if (i < 4) sa += s; else sf += s; }
    const float ra = 1.0f / sqrtf(wave_sum(sa) * (1.0f / QW) + EPS), rf = 1.0f / sqrtf(wave_sum(sf) * (1.0f / FW) + EPS);
#pragma unroll
    for (int i = 0; i < 8; ++i) { const float rs = i < 4 ? ra : rf; const float* g = (i < 4 ? ga + 512 * i : gf + 512 * (i - 4)) + 8 * lane;
        const f32x4 g0 = *(const f32x4*)g, g1 = *(const f32x4*)(g + 4);
        u32x4 o;
#pragma unroll
        for (int e = 0; e < 4; ++e) { const float lo = __builtin_bit_cast(float, w[i][e] << 16), hi = __builtin_bit_cast(float, w[i][e] & 0xffff0000u);
            const float glo = e < 2 ? g0[2 * e] : g1[2 * e - 4], ghi = e < 2 ? g0[2 * e + 1] : g1[2 * e - 3];
            o[e] = cvt_pk_bf16(lo * rs * glo, hi * rs * ghi); }
        p[64 * i] = o; }
}

struct Args {
    const float* x; const float* c; const float* ctx; const float* c_ctx; const float* ada_a; const float* ada_b; const float* ada_bias; const float* g_mix;
    const float* w_in; const float* sink; const float* w_f; const float* g_attn; const float* g_four; const float* w_out; const float* g_mlp; const float* w1; const float* w2; const float* g_final;
    float* out; unsigned char* ws; int ph_lo, ph_hi;
};
constexpr int NPH_PRO = 2, NPH_LAYER = 10, NPH = NPH_PRO + DEPTH * NPH_LAYER + 1;

__global__ void __launch_bounds__(NWAVES * 64, 2) fwd_kernel(Args args) {
    extern __shared__ __attribute__((aligned(16))) unsigned char lds_raw[];
    LAS unsigned char* lds = (LAS unsigned char*)lds_raw;
    const int G = gridDim.x, bx = blockIdx.x, NGW = G * NWAVES;
#define LANEVARS int tid = threadIdx.x; asm volatile("" : "+v"(tid)); const int lane = tid & 63, wave = __builtin_amdgcn_readfirstlane(tid >> 6), gw = bx * NWAVES + wave; (void)lane; (void)gw;
    unsigned char* ws = args.ws;
    unsigned* ctl = (unsigned*)(ws + WS_CTL);
    float* MOD = (float*)(ws + WS_MOD); float* TPART = (float*)(ws + WS_TPART);
    float* COS = (float*)(ws + WS_ROPE); float* SIN = COS + 256 * 32;
    f32x2* TW = (f32x2*)(ws + WS_TW);
    bf16_t* FM1 = (bf16_t*)(ws + WS_FM1); bf16_t* FM2 = (bf16_t*)(ws + WS_FM2); bf16_t* FC = (bf16_t*)(ws + WS_FC); bf16_t* CS = (bf16_t*)(ws + WS_CS);
    bf16_t* WFRAW = (bf16_t*)(ws + WS_WFRAW); bf16_t* WFT = (bf16_t*)(ws + WS_WFT);
    bf16_t* WIN = (bf16_t*)(ws + WS_WIN); bf16_t* WOUT = (bf16_t*)(ws + WS_WOUT); bf16_t* W1T = (bf16_t*)(ws + WS_W1); bf16_t* W2T = (bf16_t*)(ws + WS_W2);
    float* XW = (float*)(ws + WS_XW); bf16_t* HX = (bf16_t*)(ws + WS_HX); bf16_t* PX = (bf16_t*)(ws + WS_PX); bf16_t* MIX = (bf16_t*)(ws + WS_MIX);
    bf16_t* ZT2 = (bf16_t*)(ws + WS_ZT2); bf16_t* Y2 = (bf16_t*)(ws + WS_Y2); bf16_t* ZTC = (bf16_t*)(ws + WS_ZTC); bf16_t* HB = (bf16_t*)(ws + WS_H);

    for (int u = threadIdx.x; u < (LDS_BYTES - LDSCTL_OFF) / 4; u += NWAVES * 64) ((LAS unsigned*)(lds + LDSCTL_OFF))[u] = 0u;
    __syncthreads();
#if MK_PER_PHASE
#define GRID_BAR() do { } while (0)
#else
    XcdBarrier bar = xcd_barrier_post(ctl + CW_BAR, (volatile LAS unsigned*)(lds + MISC_OFF) + 8);
#define GRID_BAR() xcd_barrier(bar)
#endif
    const int lo = args.ph_lo, hi = args.ph_hi;
#ifndef SITEMASK
#define SITEMASK 0xFFFF
#endif
#define EN(s) (((SITEMASK) >> (s)) & 1)
#define IN(k) (lo <= (k) && (k) < hi)
#define SEAM(k) do { if (IN(k) && IN((k) + 1)) GRID_BAR(); } while (0)

    if (EN(0) && IN(0)) {
        LANEVARS
        LAS float* scr = (LAS float*)(lds + wave * 16384);
        constexpr int I_IN = (DM / 64) * (INW / 32), I_OUT = (DM / 64) * (DM / 32), I_1 = (DM / 64) * (DFF / 32), I_2 = (DFF / 64) * (DM / 32), I_F = (512 / 64) * (512 / 32);
        constexpr int PER_L = I_IN + I_OUT + I_1 + I_2 + 4 * I_F, NITEMS = DEPTH * PER_L;
        for (int it = gw; it < NITEMS; it += NGW) {
            const int l = it / PER_L; int r = it - l * PER_L;
            if (r < I_IN) { transpose_item<true>(args.w_in + (size_t)l * DM * INW, DM, INW, WIN + (size_t)l * INW * DM, scr, r, lane); continue; } r -= I_IN;
            if (r < I_OUT) { transpose_item<false>(args.w_out + (size_t)l * DM * DM, DM, DM, WOUT + (size_t)l * DM * DM, scr, r, lane); continue; } r -= I_OUT;
            if (r < I_1) { transpose_item<false>(args.w1 + (size_t)l * DM * DFF, DM, DFF, W1T + (size_t)l * DFF * DM, scr, r, lane); continue; } r -= I_1;
            if (r < I_2) { transpose_item<false>(args.w2 + (size_t)l * DFF * DM, DFF, DM, W2T + (size_t)l * DM * DFF, scr, r, lane); continue; } r -= I_2;
            const int gq = r / I_F; r -= gq * I_F;
            transpose_item<false>(args.w_f + (size_t)(l * 4 + gq) * 512 * 512, 512, 512, WFRAW + (size_t)(l * 4 + gq) * 512 * 512, scr, r, lane);
        }
        __syncthreads();
        for (int it = bx; it < DEPTH * 16 * 4; it += G) {
            const int l = it >> 6, rc = (it >> 2) & 15, dp = it & 3, rr = tid & 31, dg = tid >> 5;
            float s0 = 0.f, s1 = 0.f;
            const float* ap = args.ada_a + (size_t)l * DM * ARANK + rc * 32 + rr;
            for (int i = 0; i < 64; ++i) { const int d = dp * 1024 + dg + 16 * i; const float av = ap[(size_t)d * ARANK];
                const float c0 = args.c[d], c1 = args.c_ctx[d];
                s0 += (c0 / (1.0f + __expf(-c0))) * av; s1 += (c1 / (1.0f + __expf(-c1))) * av; }
            LAS float* red = (LAS float*)lds;
            red[(dg * 32 + rr) * 2 + 0] = s0; red[(dg * 32 + rr) * 2 + 1] = s1;
            __syncthreads();
            if (tid < 64) { const int r2 = tid & 31, v = tid >> 5; float s = 0.f;
                for (int q = 0; q < 16; ++q) s += red[(q * 32 + r2) * 2 + v];
                TPART[((l * 4 + dp) * 2 + v) * ARANK + rc * 32 + r2] = s; }
            __syncthreads();
        }
        const int gt = bx * (NWAVES * 64) + tid, NT = G * NWAVES * 64;
        for (int i = gt; i < 256 * 32; i += NT) { const int pos = i >> 5, j = i & 31;
            const float inv = __builtin_amdgcn_exp2f(-(float)j * (13.287712379549449f / 32.0f));
            const float rev = (float)pos * inv * 0.15915494309189535f;
            COS[i] = cos_rev(rev); SIN[i] = sin_rev(rev); }
        for (int i = gt; i < 16384; i += NT) { const float rev = (float)i * (1.0f / 16384.0f); TW[i] = (f32x2){cos_rev(rev), sin_rev(rev)}; }
        for (int i = gt; i < 256 * 256; i += NT) { const int m = i >> 8, k = i & 255, ro = m >> 7, kk = m & 127, ri = k >> 7, ll = k & 127;
            const float rev = (float)((kk * ll) & 127) * (1.0f / 128.0f); const float cv = cos_rev(rev) * 0.08838834764831845f, sv = sin_rev(rev) * 0.08838834764831845f;
            FM1[i] = (bf16_t)f2bf(ro == 0 ? (ri == 0 ? cv : sv) : (ri == 0 ? -sv : cv));
            FM2[i] = (bf16_t)f2bf(ro == 0 ? (ri == 0 ? cv : sv) : 0.f); }
        for (int i = gt; i < 256 * 512; i += NT) { const int k = i >> 9, q = i & 511, ri = q >> 8, ll = q & 255;
            const float rev = (float)((k * ll) & 255) * (1.0f / 256.0f);
            FC[i] = (bf16_t)f2bf((ri == 0 ? cos_rev(rev) : sin_rev(rev)) * 0.0625f); }
        for (int i = gt; i < 1024 * 512; i += NT) { const int n = i >> 9, m = i & 511, ri = n >> 9, cch = n & 511;
            const float rev = (float)((cch * m) & 511) * (1.0f / 512.0f);
            CS[i] = (bf16_t)f2bf((ri == 0 ? cos_rev(rev) : -sin_rev(rev)) * 0.04419417382415922f); }
    }
    SEAM(0);
    if (EN(1) && IN(1)) {
        LANEVARS
        for (int it = bx; it < DEPTH * 96; it += G) {
            const int l = it / 96, jc = it - l * 96;
            LAS float* tl = (LAS float*)lds;
            LAS float* red = tl + 1024;
            for (int q = tid; q < 1024; q += NWAVES * 64) { const int v = q >> 9, r = q & 511; float s = 0.f;
                for (int dp = 0; dp < 4; ++dp) s += TPART[((l * 4 + dp) * 2 + v) * ARANK + r];
                tl[q] = s; }
            __syncthreads();
            const int th = tid >> 8, jj = tid & 255, j = jc * 256 + jj;
            const float* bp = args.ada_b + (size_t)l * ARANK * (NMOD * DM) + j;
            float s0 = 0.f, s1 = 0.f;
#pragma unroll 8
            for (int r = th * 256; r < th * 256 + 256; ++r) { const float bv = bp[(size_t)r * (NMOD * DM)]; s0 += tl[r] * bv; s1 += tl[512 + r] * bv; }
            red[(th * 256 + jj) * 2 + 0] = s0; red[(th * 256 + jj) * 2 + 1] = s1;
            __syncthreads();
            if (tid < 256) { const float bias = args.ada_bias[(size_t)l * (NMOD * DM) + j];
                MOD[(size_t)(l * 2 + 0) * (NMOD * DM) + j] = bias + red[(0 * 256 + jj) * 2 + 0] + red[(1 * 256 + jj) * 2 + 0];
                MOD[(size_t)(l * 2 + 1) * (NMOD * DM) + j] = bias + red[(0 * 256 + jj) * 2 + 1] + red[(1 * 256 + jj) * 2 + 1]; }
            __syncthreads();
        }
        { pg8::Gemm g{512, 1024u, 1024u, (size_t)128 * 1024, (size_t)128 * 1024};
          pg8::SchedWf S{G, bx, (const char*)WFRAW, (const char*)CS}; pg8::EpiWf E{WFT};
          pg8::gemm_phase<pg8::EpiWf, pg8::SchedWf>(lds, g, S, E); }
    }
    SEAM(1);

    for (int l = 0; l < DEPTH; ++l) {
        const int pb = NPH_PRO + l * NPH_LAYER;
        const float* modl = MOD + (size_t)(l * 2 + 0) * (NMOD * DM);
        const float* modc = MOD + (size_t)(l * 2 + 1) * (NMOD * DM);
        const float* xlat = l == 0 ? args.x : XW; const float* xctx = l == 0 ? args.ctx : XW + (size_t)SEQ * DM;
        if (EN(2) && IN(pb + 0)) {
            LANEVARS
            const float* g = args.g_mix + (size_t)l * DM;
            for (int m = gw; m < MT; m += NGW) { const bool isc = m >= SEQ; const float* md = isc ? modc : modl;
                const float* xr = isc ? xctx + (size_t)(m - SEQ) * DM : xlat + (size_t)m * DM;
                norm_mod_row(xr, g, md + 1 * DM, md + 0 * DM, HX + (size_t)m * DM, lane); }
        }
        SEAM(pb + 0);
        if (EN(3) && IN(pb + 1)) {
            pg8::Gemm g{DM, (unsigned)(DM * 2), (unsigned)(DM * 2), (size_t)128 * DM * 2, (size_t)128 * DM * 2};
            pg8::SchedStd S; S.init(MT / 256, INW / 256, G, bx, HX, (size_t)256 * DM * 2, WIN + (size_t)l * INW * DM, (size_t)256 * DM * 2);
            pg8::EpiInproj E{PX, COS, SIN};
            pg8::gemm_phase<pg8::EpiInproj, pg8::SchedStd>(lds, g, S, E);
        }
        SEAM(pb + 1);
        if (EN(4) && IN(pb + 2)) {
            const float* sk = args.sink + l * NHEAD;
            const int nitems = (l == DEPTH - 1) ? 1024 : 1040;
            for (int it = bx; it < nitems; it += G) {
                int qrow0, ntile, w0; const int kvh = (it >> 1) & 3, hp = it & 1;
                if (it < 1024) { const int n = it >> 3; w0 = n == 0 ? 0 : 128 * (n - 1); const int w1 = n == 127 ? SEQ : 128 * (n + 2); qrow0 = 128 * n; ntile = 4 + (w1 - w0) / 64; }
                else { qrow0 = SEQ + 128 * ((it - 1024) >> 3); ntile = 4; w0 = 0; }
                att::attn_item((LAS char*)lds, PX, MIX, sk, qrow0, kvh, hp, ntile, w0);
            }
            { pg8::Gemm g{512, 2048u, (unsigned)(128 * INW * 2), (size_t)128 * 2048, (size_t)INW * 2};
              pg8::SchedGa S{G, bx, (const char*)(WFT + (size_t)l * 4 * 512 * 1024), (const char*)(PX + F_LO)}; pg8::EpiGa E{ZT2};
              pg8::gemm_phase<pg8::EpiGa, pg8::SchedGa>(lds, g, S, E); }
            if (l != DEPTH - 1) {
              pg8::Gemm g{512, 2048u, (unsigned)(INW * 2), (size_t)128 * 2048, (size_t)128 * INW * 2};
              pg8::SchedGaCtx S{G, bx, (const char*)(WFT + (size_t)l * 4 * 512 * 1024), (const char*)(PX + F_LO)}; pg8::EpiGaCtx E{ZTC};
              pg8::gemm_phase<pg8::EpiGaCtx, pg8::SchedGaCtx>(lds, g, S, E); }
        }
        SEAM(pb + 2);
        if (EN(5) && IN(pb + 3)) {
            { pg8::Gemm g{256, 512u, 512u, (size_t)128 * 512, (size_t)128 * 512};
              pg8::SchedN S{G, bx, 1024, (const char*)FM1, (const char*)ZT2, (size_t)256 * 512}; pg8::EpiGb E{Y2, TW};
              pg8::gemm_phase<pg8::EpiGb, pg8::SchedN>(lds, g, S, E); }
            if (l != DEPTH - 1) {
              pg8::Gemm g{512, 1024u, 1024u, (size_t)128 * 1024, (size_t)128 * 1024};
              pg8::SchedN S{G, bx, 8, (const char*)FC, (const char*)ZTC, (size_t)256 * 1024}; pg8::EpiGctx E{MIX};
              pg8::gemm_phase<pg8::EpiGctx, pg8::SchedN>(lds, g, S, E); }
        }
        SEAM(pb + 3);
        if (EN(6) && IN(pb + 4)) {
            pg8::Gemm g{256, 512u, 512u, (size_t)128 * 512, (size_t)128 * 512};
            pg8::SchedN S{G, bx, 1024, (const char*)FM2, (const char*)Y2, (size_t)256 * 512}; pg8::EpiGc E{MIX};
            pg8::gemm_phase<pg8::EpiGc, pg8::SchedN>(lds, g, S, E);
        }
        SEAM(pb + 4);
        if (EN(7) && IN(pb + 5)) {
            LANEVARS
            const int nrows = (l == DEPTH - 1) ? SEQ : MT;
            for (int m = gw; m < nrows; m += NGW) mixnorm_row(MIX + (size_t)m * DM, args.g_attn + (size_t)l * QW, args.g_four + (size_t)l * FW, lane);
        }
        SEAM(pb + 5);
        if (EN(8) && IN(pb + 6)) {
            pg8::Gemm g{DM, (unsigned)(DM * 2), (unsigned)(DM * 2), (size_t)128 * DM * 2, (size_t)128 * DM * 2};
            pg8::SchedStd S; S.init((l == DEPTH - 1) ? SEQ / 256 : MT / 256, DM / 256, G, bx, MIX, (size_t)256 * DM * 2, WOUT + (size_t)l * DM * DM, (size_t)256 * DM * 2);
            pg8::EpiResid E{xlat, xctx, XW, modl + 2 * DM, modc + 2 * DM};
            pg8::gemm_phase<pg8::EpiResid, pg8::SchedStd>(lds, g, S, E);
        }
        SEAM(pb + 6);
        if (EN(9) && IN(pb + 7)) {
            LANEVARS
            const float* g = args.g_mlp + (size_t)l * DM;
            const int nrows = (l == DEPTH - 1) ? SEQ : MT;
            for (int m = gw; m < nrows; m += NGW) { const float* md = m >= SEQ ? modc : modl;
                norm_mod_row(XW + (size_t)m * DM, g, md + 4 * DM, md + 3 * DM, HX + (size_t)m * DM, lane); }
        }
        SEAM(pb + 7);
        if (EN(10) && IN(pb + 8)) {
            pg8::Gemm g{DM, (unsigned)(DM * 2), (unsigned)(DM * 2), (size_t)128 * DM * 2, (size_t)128 * DM * 2};
            pg8::SchedStd S; S.init((l == DEPTH - 1) ? SEQ / 256 : MT / 256, DFF / 256, G, bx, HX, (size_t)256 * DM * 2, W1T + (size_t)l * DFF * DM, (size_t)256 * DM * 2);
            pg8::EpiRelu2 E{HB};
            pg8::gemm_phase<pg8::EpiRelu2, pg8::SchedStd>(lds, g, S, E);
        }
        SEAM(pb + 8);
        if (EN(11) && IN(pb + 9)) {
            pg8::Gemm g{DFF, (unsigned)(DFF * 2), (unsigned)(DFF * 2), (size_t)128 * DFF * 2, (size_t)128 * DFF * 2};
            pg8::SchedStd S; S.init((l == DEPTH - 1) ? SEQ / 256 : MT / 256, DM / 256, G, bx, HB, (size_t)256 * DFF * 2, W2T + (size_t)l * DM * DFF, (size_t)256 * DFF * 2);
            pg8::EpiResid E{XW, XW + (size_t)SEQ * DM, XW, modl + 5 * DM, modc + 5 * DM};
            pg8::gemm_phase<pg8::EpiResid, pg8::SchedStd>(lds, g, S, E);
        }
        SEAM(pb + 9);
    }
    if (EN(12) && IN(NPH - 1)) {
        LANEVARS
        for (int m = gw; m < SEQ; m += NGW) norm_final_row(XW + (size_t)m * DM, args.g_final, args.out + (size_t)m * DM, lane);
    }
#undef IN
#undef SEAM
#undef GRID_BAR
}

extern "C" void kernel_launch(void* const* d_in, const int* in_sizes, int n_in, void* d_out, int out_size, void* d_ws, size_t ws_size, hipStream_t stream) {
    static int grid = 0;
    if (grid == 0) {
        if (n_in != 18 || out_size != SEQ * DM || ws_size < WS_END) { fprintf(stderr, "kernel_launch: unexpected shapes: n_in %d out %d ws %zu (need %zu)\n", n_in, out_size, ws_size, (size_t)WS_END); grid = -1; return; }
        int dev = 0, cus = 0, per_cu = 0;
        if (hipGetDevice(&dev) != hipSuccess || hipDeviceGetAttribute(&cus, hipDeviceAttributeMultiprocessorCount, dev) != hipSuccess) { grid = -1; return; }
        if (hipFuncSetAttribute((const void*)fwd_kernel, hipFuncAttributeMaxDynamicSharedMemorySize, LDS_BYTES) != hipSuccess) { fprintf(stderr, "kernel_launch: hipFuncSetAttribute failed\n"); grid = -1; return; }
        if (hipOccupancyMaxActiveBlocksPerMultiprocessor(&per_cu, (const void*)fwd_kernel, NWAVES * 64, LDS_BYTES) != hipSuccess || per_cu < 1) { fprintf(stderr, "kernel_launch: occupancy query says %d\n", per_cu); }
        (void)hipGetLastError();
        grid = cus;
    }
    if (grid < 0) return;
    (void)hipMemsetAsync((char*)d_ws + WS_CTL, 0, CTL_ZERO_BYTES, stream);
    Args a{};
    a.x = (const float*)d_in[0]; a.c = (const float*)d_in[1]; a.ctx = (const float*)d_in[2]; a.c_ctx = (const float*)d_in[3];
    a.ada_a = (const float*)d_in[4]; a.ada_b = (const float*)d_in[5]; a.ada_bias = (const float*)d_in[6]; a.g_mix = (const float*)d_in[7];
    a.w_in = (const float*)d_in[8]; a.sink = (const float*)d_in[9]; a.w_f = (const float*)d_in[10]; a.g_attn = (const float*)d_in[11];
    a.g_four = (const float*)d_in[12]; a.w_out = (const float*)d_in[13]; a.g_mlp = (const float*)d_in[14]; a.w1 = (const float*)d_in[15];
    a.w2 = (const float*)d_in[16]; a.g_final = (const float*)d_in[17];
    a.out = (float*)d_out; a.ws = (unsigned char*)d_ws;
#if MK_PER_PHASE
    for (int p = 0; p < NPH; ++p) { a.ph_lo = p; a.ph_hi = p + 1; hipLaunchKernelGGL(fwd_kernel, dim3(grid), dim3(NWAVES * 64), LDS_BYTES, stream, a); }
#else
    a.ph_lo = 0; a.ph_hi = NPH;
    hipLaunchKernelGGL(fwd_kernel, dim3(grid), dim3(NWAVES * 64), LDS_BYTES, stream, a);
#endif
    const hipError_t le = hipPeekAtLastError();
    if (le != hipSuccess) fprintf(stderr, "kernel_launch: launch failed: %s\n", hipGetErrorName(le));
}
```

```cpp
#include <hip/hip_runtime.h>
#include <cstdio>
#include <cstdint>

#ifndef MK_PER_PHASE
#define MK_PER_PHASE 0
#endif

#define LAS __attribute__((address_space(3)))
typedef unsigned short bf16_t;
typedef short bf16x8 __attribute__((ext_vector_type(8)));
typedef short s16x4 __attribute__((ext_vector_type(4)));
typedef float f32x2 __attribute__((ext_vector_type(2)));
typedef float f32x4 __attribute__((ext_vector_type(4)));
typedef float f32x16 __attribute__((ext_vector_type(16)));
typedef unsigned u32x2 __attribute__((ext_vector_type(2)));
typedef unsigned u32x4 __attribute__((ext_vector_type(4)));

constexpr int DM = 4096, SEQ = 16384, CTX = 256, MT = SEQ + CTX, DEPTH = 4;
constexpr int NHEAD = 16, NKVH = 4, HD = 128, QW = 2048, FW = 2048, INW = 5120, DFF = 16384, ARANK = 512, NMOD = 6;
constexpr int K_LO = 2048, V_LO = 2560, F_LO = 3072;
constexpr float EPS = 1e-6f;

constexpr size_t MiB = 1u << 20;
constexpr size_t WS_CTL = 0, CTL_ZERO_BYTES = 1 * MiB;
constexpr size_t WS_MOD = 1 * MiB;
constexpr size_t WS_TPART = 2 * MiB;
constexpr size_t WS_ROPE = 2 * MiB + 256 * 1024;
constexpr size_t WS_TW = 2 * MiB + 512 * 1024;
constexpr size_t WS_FM1 = 3 * MiB, WS_FM2 = 3 * MiB + 128 * 1024, WS_FC = 3 * MiB + 256 * 1024, WS_CS = 3 * MiB + 512 * 1024;
constexpr size_t WS_WFRAW = 5 * MiB;
constexpr size_t WS_WFT = 13 * MiB;
constexpr size_t WS_WIN = 32 * MiB;
constexpr size_t WS_WOUT = 192 * MiB;
constexpr size_t WS_W1 = 320 * MiB;
constexpr size_t WS_W2 = 832 * MiB;
constexpr size_t WS_XW = 1344 * MiB;
constexpr size_t WS_HX = 1604 * MiB;
constexpr size_t WS_PX = 1734 * MiB;
constexpr size_t WS_MIX = 1897 * MiB;
constexpr size_t WS_ZT2 = 2027 * MiB;
constexpr size_t WS_Y2 = 2155 * MiB;
constexpr size_t WS_ZTC = 2283 * MiB;
constexpr size_t WS_H = 2285 * MiB;
constexpr size_t WS_SLAB = 2805 * MiB;
constexpr size_t WS_END = 2873 * MiB;
static_assert(WS_XW + (size_t)MT * DM * 4 <= WS_HX && WS_HX + (size_t)MT * DM * 2 <= WS_PX && WS_PX + (size_t)MT * INW * 2 <= WS_MIX && WS_MIX + (size_t)MT * DM * 2 <= WS_ZT2 && WS_H + (size_t)MT * DFF * 2 <= WS_SLAB, "ws map");

constexpr int CW_BAR = 4096;

constexpr int RING_BYTES = 131072, LDSCTL_OFF = RING_BYTES, MISC_OFF = LDSCTL_OFF + 320, LDS_BYTES = 147456;
constexpr int NWAVES = 8;

__device__ __forceinline__ unsigned cvt_pk_bf16(float lo, float hi) { unsigned r; asm volatile("v_cvt_pk_bf16_f32 %0, %1, %2" : "=v"(r) : "v"(lo), "v"(hi)); return r; }
__device__ __forceinline__ unsigned f2bf(float f) { unsigned u = __builtin_bit_cast(unsigned, f); return (u + 0x7fffu + ((u >> 16) & 1u)) >> 16; }
__device__ __forceinline__ unsigned pk2(float lo, float hi) { return f2bf(lo) | (f2bf(hi) << 16); }
__device__ __forceinline__ float bf2f(unsigned short b) { return __builtin_bit_cast(float, ((unsigned)b) << 16); }
__device__ __forceinline__ float wave_sum(float v) {
#pragma unroll
    for (int o = 1; o < 64; o <<= 1) v += __shfl_xor(v, o);
    return v;
}
__device__ __forceinline__ float cos_rev(float x) { return __builtin_amdgcn_cosf(x); }
__device__ __forceinline__ float sin_rev(float x) { return __builtin_amdgcn_sinf(x); }

namespace pg8 {
constexpr int BM = 256, BK = 64, HALF = 128, HTB = HALF * BK * 2, STAGE_BYTES = 8 * HTB, NXCD = 8, WGM = 8;
__host__ __device__ __forceinline__ int lds_byte(int r, int c) { const int st = (r >> 4) * 2 + (c >> 5), rr = r & 15, cc = c & 31, ob = rr * 64 + cc * 2; return st * 1024 + (ob ^ (((ob >> 9) & 1) << 5)); }
__host__ __device__ __forceinline__ void stage_rc(int b, int& R, int& C) { const int st = b / 1024, sb = b % 1024, swz = sb ^ (((sb >> 9) & 1) << 5); R = (st >> 1) * 16 + swz / 64; C = (st & 1) * 32 + (swz % 64) / 2; }
__host__ __device__ __forceinline__ int perm32(int rho) { const int n = rho >> 4, i = rho & 15; return 8 * (i >> 2) + 4 * n + (i & 3); }

struct Unit { int pm, pn, g; };
struct Gemm { int K; unsigned rsA, rsB; size_t hsA, hsB; };

template <class Epi, class Sched>
__device__ __forceinline__ void gemm_phase(LAS unsigned char* lds, const Gemm g, const Sched& S, const Epi& E) {
    int tid = threadIdx.x; asm volatile("" : "+v"(tid));
    const int wid = __builtin_amdgcn_readfirstlane(tid >> 6), lane = tid & 63, wr = wid >> 2, wc = wid & 3, fr = lane & 15, fq = lane >> 4;
    const int K = g.K, nt = K / BK;
    unsigned voffA[2], voffB[2];
#pragma unroll
    for (int i = 0; i < 2; ++i) { int R, C; stage_rc(tid * 16 + i * 8192, R, C); const int Rb = Epi::PERM ? ((R & ~31) + perm32(R & 31)) : R;
        voffA[i] = (unsigned)R * g.rsA + (unsigned)C * 2u; voffB[i] = (unsigned)Rb * g.rsB + (unsigned)C * 2u; }
    const size_t kstep = (size_t)(BK * 2);
    const size_t hA = g.hsA, hB = g.hsB;
    const unsigned ldsw = (unsigned)wid * 1024u;
    const int aoff = lds_byte(wr * 64 + fr, fq * 8), boff = lds_byte(wc * 32 + fr, fq * 8);
#define PG8_SA(b, h) (((b) * 2 + (h)) * HTB)
#define PG8_SB(b, h) ((4 + (b) * 2 + (h)) * HTB)
#define PG8_STAGE(bufoff, gbase, voff) do { _Pragma("unroll") for (int _i = 0; _i < 2; ++_i) \
        __builtin_amdgcn_global_load_lds((const unsigned*)((const char*)(gbase) + (voff)[_i]), (LAS unsigned*)(lds + (bufoff) + ldsw + _i * 8192), 16, 0, 0); } while (0)
#define PG8_LDA(dst, b, h) do { _Pragma("unroll") for (int m = 0; m < 4; ++m) _Pragma("unroll") for (int k = 0; k < 2; ++k) dst[m][k] = *(const LAS bf16x8*)(lds + PG8_SA(b, h) + aoff + m * 2048 + k * 1024); } while (0)
#define PG8_LDB(dst, b, h) do { _Pragma("unroll") for (int n = 0; n < 2; ++n) _Pragma("unroll") for (int k = 0; k < 2; ++k) dst[n][k] = *(const LAS bf16x8*)(lds + PG8_SB(b, h) + boff + n * 2048 + k * 1024); } while (0)
#define PG8_MMA(ai, bj, At, Bt) do { __builtin_amdgcn_s_setprio(1); _Pragma("unroll") for (int m = 0; m < 4; ++m) _Pragma("unroll") for (int n = 0; n < 2; ++n) _Pragma("unroll") for (int k = 0; k < 2; ++k) \
        acc[ai][bj][m][n] = __builtin_amdgcn_mfma_f32_16x16x32_bf16(Bt[n][k], At[m][k], acc[ai][bj][m][n], 0, 0, 0); __builtin_amdgcn_s_setprio(0); } while (0)
#define PG8_WAIT_V(n) asm volatile("s_waitcnt vmcnt(" #n ")" ::: "memory")
#define PG8_WAIT_L(n) asm volatile("s_waitcnt lgkmcnt(" #n ")" ::: "memory")
#define PG8_BAR __builtin_amdgcn_s_barrier()
#define PG8_SCHED __builtin_amdgcn_sched_barrier(0)
    Unit cur, nxt; int ui = 0;
    if (!S.next(0, cur)) return;
    f32x4 acc[2][2][4][2];
#pragma unroll
    for (int a = 0; a < 2; ++a)
#pragma unroll
        for (int b = 0; b < 2; ++b)
#pragma unroll
            for (int m = 0; m < 4; ++m)
#pragma unroll
                for (int n = 0; n < 2; ++n) acc[a][b][m][n] = (f32x4){0.f, 0.f, 0.f, 0.f};
    bf16x8 At[4][2], B0[2][2], B1[2][2];
    const char* cA = S.abase(cur); const char* cB = S.bbase(cur);
    PG8_STAGE(PG8_SB(0, 0), cB, voffB); PG8_STAGE(PG8_SB(0, 1), cB + hB, voffB); PG8_STAGE(PG8_SA(0, 0), cA, voffA); PG8_STAGE(PG8_SA(0, 1), cA + hA, voffA);
    if (wr == 1) PG8_BAR;
    PG8_WAIT_V(2); PG8_BAR;
    PG8_STAGE(PG8_SB(1, 0), cB + kstep, voffB); PG8_STAGE(PG8_SA(1, 0), cA + kstep, voffA); PG8_STAGE(PG8_SB(1, 1), cB + hB + kstep, voffB);
    PG8_WAIT_V(6); PG8_BAR;
    for (;;) {
        const bool has_next = S.next(ui + 1, nxt);
        const char* nA = has_next ? S.abase(nxt) : cA; const char* nB = has_next ? S.bbase(nxt) : cB;
#pragma nounroll
        for (int t = 0; t < nt; t += 2) {
            const bool last = (t == nt - 2);
            const char* a1 = cA + (size_t)(t + 1) * kstep;
            const char* a2 = last ? nA : cA + (size_t)(t + 2) * kstep; const char* b2 = last ? nB : cB + (size_t)(t + 2) * kstep;
            const char* a3 = a2 + kstep; const char* b3 = b2 + kstep;
            PG8_LDB(B0, 0, 0); PG8_LDB(B1, 0, 1); PG8_SCHED; PG8_LDA(At, 0, 0); PG8_STAGE(PG8_SA(1, 1), a1 + hA, voffA);
            PG8_WAIT_V(8); PG8_WAIT_L(0); PG8_BAR; PG8_MMA(0, 0, At, B0); PG8_MMA(0, 1, At, B1); PG8_BAR; PG8_SCHED;
            PG8_LDA(At, 0, 1); PG8_STAGE(PG8_SB(0, 0), b2, voffB); PG8_STAGE(PG8_SB(0, 1), b2 + hB, voffB); PG8_STAGE(PG8_SA(0, 0), a2, voffA);
            PG8_WAIT_V(8); PG8_WAIT_L(0); PG8_BAR; PG8_MMA(1, 0, At, B0); PG8_MMA(1, 1, At, B1); PG8_BAR; PG8_SCHED;
            PG8_LDB(B0, 1, 0); PG8_LDB(B1, 1, 1); PG8_SCHED; PG8_LDA(At, 1, 0); PG8_STAGE(PG8_SA(0, 1), a2 + hA, voffA);
            PG8_WAIT_V(8); PG8_WAIT_L(0); PG8_BAR; PG8_MMA(0, 0, At, B0); PG8_MMA(0, 1, At, B1); PG8_BAR; PG8_SCHED;
            PG8_LDA(At, 1, 1); PG8_STAGE(PG8_SB(1, 0), b3, voffB); PG8_STAGE(PG8_SB(1, 1), b3 + hB, voffB); PG8_STAGE(PG8_SA(1, 0), a3, voffA);
            PG8_WAIT_V(8); PG8_WAIT_L(0); PG8_BAR; PG8_MMA(1, 0, At, B0); PG8_MMA(1, 1, At, B1); PG8_BAR; PG8_SCHED;
        }
        if (wr == 0) PG8_BAR;
        { int efr = fr, efq = fq; asm volatile("" : "+v"(efr), "+v"(efq));
          E(acc, cur, wr, wc, efr, efq); }
        if (!has_next) break;
#pragma unroll
        for (int a = 0; a < 2; ++a)
#pragma unroll
            for (int b = 0; b < 2; ++b)
#pragma unroll
                for (int m = 0; m < 4; ++m)
#pragma unroll
                    for (int n = 0; n < 2; ++n) acc[a][b][m][n] = (f32x4){0.f, 0.f, 0.f, 0.f};
        cur = nxt; cA = nA; cB = nB; ++ui;
        if (wr == 1) PG8_BAR;
    }
    PG8_WAIT_V(0);
    PG8_BAR;
#undef PG8_SA
#undef PG8_SB
#undef PG8_STAGE
#undef PG8_LDA
#undef PG8_LDB
#undef PG8_MMA
#undef PG8_WAIT_V
#undef PG8_WAIT_L
#undef PG8_BAR
#undef PG8_SCHED
}

struct SchedStd {
    int nM, nN, nwg, G, c; const char* A; const char* B; size_t tsA, tsB;
    __device__ __forceinline__ void init(int nM_, int nN_, int G_, int c_, const void* A_, size_t tsA_, const void* B_, size_t tsB_) { nM = nM_; nN = nN_; nwg = nM * nN; G = G_; c = c_; A = (const char*)A_; B = (const char*)B_; tsA = tsA_; tsB = tsB_; }
    __device__ __forceinline__ bool next(int i, Unit& u) const {
        const long L = (long)i * G + c; if (L >= nwg) return false;
        int wgid = (int)L; { const int q = nwg / NXCD, r = nwg % NXCD, xcd = wgid % NXCD, off = wgid / NXCD; wgid = (xcd < r ? xcd * (q + 1) : r * (q + 1) + (xcd - r) * q) + off; }
        const int nig = WGM * nN, gid = wgid / nig, fm = gid * WGM, gsz = (nM - fm) < WGM ? (nM - fm) : WGM;
        u.pm = fm + ((wgid % nig) % gsz); u.pn = (wgid % nig) / gsz; u.g = 0; return true;
    }
    __device__ __forceinline__ const char* abase(const Unit& u) const { return A + (size_t)u.pm * tsA; }
    __device__ __forceinline__ const char* bbase(const Unit& u) const { return B + (size_t)u.pn * tsB; }
};
struct SchedGa {
    int G, c; const char* WfT; const char* PXf;
    __device__ __forceinline__ bool next(int i, Unit& u) const { const int L = i * G + c; if (L >= 1024) return false; u.pn = L >> 4; u.g = (L >> 2) & 3; u.pm = L & 3; return true; }
    __device__ __forceinline__ const char* abase(const Unit& u) const { return WfT + (size_t)u.g * (512 * 1024 * 2) + ((size_t)(u.pm & 1) * 256 * 1024 + (size_t)(u.pm >> 1) * 512) * 2; }
    __device__ __forceinline__ const char* bbase(const Unit& u) const { return PXf + ((size_t)(2 * u.pn) * INW + 512 * u.g) * 2; }
};
struct SchedGaCtx {
    int G, c; const char* WfT; const char* PXf;
    __device__ __forceinline__ bool next(int i, Unit& u) const { const int L = i * G + c; if (L >= 16) return false; u.pn = 0; u.g = L >> 2; u.pm = L & 3; return true; }
    __device__ __forceinline__ const char* abase(const Unit& u) const { return WfT + (size_t)u.g * (512 * 1024 * 2) + ((size_t)(u.pm & 1) * 256 * 1024 + (size_t)(u.pm >> 1) * 512) * 2; }
    __device__ __forceinline__ const char* bbase(const Unit& u) const { return PXf + ((size_t)SEQ * INW + 512 * u.g) * 2; }
};
struct SchedN {
    int G, c, ntile; const char* A; const char* B; size_t tsB;
    __device__ __forceinline__ bool next(int i, Unit& u) const { const int L = i * G + c; if (L >= ntile) return false; u.pn = L; u.pm = 0; u.g = 0; return true; }
    __device__ __forceinline__ const char* abase(const Unit&) const { return A; }
    __device__ __forceinline__ const char* bbase(const Unit& u) const { return B + (size_t)u.pn * tsB; }
};
struct SchedWf {
    int G, c; const char* WfRaw; const char* CS;
    __device__ __forceinline__ bool next(int i, Unit& u) const { const int L = i * G + c; if (L >= 128) return false; u.g = L >> 3; u.pm = (L >> 2) & 1; u.pn = L & 3; return true; }
    __device__ __forceinline__ const char* abase(const Unit& u) const { return WfRaw + (size_t)u.g * (512 * 512 * 2) + (size_t)u.pm * 256 * 1024; }
    __device__ __forceinline__ const char* bbase(const Unit& u) const { return CS + (size_t)u.pn * 256 * 1024; }
};

#define ACC_T const f32x4 (&acc)[2][2][4][2]
__device__ __forceinline__ u32x4 pack8(const f32x4 a, const f32x4 b) { u32x4 w; w.x = cvt_pk_bf16(a[0], a[1]); w.y = cvt_pk_bf16(a[2], a[3]); w.z = cvt_pk_bf16(b[0], b[1]); w.w = cvt_pk_bf16(b[2], b[3]); return w; }
__device__ __forceinline__ u32x2 pack4(const f32x4 a) { u32x2 w; w.x = cvt_pk_bf16(a[0], a[1]); w.y = cvt_pk_bf16(a[2], a[3]); return w; }

struct EpiInproj {
    static constexpr bool PERM = true;
    bf16_t* PX; const float* COS; const float* SIN;
    __device__ __forceinline__ void operator()(ACC_T, const Unit& u, int wr, int wc, int fr, int fq) const {
        const int row0 = u.pm * BM + wr * 64 + fr;
        if (u.pn < 10) {
            const int a = wc >> 1, b = wc & 1, jj = 16 * b + 4 * fq, dcol = 64 * a + jj;
            const bool rot = u.pm < 64;
#pragma unroll
            for (int ai = 0; ai < 2; ++ai)
#pragma unroll
                for (int m = 0; m < 4; ++m) {
                    const int row = row0 + ai * HALF + m * 16; const int pos = a ? (row & 63) : ((row >> 6) & 255);
                    f32x4 cs = (f32x4){1.f, 1.f, 1.f, 1.f}, sn = (f32x4){0.f, 0.f, 0.f, 0.f};
                    if (rot) { cs = *(const f32x4*)(COS + pos * 32 + jj); sn = *(const f32x4*)(SIN + pos * 32 + jj); }
                    bf16_t* rowp = PX + (size_t)row * INW + u.pn * BM + dcol;
#pragma unroll
                    for (int bj = 0; bj < 2; ++bj) { const f32x4 x1 = acc[ai][bj][m][0], x2 = acc[ai][bj][m][1];
                        const f32x4 o1 = x1 * cs - x2 * sn, o2 = x2 * cs + x1 * sn;
                        *(u32x2*)(rowp + bj * HALF) = pack4(o1); *(u32x2*)(rowp + bj * HALF + 32) = pack4(o2); }
                }
        } else {
            const int col0 = u.pn * BM + wc * 32 + 8 * fq;
#pragma unroll
            for (int ai = 0; ai < 2; ++ai)
#pragma unroll
                for (int m = 0; m < 4; ++m) { bf16_t* rowp = PX + (size_t)(row0 + ai * HALF + m * 16) * INW + col0;
#pragma unroll
                    for (int bj = 0; bj < 2; ++bj) *(u32x4*)(rowp + bj * HALF) = pack8(acc[ai][bj][m][0], acc[ai][bj][m][1]); }
        }
    }
};
struct EpiResid {
    static constexpr bool PERM = false;
    const float* base; float* XW; const float* gate;
    __device__ __forceinline__ void operator()(ACC_T, const Unit& u, int wr, int wc, int fr, int fq) const {
        const int row0 = u.pm * BM + wr * 64 + fr, col0 = u.pn * BM + wc * 32 + 4 * fq;
        f32x4 gv[2][2];
#pragma unroll
        for (int bj = 0; bj < 2; ++bj)
#pragma unroll
            for (int n = 0; n < 2; ++n) gv[bj][n] = *(const f32x4*)(gate + col0 + bj * HALF + n * 16);
#pragma unroll
        for (int ai = 0; ai < 2; ++ai)
#pragma unroll
            for (int m = 0; m < 4; ++m) { const size_t off = (size_t)(row0 + ai * HALF + m * 16) * DM + col0;
#pragma unroll
                for (int bj = 0; bj < 2; ++bj)
#pragma unroll
                    for (int n = 0; n < 2; ++n) { const f32x4 bs = *(const f32x4*)(base + off + bj * HALF + n * 16);
                        *(f32x4*)(XW + off + bj * HALF + n * 16) = bs + gv[bj][n] * acc[ai][bj][m][n]; } }
    }
};
struct EpiRelu2 {
    static constexpr bool PERM = true;
    bf16_t* H;
    __device__ __forceinline__ void operator()(ACC_T, const Unit& u, int wr, int wc, int fr, int fq) const {
        const int row0 = u.pm * BM + wr * 64 + fr, col0 = u.pn * BM + wc * 32 + 8 * fq;
#pragma unroll
        for (int ai = 0; ai < 2; ++ai)
#pragma unroll
            for (int m = 0; m < 4; ++m) { bf16_t* rowp = H + (size_t)(row0 + ai * HALF + m * 16) * DFF + col0;
#pragma unroll
                for (int bj = 0; bj < 2; ++bj) { f32x4 v0 = acc[ai][bj][m][0], v1 = acc[ai][bj][m][1];
#pragma unroll
                    for (int e = 0; e < 4; ++e) { const float a0 = fmaxf(v0[e], 0.f), a1 = fmaxf(v1[e], 0.f); v0[e] = a0 * a0; v1[e] = a1 * a1; }
                    *(u32x4*)(rowp + bj * HALF) = pack8(v0, v1); } }
    }
};
struct EpiWf {
    static constexpr bool PERM = true;
    bf16_t* WfT;
    __device__ __forceinline__ void operator()(ACC_T, const Unit& u, int wr, int wc, int fr, int fq) const {
        const int row0 = u.pm * BM + wr * 64 + fr, col0 = u.pn * BM + wc * 32 + 8 * fq;
        bf16_t* base = WfT + (size_t)u.g * (512 * 1024);
#pragma unroll
        for (int ai = 0; ai < 2; ++ai)
#pragma unroll
            for (int m = 0; m < 4; ++m) { bf16_t* rowp = base + (size_t)(row0 + ai * HALF + m * 16) * 1024 + col0;
#pragma unroll
                for (int bj = 0; bj < 2; ++bj) *(u32x4*)(rowp + bj * HALF) = pack8(acc[ai][bj][m][0], acc[ai][bj][m][1]); }
    }
};
struct EpiGa {
    static constexpr bool PERM = true;
    bf16_t* ZT2;
    __device__ __forceinline__ void operator()(ACC_T, const Unit& u, int wr, int wc, int fr, int fq) const {
        const int reim = u.pm >> 1, d0 = (u.pm & 1) * 256 + wr * 64 + fr, l1 = wc * 32 + 8 * fq;
#pragma unroll
        for (int ai = 0; ai < 2; ++ai)
#pragma unroll
            for (int m = 0; m < 4; ++m) { const int j = u.g * 512 + d0 + ai * HALF + m * 16;
#pragma unroll
                for (int bj = 0; bj < 2; ++bj) { const int l2 = 2 * u.pn + bj;
                    *(u32x4*)(ZT2 + ((size_t)(j * 128 + l2) * 256 + reim * 128 + l1)) = pack8(acc[ai][bj][m][0], acc[ai][bj][m][1]); } }
    }
};
struct EpiGaCtx {
    static constexpr bool PERM = true;
    bf16_t* ZTc;
    __device__ __forceinline__ void operator()(ACC_T, const Unit& u, int wr, int wc, int fr, int fq) const {
        const int reim = u.pm >> 1, d0 = (u.pm & 1) * 256 + wr * 64 + fr, l0 = wc * 32 + 8 * fq;
#pragma unroll
        for (int ai = 0; ai < 2; ++ai)
#pragma unroll
            for (int m = 0; m < 4; ++m) { const int j = u.g * 512 + d0 + ai * HALF + m * 16;
#pragma unroll
                for (int bj = 0; bj < 2; ++bj)
                    *(u32x4*)(ZTc + ((size_t)j * 512 + reim * 256 + bj * HALF + l0)) = pack8(acc[ai][bj][m][0], acc[ai][bj][m][1]); }
    }
};
struct EpiGb {
    static constexpr bool PERM = true;
    bf16_t* Y2; const f32x2* TW;
    __device__ __forceinline__ void operator()(ACC_T, const Unit& u, int wr, int wc, int fr, int fq) const {
        const int l2b = wc * 32 + 8 * fq;
#pragma unroll
        for (int m = 0; m < 4; ++m) { const int k1 = wr * 64 + m * 16 + fr;
            f32x2 t[8];
#pragma unroll
            for (int e = 0; e < 8; ++e) t[e] = TW[(unsigned)(k1 * (l2b + e))];
#pragma unroll
            for (int bj = 0; bj < 2; ++bj) { const int j = 2 * u.pn + bj;
                f32x4 r0, r1, i0, i1;
#pragma unroll
                for (int e = 0; e < 4; ++e) {
                    const float yr0 = acc[0][bj][m][0][e], yi0 = acc[1][bj][m][0][e], yr1 = acc[0][bj][m][1][e], yi1 = acc[1][bj][m][1][e];
                    r0[e] = yr0 * t[e].x + yi0 * t[e].y; i0[e] = yi0 * t[e].x - yr0 * t[e].y;
                    r1[e] = yr1 * t[4 + e].x + yi1 * t[4 + e].y; i1[e] = yi1 * t[4 + e].x - yr1 * t[4 + e].y; }
                bf16_t* p = Y2 + ((size_t)(k1 * 2048 + j) * 256 + l2b);
                *(u32x4*)p = pack8(r0, r1); *(u32x4*)(p + 128) = pack8(i0, i1); }
            asm volatile("" ::: "memory"); }
    }
};
struct EpiGc {
    static constexpr bool PERM = true;
    bf16_t* MIX;
    __device__ __forceinline__ void operator()(ACC_T, const Unit& u, int wr, int wc, int fr, int fq) const {
        const int k1 = u.pn >> 3, j0 = (u.pn & 7) * 256 + wc * 32 + 8 * fq;
#pragma unroll
        for (int m = 0; m < 4; ++m) { const int k2 = wr * 64 + m * 16 + fr; const int pos = k1 + 128 * k2;
#pragma unroll
            for (int bj = 0; bj < 2; ++bj) *(u32x4*)(MIX + (size_t)pos * DM + QW + j0 + bj * HALF) = pack8(acc[0][bj][m][0], acc[0][bj][m][1]); }
    }
};
struct EpiGctx {
    static constexpr bool PERM = true;
    bf16_t* MIX;
    __device__ __forceinline__ void operator()(ACC_T, const Unit& u, int wr, int wc, int fr, int fq) const {
        const int j0 = u.pn * 256 + wc * 32 + 8 * fq;
#pragma unroll
        for (int ai = 0; ai < 2; ++ai)
#pragma unroll
            for (int m = 0; m < 4; ++m) { const int k = ai * HALF + wr * 64 + m * 16 + fr;
#pragma unroll
                for (int bj = 0; bj < 2; ++bj) *(u32x4*)(MIX + (size_t)(SEQ + k) * DM + QW + j0 + bj * HALF) = pack8(acc[ai][bj][m][0], acc[ai][bj][m][1]); }
    }
};

struct SchedPiece {
    int G, c, npiece, nks, pn0; const char* A; const char* B; size_t tsB, kbytes;
    __device__ __forceinline__ bool next(int i, Unit& u) const { const int L = i * G + c; if (L >= npiece) return false; u.pn = pn0 + L / nks; u.g = L % nks; u.pm = 0; return true; }
    __device__ __forceinline__ const char* abase(const Unit& u) const { return A + (size_t)u.g * kbytes; }
    __device__ __forceinline__ const char* bbase(const Unit& u) const { return B + (size_t)u.pn * tsB + (size_t)u.g * kbytes; }
};
struct EpiSlab {
    static constexpr bool PERM = false;
    float* SLAB; int ldn;
    __device__ __forceinline__ void operator()(ACC_T, const Unit& u, int wr, int wc, int fr, int fq) const {
        const int row0 = wr * 64 + fr, col0 = u.pn * BM + wc * 32 + 4 * fq;
        float* base = SLAB + (size_t)u.g * 256 * ldn;
#pragma unroll
        for (int ai = 0; ai < 2; ++ai)
#pragma unroll
            for (int m = 0; m < 4; ++m) { float* rowp = base + (size_t)(row0 + ai * HALF + m * 16) * ldn + col0;
#pragma unroll
                for (int bj = 0; bj < 2; ++bj)
#pragma unroll
                    for (int n = 0; n < 2; ++n) *(f32x4*)(rowp + bj * HALF + n * 16) = acc[ai][bj][m][n]; }
    }
};
#undef ACC_T
}

namespace att {
constexpr float SCALE = 0.08838834764831845f;
constexpr float THR = 0.f;
constexpr int SHM_K = 16384, SHM_V = 16384, OFF_V = 0, OFF_K = 2 * SHM_V, OFF_WS = 2 * SHM_V + 2 * SHM_K;
#define KSWZ(row, colB) ((row) * 256 + ((colB) ^ (((row) & 7) << 4)))
#define SBAR() __builtin_amdgcn_sched_barrier(0)
__device__ __forceinline__ int v_st(int k, int c) { const int kk = (k & ~0xC) | ((k & 4) << 1) | ((k & 8) >> 1); return ((kk >> 3) * 4 + (c >> 5)) * 512 + ((kk & 7) * 32 + (c & 31)) * 2; }
__device__ __forceinline__ int v_rd_base(int lane) { return ((lane & 3) << 3) | (((lane >> 2) & 3) << 6) | (((lane >> 4) & 1) << 5) | (((lane >> 5) & 1) << 8); }
constexpr int v_rd_off(int d0, int ks, int half) { return d0 * 512 + ks * 4096 + half * 2048; }
__device__ __forceinline__ int crow(int r, int hi) { return (r & 3) + 8 * (r >> 2) + 4 * hi; }
__device__ __forceinline__ unsigned cvtpk(float lo, float hi) { unsigned r; asm volatile("v_cvt_pk_bf16_f32 %0, %1, %2" : "=v"(r) : "v"(lo), "v"(hi)); return r; }
__device__ __forceinline__ void mask_tile(f32x16& p0, f32x16& p1, int dq, unsigned W) {
    const float NEG = -__builtin_inff();
#pragma unroll
    for (int r = 0; r < 16; ++r) {
        const int c = (r & 3) + 8 * (r >> 2);
        if ((unsigned)(dq - c) >= W) p0[r] = NEG;
        if ((unsigned)(dq - c - 32) >= W) p1[r] = NEG;
    }
}
__device__ __forceinline__ void partialSM(f32x16& p0, f32x16& p1, float& m_reg, float& mn, float& alpha) {
    float pmax = p0[0];
#pragma unroll
    for (int r = 1; r < 16; ++r) pmax = fmaxf(pmax, p0[r]);
#pragma unroll
    for (int r = 0; r < 16; ++r) pmax = fmaxf(pmax, p1[r]);
    { auto rr = __builtin_amdgcn_permlane32_swap(__float_as_uint(pmax), __float_as_uint(pmax), false, false);
      pmax = fmaxf(__uint_as_float(rr[0]), __uint_as_float(rr[1])); }
    constexpr float C2 = 1.4426950408889634f * SCALE;
    if (__all((pmax - m_reg) * SCALE <= THR)) { mn = m_reg; alpha = 1.f; }
    else { mn = fmaxf(m_reg, pmax); alpha = __builtin_amdgcn_exp2f((m_reg - mn) * C2); m_reg = mn; }
    const float mnL = -mn * C2;
#pragma unroll
    for (int r = 0; r < 16; ++r) p0[r] = fmaf(p0[r], C2, mnL);
#pragma unroll
    for (int r = 0; r < 16; ++r) p1[r] = fmaf(p1[r], C2, mnL);
#pragma unroll
    for (int r = 0; r < 16; ++r) p0[r] = __builtin_amdgcn_exp2f(p0[r]);
}
__device__ __forceinline__ void finishSM(f32x16& p0, f32x16& p1, float alpha, float& l_reg, bf16x8& pa0, bf16x8& pa1, bf16x8& pa2, bf16x8& pa3) {
#pragma unroll
    for (int r = 0; r < 16; ++r) p1[r] = __builtin_amdgcn_exp2f(p1[r]);
    float ps = 0;
#pragma unroll
    for (int r = 0; r < 16; ++r) ps += p0[r];
#pragma unroll
    for (int r = 0; r < 16; ++r) ps += p1[r];
    { auto rr = __builtin_amdgcn_permlane32_swap(__float_as_uint(ps), __float_as_uint(ps), false, false);
      ps = __uint_as_float(rr[0]) + __uint_as_float(rr[1]); }
    l_reg = l_reg * alpha + ps;
#define PK4(P, B_, OUT) do { unsigned a0 = cvtpk(P[B_+0], P[B_+1]), a1 = cvtpk(P[B_+2], P[B_+3]);                          \
        unsigned b0 = cvtpk(P[B_+4], P[B_+5]), b1 = cvtpk(P[B_+6], P[B_+7]);                                             \
        auto r0 = __builtin_amdgcn_permlane32_swap(a0, b0, false, false); auto r1 = __builtin_amdgcn_permlane32_swap(a1, b1, false, false); \
        u32x4 w = {r0[0], r1[0], r0[1], r1[1]}; OUT = __builtin_bit_cast(bf16x8, w); } while (0)
    PK4(p0, 0, pa0); PK4(p0, 8, pa1); PK4(p1, 0, pa2); PK4(p1, 8, pa3);
#undef PK4
}
template <int KB>
__device__ __forceinline__ void qkt(f32x16& p0, f32x16& p1, const LAS char* K_lds, int r32, int hi, const bf16x8* qr) {
    p0 = f32x16{}; p1 = f32x16{};
    const LAS char* kb[4];
#pragma unroll
    for (int dd = 0; dd < 4; ++dd) kb[dd] = K_lds + KB * SHM_K + KSWZ(r32, (dd * 16 + hi * 8) * 2);
#pragma unroll
    for (int d0 = 0; d0 < 8; ++d0) { const LAS char* a = kb[d0 & 3] + (d0 >> 2) * 128;
        bf16x8 b0 = *(const LAS bf16x8*)(a);
        bf16x8 b1 = *(const LAS bf16x8*)(a + 32 * 256);
        p0 = __builtin_amdgcn_mfma_f32_32x32x16_bf16(b0, qr[d0], p0, 0, 0, 0);
        p1 = __builtin_amdgcn_mfma_f32_32x32x16_bf16(b1, qr[d0], p1, 0, 0, 0); }
}
template <int VB>
__device__ __forceinline__ void pv_tile(f32x16* o, int vb0, bf16x8 pa0, bf16x8 pa1, bf16x8 pa2, bf16x8 pa3) {
#define TRRD(dst, off) asm volatile("ds_read_b64_tr_b16 %0, %1 offset:%2" : "=&v"(dst) : "v"(vb0), "i"(off) : "memory")
#define PV_D0(d0) do { s16x4 l0, l1, l2, l3, h0, h1, h2, h3; constexpr int b_ = VB * SHM_V + v_rd_off(d0, 0, 0); \
        TRRD(l0, b_); TRRD(h0, b_ + 2048); TRRD(l1, b_ + 4096); TRRD(h1, b_ + 6144); TRRD(l2, b_ + 8192); TRRD(h2, b_ + 10240); TRRD(l3, b_ + 12288); TRRD(h3, b_ + 14336); \
        asm volatile("s_waitcnt lgkmcnt(0)" ::: "memory"); SBAR();   \
        o[d0] = __builtin_amdgcn_mfma_f32_32x32x16_bf16(pa0, (bf16x8){l0[0], l0[1], l0[2], l0[3], h0[0], h0[1], h0[2], h0[3]}, o[d0], 0, 0, 0);   \
        o[d0] = __builtin_amdgcn_mfma_f32_32x32x16_bf16(pa1, (bf16x8){l1[0], l1[1], l1[2], l1[3], h1[0], h1[1], h1[2], h1[3]}, o[d0], 0, 0, 0);   \
        o[d0] = __builtin_amdgcn_mfma_f32_32x32x16_bf16(pa2, (bf16x8){l2[0], l2[1], l2[2], l2[3], h2[0], h2[1], h2[2], h2[3]}, o[d0], 0, 0, 0);   \
        o[d0] = __builtin_amdgcn_mfma_f32_32x32x16_bf16(pa3, (bf16x8){l3[0], l3[1], l3[2], l3[3], h3[0], h3[1], h3[2], h3[3]}, o[d0], 0, 0, 0); } while (0)
    PV_D0(0); PV_D0(1); PV_D0(2); PV_D0(3);
#undef PV_D0
#undef TRRD
}

__device__ __forceinline__ void attn_item(LAS char* lds, const bf16_t* PX, bf16_t* MIX, const float* sink, int qrow0, int kvh, int hp, int nt, int wstart) {
    int tid = threadIdx.x; asm volatile("" : "+v"(tid));
    const int wid = __builtin_amdgcn_readfirstlane(tid >> 6), lane = tid & 63, r32 = lane & 31, hi = lane >> 5;
    const int hq = 4 * kvh + 2 * hp + (wid >> 2);
    const int qw0 = qrow0 + 32 * (wid & 3), qrow = qw0 + r32;
    LAS char* V_lds = lds + OFF_V; LAS char* K_lds = lds + OFF_K;
    LAS float* ws = (LAS float*)(lds + OFF_WS) + wid * 64; LAS float* li_l = ws; LAS float* al_l = ws + 32;
    bf16x8 qr[8];
    { const bf16_t* qp = PX + (size_t)qrow * INW + hq * HD + hi * 8;
#pragma unroll
      for (int d0 = 0; d0 < 8; ++d0) qr[d0] = *(const bf16x8*)(qp + d0 * 16); }
    const int sr = tid >> 4, sc = (tid & 15) * 8, vst0 = v_st(sr, sc), vst1 = v_st(32 + sr, sc), kws = KSWZ(sr, sc * 2);
    const int vb0 = (int)(unsigned)(size_t)V_lds + v_rd_base(lane);
    const bf16_t* Kg = PX + K_LO + kvh * HD + sc; const bf16_t* Vg = PX + V_LO + kvh * HD + sc;
    float m_reg = sink[hq] * (1.0f / SCALE), l_reg = 1.f; f32x16 o[4] = {};
    bf16x8 st_k0, st_k1, st_v0, st_v1;
#define TROW(t_) ((t_) < 4 ? SEQ + 64 * (t_) : wstart + 64 * ((t_) - 4))
#define LOADT(t_) do { const size_t rb_ = (size_t)(TROW(t_) + sr); st_k0 = *(const bf16x8*)(Kg + rb_ * INW); st_k1 = *(const bf16x8*)(Kg + (rb_ + 32) * INW); \
                       st_v0 = *(const bf16x8*)(Vg + rb_ * INW); st_v1 = *(const bf16x8*)(Vg + (rb_ + 32) * INW); } while (0)
#define WRITET(b_) do { *(LAS bf16x8*)(K_lds + (b_) * SHM_K + kws) = st_k0; *(LAS bf16x8*)(K_lds + (b_) * SHM_K + kws + 32 * 256) = st_k1; \
                        *(LAS bf16x8*)(V_lds + (b_) * SHM_V + vst0) = st_v0; *(LAS bf16x8*)(V_lds + (b_) * SHM_V + vst1) = st_v1; } while (0)
#define RESC(a) do { if (__any((a) < 1.f)) { if (hi == 0) al_l[r32] = (a); asm volatile("s_waitcnt lgkmcnt(0)" ::: "memory"); \
        _Pragma("unroll") for (int d_ = 0; d_ < 4; ++d_) _Pragma("unroll") for (int r = 0; r < 16; ++r) o[d_][r] *= al_l[crow(r, hi)]; } } while (0)
#define STEP(B_, t_) do { const int tt_ = (t_); f32x16 p0, p1; float mn, alpha; bf16x8 pa0, pa1, pa2, pa3; \
        if (tt_ + 1 < nt) LOADT(tt_ + 1); \
        SBAR(); qkt<B_>(p0, p1, K_lds, r32, hi, qr); \
        if (tt_ >= 4) mask_tile(p0, p1, qrow + 128 - TROW(tt_) - 4 * hi, 257u); \
        partialSM(p0, p1, m_reg, mn, alpha); RESC(alpha); \
        finishSM(p0, p1, alpha, l_reg, pa0, pa1, pa2, pa3); SBAR(); \
        pv_tile<B_>(o, vb0, pa0, pa1, pa2, pa3); \
        if (tt_ + 1 < nt) WRITET((B_) ^ 1); \
        __syncthreads(); } while (0)
    LOADT(0); WRITET(0); __syncthreads();
    for (int t = 0; t < nt; t += 2) { STEP(0, t); STEP(1, t + 1); }
    if (hi == 0) li_l[r32] = l_reg;
    asm volatile("s_waitcnt lgkmcnt(0)" ::: "memory");
    float rli[16];
#pragma unroll
    for (int r = 0; r < 16; ++r) rli[r] = 1.0f / li_l[crow(r, hi)];
    bf16_t* Ow = MIX + (size_t)qw0 * DM + hq * HD;
#pragma unroll
    for (int r = 0; r < 16; ++r) { const int orow = crow(r, hi);
#pragma unroll
        for (int d0 = 0; d0 < 4; ++d0) { const float v = o[d0][r] * rli[r]; const float vn = __shfl_xor(v, 1);
            if ((r32 & 1) == 0) *(unsigned*)(Ow + (size_t)orow * DM + d0 * 32 + r32) = cvtpk(v, vn); } }
    __syncthreads();
#undef TROW
#undef LOADT
#undef WRITET
#undef RESC
#undef STEP
}
}

#define XB_TMO      128
#define XB_XCNT(j)  (256  + 64 * (j))
#define XB_XSUB(j)  (1280 + 64 * (j))
#define XB_XGEN(j)  (2304 + 64 * (j))
#define XB_TOP      3328
#define XB_TOPGEN   3392
#define XCD_BAR_WORDS 3456
#define XB_SPIN_CAP (1u << 22)
__device__ __forceinline__ unsigned xb_ld(unsigned* p)              { return __hip_atomic_load(p, __ATOMIC_RELAXED, __HIP_MEMORY_SCOPE_AGENT); }
__device__ __forceinline__ unsigned xb_add(unsigned* p, unsigned v) { return __hip_atomic_fetch_add(p, v, __ATOMIC_RELAXED, __HIP_MEMORY_SCOPE_AGENT); }
__device__ __forceinline__ unsigned xb_xcc_id() { return (unsigned)__builtin_amdgcn_s_getreg((3 << 11) | 20) & 0xFu; }
#define XB_SPIN(cond, bar) do { unsigned _sp = 0; while (cond) { __builtin_amdgcn_s_sleep(1); \
    if ((++_sp & 255u) == 0u) { if (xb_ld(&(bar)[XB_TMO])) break; if (_sp > XB_SPIN_CAP) { atomicAdd(&(bar)[XB_TMO], 1u); break; } } } } while (0)
struct XcdBarrier { unsigned* bar; unsigned x; volatile LAS unsigned* st; };
__device__ __forceinline__ XcdBarrier xcd_barrier_post(unsigned* bar, volatile LAS unsigned* st) {
    XcdBarrier b; b.bar = bar; b.x = xb_xcc_id(); b.st = st;
    if (threadIdx.x == 0) (void)xb_add(&bar[XB_XCNT(b.x)], 1u);
    return b;
}
__device__ __forceinline__ void xcd_barrier_complete(unsigned* bar, unsigned x, unsigned& nloc, unsigned& nx) {
    const unsigned G = gridDim.x * gridDim.y * gridDim.z;
    unsigned sum, cnt, mine, sp = 0u;
    for (;;) {
        sum = 0u; cnt = 0u; mine = 0u;
#pragma unroll
        for (unsigned j = 0; j < 16; ++j) { const unsigned c = xb_ld(&bar[XB_XCNT(j)]); sum += c; cnt += (c > 0u) ? 1u : 0u; mine = (j == x) ? c : mine; }
        if (sum == G) break;
        __builtin_amdgcn_s_sleep(1);
        if ((++sp & 255u) == 0u) { if (xb_ld(&bar[XB_TMO])) break; if (sp > XB_SPIN_CAP) { atomicAdd(&bar[XB_TMO], 1u); break; } }
    }
    nloc = mine > 0u ? mine : 1u; nx = cnt > 0u ? cnt : 1u;
}
__device__ __forceinline__ void xcd_barrier(const XcdBarrier& b) {
    asm volatile("s_waitcnt vmcnt(0)" ::: "memory");
    __syncthreads();
    if (threadIdx.x == 0) {
        unsigned* bar = b.bar;
        __builtin_amdgcn_s_waitcnt(0);
        unsigned nloc = b.st[0], nx = b.st[1];
        if (nloc == 0u) { xcd_barrier_complete(bar, b.x, nloc, nx); b.st[0] = nloc; b.st[1] = nx; }
        const unsigned old = xb_add(&bar[XB_XSUB(b.x)], 1u);
        const unsigned gen = old / nloc;
        if (old + 1u == (gen + 1u) * nloc) {
            __builtin_amdgcn_fence(__ATOMIC_RELEASE, "agent");
            asm volatile("s_waitcnt vmcnt(0)" ::: "memory");
            const unsigned og = xb_add(&bar[XB_TOP], 1u);
            const unsigned tg = og / nx;
            if (og + 1u == (tg + 1u) * nx) xb_add(&bar[XB_TOPGEN], 1u);
            else XB_SPIN(xb_ld(&bar[XB_TOPGEN]) == tg, bar);
            __builtin_amdgcn_fence(__ATOMIC_ACQUIRE, "agent");
            xb_add(&bar[XB_XGEN(b.x)], 1u);
            asm volatile("s_waitcnt vmcnt(0)" ::: "memory");
        } else {
            XB_SPIN(xb_ld(&bar[XB_XGEN(b.x)]) == gen, bar);
            __builtin_amdgcn_fence(__ATOMIC_ACQUIRE, "agent");
            asm volatile("s_waitcnt vmcnt(0)" ::: "memory");
        }
    }
    __syncthreads();
}

template <bool PERMQK>
__device__ __forceinline__ void transpose_item(const float* W, int K, int N, bf16_t* WT, LAS float* scr, int item, int lane) {
    const int nblk = N / 32, kb = item / nblk, nb = item % nblk, k0 = 64 * kb, n0 = 32 * nb;
#pragma unroll 8
    for (int i = 0; i < 32; ++i) { const int kk = 2 * i + (lane >> 5); scr[kk * 33 + (lane & 31)] = W[(size_t)(k0 + kk) * N + n0 + (lane & 31)]; }
    asm volatile("s_waitcnt lgkmcnt(0)" ::: "memory");
    const int c = lane & 7;
#pragma unroll
    for (int j = 0; j < 4; ++j) { const int n = (lane >> 3) + 8 * j; const LAS float* s = scr + (8 * c) * 33 + n;
        u32x4 o; o.x = pk2(s[0 * 33], s[1 * 33]); o.y = pk2(s[2 * 33], s[3 * 33]); o.z = pk2(s[4 * 33], s[5 * 33]); o.w = pk2(s[6 * 33], s[7 * 33]);
        int nt = n0 + n;
        if (PERMQK && nt < K_LO + 512) {
            const int d = nt & 127, a = d >> 6, nn = (d >> 5) & 1, b = (d >> 4) & 1, fq = (d >> 2) & 3, e = d & 3;
            nt = (nt & ~127) + 32 * (2 * a + b) + 8 * fq + 4 * nn + e; }
        *(u32x4*)(WT + (size_t)nt * K + k0 + 8 * c) = o; }
    asm volatile("s_waitcnt lgkmcnt(0)" ::: "memory");
}

__device__ __forceinline__ void norm_mod_row(const float* xrow, const float* g, const float* sc, const float* sh, bf16_t* orow, int lane) {
    const f32x4* xr = (const f32x4*)xrow + lane;
    f32x4 v[16]; float s = 0.f;
#pragma unroll
    for (int j = 0; j < 16; ++j) { v[j] = xr[64 * j]; s += (v[j].x * v[j].x + v[j].y * v[j].y) + (v[j].z * v[j].z + v[j].w * v[j].w); }
    const float rstd = 1.0f / sqrtf(wave_sum(s) * (1.0f / DM) + EPS);
    u32x2* o8 = (u32x2*)orow + lane;
#pragma unroll
    for (int j = 0; j < 16; ++j) { const f32x4 gg = ((const f32x4*)g)[lane + 64 * j], ss = ((const f32x4*)sc)[lane + 64 * j], hh = ((const f32x4*)sh)[lane + 64 * j];
        const f32x4 y = (v[j] * rstd) * gg * (ss + 1.0f) + hh; o8[64 * j] = pg8::pack4(y); }
}

template <int NKS>
__device__ __forceinline__ void ctx_fold_norm_row(LAS float* red, const float* xrow, float* xout, const float* slab, size_t kstride, const float* gate,
                                                  const float* g, const float* sc, const float* sh, bf16_t* orow, int lane, int wave) {
    f32x4 v[2]; float s = 0.f;
#pragma unroll
    for (int q = 0; q < 2; ++q) { const int idx = lane + 64 * (2 * wave + q);
        f32x4 a = (f32x4){0.f, 0.f, 0.f, 0.f};
#pragma unroll
        for (int ks = 0; ks < NKS; ++ks) a += ((const f32x4*)(slab + (size_t)ks * kstride))[idx];
        v[q] = ((const f32x4*)xrow)[idx] + ((const f32x4*)gate)[idx] * a;
        ((f32x4*)xout)[idx] = v[q];
        s += (v[q].x * v[q].x + v[q].y * v[q].y) + (v[q].z * v[q].z + v[q].w * v[q].w); }
    s = wave_sum(s);
    if (lane == 0) red[wave] = s;
    __syncthreads();
    float tot = 0.f;
#pragma unroll
    for (int w = 0; w < 8; ++w) tot += red[w];
    const float rstd = 1.0f / sqrtf(tot * (1.0f / DM) + EPS);
#pragma unroll
    for (int q = 0; q < 2; ++q) { const int idx = lane + 64 * (2 * wave + q);
        const f32x4 gg = ((const f32x4*)g)[idx], ss = ((const f32x4*)sc)[idx], hh = ((const f32x4*)sh)[idx];
        const f32x4 y = (v[q] * rstd) * gg * (ss + 1.0f) + hh; ((u32x2*)orow)[idx] = pg8::pack4(y); }
    __syncthreads();
}
__device__ __forceinline__ void norm_final_row(const float* xrow, const float* g, float* orow, int lane) {
    const f32x4* xr = (const f32x4*)xrow + lane;
    f32x4 v[16]; float s = 0.f;
#pragma unroll
    for (int j = 0; j < 16; ++j) { v[j] = xr[64 * j]; s += (v[j].x * v[j].x + v[j].y * v[j].y) + (v[j].z * v[j].z + v[j].w * v[j].w); }
    const float rstd = 1.0f / sqrtf(wave_sum(s) * (1.0f / DM) + EPS);
    f32x4* o = (f32x4*)orow + lane;
#pragma unroll
    for (int j = 0; j < 16; ++j) { const f32x4 gg = ((const f32x4*)g)[lane + 64 * j]; o[64 * j] = (v[j] * rstd) * gg; }
}
__device__ __forceinline__ void mixnorm_row(bf16_t* row, const float* ga, const float* gf, int lane) {
    u32x4* p = (u32x4*)row + lane;
    u32x4 w[8]; float sa = 0.f, sf = 0.f;
#pragma unroll
    for (int i = 0; i < 8; ++i) { w[i] = p[64 * i];
        float s = 0.f;
#pragma unroll
        for (int e = 0; e < 4; ++e) { const float lo = __builtin_bit_cast(float, w[i][e] << 16), hi = __builtin_bit_cast(float, w[i][e] & 0xffff0000u); s += lo * lo + hi * hi; }
        if (i < 4) sa += s; else sf += s; }
    const float ra = 1.0f / sqrtf(wave_sum(sa) * (1.0f / QW) + EPS), rf = 1.0f / sqrtf(wave_sum(sf) * (1.0f / FW) + EPS);
#pragma unroll
    for (int i = 0; i < 8; ++i) { const float rs = i < 4 ? ra : rf; const float* g = (i < 4 ? ga + 512 * i : gf + 512 * (i - 4)) + 8 * lane;
        const f32x4 g0 = *(const f32x4*)g, g1 = *(const f32x4*)(g + 4);
        u32x4 o;
#pragma unroll
        for (int e = 0; e < 4; ++e) { const float lo = __builtin_bit_cast(float, w[i][e] << 16), hi = __builtin_bit_cast(float, w[i][e] & 0xffff0000u);
            const float glo = e < 2 ? g0[2 * e] : g1[2 * e - 4], ghi = e < 2 ? g0[2 * e + 1] : g1[2 * e - 3];
            o[e] = cvt_pk_bf16(lo * rs * glo, hi * rs * ghi); }
        p[64 * i] = o; }
}

struct Args {
    const float* x; const float* c; const float* ctx; const float* c_ctx; const float* ada_a; const float* ada_b; const float* ada_bias; const float* g_mix;
    const float* w_in; const float* sink; const float* w_f; const float* g_attn; const float* g_four; const float* w_out; const float* g_mlp; const float* w1; const float* w2; const float* g_final;
    float* out; unsigned char* ws; int ph_lo, ph_hi;
};
constexpr int NPH_PRO = 2, NPH_LAYER = 12, NPH = NPH_PRO + DEPTH * NPH_LAYER + 1;

__global__ void __launch_bounds__(NWAVES * 64, 2) fwd_kernel(Args args) {
    extern __shared__ __attribute__((aligned(16))) unsigned char lds_raw[];
    LAS unsigned char* lds = (LAS unsigned char*)lds_raw;
    const int G = gridDim.x, bx = blockIdx.x, NGW = G * NWAVES;
#define LANEVARS int tid = threadIdx.x; asm volatile("" : "+v"(tid)); const int lane = tid & 63, wave = __builtin_amdgcn_readfirstlane(tid >> 6), gw = bx * NWAVES + wave; (void)lane; (void)gw;
    unsigned char* ws = args.ws;
    unsigned* ctl = (unsigned*)(ws + WS_CTL);
    float* MOD = (float*)(ws + WS_MOD); float* TPART = (float*)(ws + WS_TPART);
    float* COS = (float*)(ws + WS_ROPE); float* SIN = COS + 256 * 32;
    f32x2* TW = (f32x2*)(ws + WS_TW);
    bf16_t* FM1 = (bf16_t*)(ws + WS_FM1); bf16_t* FM2 = (bf16_t*)(ws + WS_FM2); bf16_t* FC = (bf16_t*)(ws + WS_FC); bf16_t* CS = (bf16_t*)(ws + WS_CS);
    bf16_t* WFRAW = (bf16_t*)(ws + WS_WFRAW); bf16_t* WFT = (bf16_t*)(ws + WS_WFT);
    bf16_t* WIN = (bf16_t*)(ws + WS_WIN); bf16_t* WOUT = (bf16_t*)(ws + WS_WOUT); bf16_t* W1T = (bf16_t*)(ws + WS_W1); bf16_t* W2T = (bf16_t*)(ws + WS_W2);
    float* XW = (float*)(ws + WS_XW); bf16_t* HX = (bf16_t*)(ws + WS_HX); bf16_t* PX = (bf16_t*)(ws + WS_PX); bf16_t* MIX = (bf16_t*)(ws + WS_MIX);
    bf16_t* ZT2 = (bf16_t*)(ws + WS_ZT2); bf16_t* Y2 = (bf16_t*)(ws + WS_Y2); bf16_t* ZTC = (bf16_t*)(ws + WS_ZTC); bf16_t* HB = (bf16_t*)(ws + WS_H);

    for (int u = threadIdx.x; u < (LDS_BYTES - LDSCTL_OFF) / 4; u += NWAVES * 64) ((LAS unsigned*)(lds + LDSCTL_OFF))[u] = 0u;
    __syncthreads();
#if MK_PER_PHASE
#define GRID_BAR() do { } while (0)
#else
    XcdBarrier bar = xcd_barrier_post(ctl + CW_BAR, (volatile LAS unsigned*)(lds + MISC_OFF) + 8);
#define GRID_BAR() xcd_barrier(bar)
#endif
    const int lo = args.ph_lo, hi = args.ph_hi;
#ifndef SITEMASK
#define SITEMASK 0xFFFF
#endif
#define EN(s) (((SITEMASK) >> (s)) & 1)
#ifndef REPMASK
#define REPMASK 0
#endif
#ifndef REPLMIN
#define REPLMIN 0
#endif
#define NREP0(s) ((((REPMASK) >> (s)) & 1) ? 2 : 1)
#define NREP(s) (((((REPMASK) >> (s)) & 1) && l >= REPLMIN) ? 2 : 1)
#define IN(k) (lo <= (k) && (k) < hi)
#define SEAM(k) do { if (IN(k) && IN((k) + 1)) GRID_BAR(); } while (0)

    for (int rep = 0; rep < NREP0(0); ++rep) if (EN(0) && IN(0)) {
        LANEVARS
        LAS float* scr = (LAS float*)(lds + wave * 16384);
        constexpr int I_IN = (DM / 64) * (INW / 32), I_OUT = (DM / 64) * (DM / 32), I_1 = (DM / 64) * (DFF / 32), I_2 = (DFF / 64) * (DM / 32), I_F = (512 / 64) * (512 / 32);
        constexpr int PER_L = I_IN + I_OUT + I_1 + I_2 + 4 * I_F, NITEMS = DEPTH * PER_L;
        for (int it = gw; it < NITEMS; it += NGW) {
            const int l = it / PER_L; int r = it - l * PER_L;
            if (r < I_IN) { transpose_item<true>(args.w_in + (size_t)l * DM * INW, DM, INW, WIN + (size_t)l * INW * DM, scr, r, lane); continue; } r -= I_IN;
            if (r < I_OUT) { transpose_item<false>(args.w_out + (size_t)l * DM * DM, DM, DM, WOUT + (size_t)l * DM * DM, scr, r, lane); continue; } r -= I_OUT;
            if (r < I_1) { transpose_item<false>(args.w1 + (size_t)l * DM * DFF, DM, DFF, W1T + (size_t)l * DFF * DM, scr, r, lane); continue; } r -= I_1;
            if (r < I_2) { transpose_item<false>(args.w2 + (size_t)l * DFF * DM, DFF, DM, W2T + (size_t)l * DM * DFF, scr, r, lane); continue; } r -= I_2;
            const int gq = r / I_F; r -= gq * I_F;
            transpose_item<false>(args.w_f + (size_t)(l * 4 + gq) * 512 * 512, 512, 512, WFRAW + (size_t)(l * 4 + gq) * 512 * 512, scr, r, lane);
        }
        __syncthreads();
        for (int it = bx; it < DEPTH * 16 * 4; it += G) {
            const int l = it >> 6, rc = (it >> 2) & 15, dp = it & 3, rr = tid & 31, dg = tid >> 5;
            float s0 = 0.f, s1 = 0.f;
            const float* ap = args.ada_a + (size_t)l * DM * ARANK + rc * 32 + rr;
            for (int i = 0; i < 64; ++i) { const int d = dp * 1024 + dg + 16 * i; const float av = ap[(size_t)d * ARANK];
                const float c0 = args.c[d], c1 = args.c_ctx[d];
                s0 += (c0 / (1.0f + __expf(-c0))) * av; s1 += (c1 / (1.0f + __expf(-c1))) * av; }
            LAS float* red = (LAS float*)lds;
            red[(dg * 32 + rr) * 2 + 0] = s0; red[(dg * 32 + rr) * 2 + 1] = s1;
            __syncthreads();
            if (tid < 64) { const int r2 = tid & 31, v = tid >> 5; float s = 0.f;
                for (int q = 0; q < 16; ++q) s += red[(q * 32 + r2) * 2 + v];
                TPART[((l * 4 + dp) * 2 + v) * ARANK + rc * 32 + r2] = s; }
            __syncthreads();
        }
        const int gt = bx * (NWAVES * 64) + tid, NT = G * NWAVES * 64;
        for (int i = gt; i < 256 * 32; i += NT) { const int pos = i >> 5, j = i & 31;
            const float inv = __builtin_amdgcn_exp2f(-(float)j * (13.287712379549449f / 32.0f));
            const float rev = (float)pos * inv * 0.15915494309189535f;
            COS[i] = cos_rev(rev); SIN[i] = sin_rev(rev); }
        for (int i = gt; i < 16384; i += NT) { const float rev = (float)i * (1.0f / 16384.0f); TW[i] = (f32x2){cos_rev(rev), sin_rev(rev)}; }
        for (int i = gt; i < 256 * 256; i += NT) { const int m = i >> 8, k = i & 255, ro = m >> 7, kk = m & 127, ri = k >> 7, ll = k & 127;
            const float rev = (float)((kk * ll) & 127) * (1.0f / 128.0f); const float cv = cos_rev(rev) * 0.08838834764831845f, sv = sin_rev(rev) * 0.08838834764831845f;
            FM1[i] = (bf16_t)f2bf(ro == 0 ? (ri == 0 ? cv : sv) : (ri == 0 ? -sv : cv));
            FM2[i] = (bf16_t)f2bf(ro == 0 ? (ri == 0 ? cv : sv) : 0.f); }
        for (int i = gt; i < 256 * 512; i += NT) { const int k = i >> 9, q = i & 511, ri = q >> 8, ll = q & 255;
            const float rev = (float)((k * ll) & 255) * (1.0f / 256.0f);
            FC[i] = (bf16_t)f2bf((ri == 0 ? cos_rev(rev) : sin_rev(rev)) * 0.0625f); }
        for (int i = gt; i < 1024 * 512; i += NT) { const int n = i >> 9, m = i & 511, ri = n >> 9, cch = n & 511;
            const float rev = (float)((cch * m) & 511) * (1.0f / 512.0f);
            CS[i] = (bf16_t)f2bf((ri == 0 ? cos_rev(rev) : -sin_rev(rev)) * 0.04419417382415922f); }
    }
    SEAM(0);
    if (EN(1) && IN(1)) {
        LANEVARS
        for (int it = bx; it < DEPTH * 96; it += G) {
            const int l = it / 96, jc = it - l * 96;
            LAS float* tl = (LAS float*)lds;
            LAS float* red = tl + 1024;
            for (int q = tid; q < 1024; q += NWAVES * 64) { const int v = q >> 9, r = q & 511; float s = 0.f;
                for (int dp = 0; dp < 4; ++dp) s += TPART[((l * 4 + dp) * 2 + v) * ARANK + r];
                tl[q] = s; }
            __syncthreads();
            const int th = tid >> 8, jj = tid & 255, j = jc * 256 + jj;
            const float* bp = args.ada_b + (size_t)l * ARANK * (NMOD * DM) + j;
            float s0 = 0.f, s1 = 0.f;
#pragma unroll 8
            for (int r = th * 256; r < th * 256 + 256; ++r) { const float bv = bp[(size_t)r * (NMOD * DM)]; s0 += tl[r] * bv; s1 += tl[512 + r] * bv; }
            red[(th * 256 + jj) * 2 + 0] = s0; red[(th * 256 + jj) * 2 + 1] = s1;
            __syncthreads();
            if (tid < 256) { const float bias = args.ada_bias[(size_t)l * (NMOD * DM) + j];
                MOD[(size_t)(l * 2 + 0) * (NMOD * DM) + j] = bias + red[(0 * 256 + jj) * 2 + 0] + red[(1 * 256 + jj) * 2 + 0];
                MOD[(size_t)(l * 2 + 1) * (NMOD * DM) + j] = bias + red[(0 * 256 + jj) * 2 + 1] + red[(1 * 256 + jj) * 2 + 1]; }
            __syncthreads();
        }
        { pg8::Gemm g{512, 1024u, 1024u, (size_t)128 * 1024, (size_t)128 * 1024};
          pg8::SchedWf S{G, bx, (const char*)WFRAW, (const char*)CS}; pg8::EpiWf E{WFT};
          pg8::gemm_phase<pg8::EpiWf, pg8::SchedWf>(lds, g, S, E); }
    }
    SEAM(1);

    float* SLAB = (float*)(ws + WS_SLAB);
    float* XWC = XW + (size_t)SEQ * DM;
    for (int l = 0; l < DEPTH; ++l) {
        const int pb = NPH_PRO + l * NPH_LAYER;
        const bool cact = (l != DEPTH - 1);
        const float* modl = MOD + (size_t)(l * 2 + 0) * (NMOD * DM);
        const float* modc = MOD + (size_t)(l * 2 + 1) * (NMOD * DM);
        const float* xlat = l == 0 ? args.x : XW;
        for (int rep = 0; rep < NREP(2); ++rep) if (EN(2) && IN(pb + 0)) {
            LANEVARS
            const float* g = args.g_mix + (size_t)l * DM;
            for (int m = gw; m < SEQ; m += NGW) norm_mod_row(xlat + (size_t)m * DM, g, modl + 1 * DM, modl + 0 * DM, HX + (size_t)m * DM, lane);
            if (l == 0) { for (int r = gw; r < CTX; r += NGW) norm_mod_row(args.ctx + (size_t)r * DM, g, modc + 1 * DM, modc + 0 * DM, HX + (size_t)(SEQ + r) * DM, lane); }
            else { for (int r = bx; r < CTX; r += G)
                       ctx_fold_norm_row<16>((LAS float*)lds, XWC + (size_t)r * DM, XWC + (size_t)r * DM, SLAB + (size_t)r * DM, (size_t)256 * DM, modc - 2 * (NMOD * DM) + 5 * DM,
                                             g, modc + 1 * DM, modc + 0 * DM, HX + (size_t)(SEQ + r) * DM, lane, wave); }
        }
        SEAM(pb + 0);
        for (int rep = 0; rep < NREP(3); ++rep) if (EN(3) && IN(pb + 1)) {
            { pg8::Gemm g{DM, (unsigned)(DM * 2), (unsigned)(DM * 2), (size_t)128 * DM * 2, (size_t)128 * DM * 2};
              pg8::SchedStd S; S.init(SEQ / 256, INW / 256, G, bx, HX, (size_t)256 * DM * 2, WIN + (size_t)l * INW * DM, (size_t)256 * DM * 2);
              pg8::EpiInproj E{PX, COS, SIN};
              pg8::gemm_phase<pg8::EpiInproj, pg8::SchedStd>(lds, g, S, E); }
            { const int nks = cact ? 8 : 16, kp = DM / nks, ntile = cact ? 20 : 4, pn0 = cact ? 0 : 8;
              pg8::Gemm g{kp, (unsigned)(DM * 2), (unsigned)(DM * 2), (size_t)128 * DM * 2, (size_t)128 * DM * 2};
              pg8::SchedPiece S{G, bx, ntile * nks, nks, pn0, (const char*)(HX + (size_t)SEQ * DM), (const char*)(WIN + (size_t)l * INW * DM), (size_t)256 * DM * 2, (size_t)kp * 2};
              pg8::EpiSlab E{SLAB, INW};
              pg8::gemm_phase<pg8::EpiSlab, pg8::SchedPiece>(lds, g, S, E); }
        }
        SEAM(pb + 1);
        for (int rep = 0; rep < NREP(4); ++rep) if (EN(4) && IN(pb + 2)) {
            LANEVARS
            const int nks = cact ? 8 : 16, c4lo = cact ? 0 : K_LO / 4, c4n = cact ? INW / 4 : 1024 / 4;
            for (int i = bx * (NWAVES * 64) + tid; i < 256 * c4n; i += G * NWAVES * 64) {
                const int r = i / c4n, cv = (c4lo + i % c4n) * 4;
                f32x4 a = (f32x4){0.f, 0.f, 0.f, 0.f};
                for (int ks = 0; ks < nks; ++ks) a += *(const f32x4*)(SLAB + ((size_t)ks * 256 + r) * INW + cv);
                int ct = cv;
                if (cv < K_LO + 512) { const int v = cv & 127, wc = v >> 5, fq = (v >> 3) & 3, n = (v >> 2) & 1; ct = (cv & ~127) + 64 * (wc >> 1) + 32 * n + 16 * (wc & 1) + 4 * fq; }
                *(u32x2*)(PX + (size_t)(SEQ + r) * INW + ct) = pg8::pack4(a);
            }
        }
        SEAM(pb + 2);
        for (int rep = 0; rep < NREP(5); ++rep) if (EN(5) && IN(pb + 3)) {
            const float* sk = args.sink + l * NHEAD;
            const int nitems = cact ? 1040 : 1024;
            for (int it = bx; it < nitems; it += G) {
                int qrow0, ntile, w0; const int kvh = (it >> 1) & 3, hp = it & 1;
                if (it < 1024) { const int n = it >> 3; w0 = n == 0 ? 0 : 128 * (n - 1); const int w1 = n == 127 ? SEQ : 128 * (n + 2); qrow0 = 128 * n; ntile = 4 + (w1 - w0) / 64; }
                else { qrow0 = SEQ + 128 * ((it - 1024) >> 3); ntile = 4; w0 = 0; }
                att::attn_item((LAS char*)lds, PX, MIX, sk, qrow0, kvh, hp, ntile, w0);
            }
            { pg8::Gemm g{512, 2048u, (unsigned)(128 * INW * 2), (size_t)128 * 2048, (size_t)INW * 2};
              pg8::SchedGa S{G, bx, (const char*)(WFT + (size_t)l * 4 * 512 * 1024), (const char*)(PX + F_LO)}; pg8::EpiGa E{ZT2};
              pg8::gemm_phase<pg8::EpiGa, pg8::SchedGa>(lds, g, S, E); }
            if (cact) {
              pg8::Gemm g{512, 2048u, (unsigned)(INW * 2), (size_t)128 * 2048, (size_t)128 * INW * 2};
              pg8::SchedGaCtx S{G, bx, (const char*)(WFT + (size_t)l * 4 * 512 * 1024), (const char*)(PX + F_LO)}; pg8::EpiGaCtx E{ZTC};
              pg8::gemm_phase<pg8::EpiGaCtx, pg8::SchedGaCtx>(lds, g, S, E); }
        }
        SEAM(pb + 3);
        for (int rep = 0; rep < NREP(6); ++rep) if (EN(6) && IN(pb + 4)) {
            { pg8::Gemm g{256, 512u, 512u, (size_t)128 * 512, (size_t)128 * 512};
              pg8::SchedN S{G, bx, 1024, (const char*)FM1, (const char*)ZT2, (size_t)256 * 512}; pg8::EpiGb E{Y2, TW};
              pg8::gemm_phase<pg8::EpiGb, pg8::SchedN>(lds, g, S, E); }
            if (cact) {
              pg8::Gemm g{512, 1024u, 1024u, (size_t)128 * 1024, (size_t)128 * 1024};
              pg8::SchedN S{G, bx, 8, (const char*)FC, (const char*)ZTC, (size_t)256 * 1024}; pg8::EpiGctx E{MIX};
              pg8::gemm_phase<pg8::EpiGctx, pg8::SchedN>(lds, g, S, E); }
        }
        SEAM(pb + 4);
        for (int rep = 0; rep < NREP(7); ++rep) if (EN(7) && IN(pb + 5)) {
            pg8::Gemm g{256, 512u, 512u, (size_t)128 * 512, (size_t)128 * 512};
            pg8::SchedN S{G, bx, 1024, (const char*)FM2, (const char*)Y2, (size_t)256 * 512}; pg8::EpiGc E{MIX};
            pg8::gemm_phase<pg8::EpiGc, pg8::SchedN>(lds, g, S, E);
        }
        SEAM(pb + 5);
        if (EN(8) && IN(pb + 6)) {
            LANEVARS
            const int nrows = cact ? MT : SEQ;
            for (int m = gw; m < nrows; m += NGW) mixnorm_row(MIX + (size_t)m * DM, args.g_attn + (size_t)l * QW, args.g_four + (size_t)l * FW, lane);
        }
        SEAM(pb + 6);
        if (EN(9) && IN(pb + 7)) {
            { pg8::Gemm g{DM, (unsigned)(DM * 2), (unsigned)(DM * 2), (size_t)128 * DM * 2, (size_t)128 * DM * 2};
              pg8::SchedStd S; S.init(SEQ / 256, DM / 256, G, bx, MIX, (size_t)256 * DM * 2, WOUT + (size_t)l * DM * DM, (size_t)256 * DM * 2);
              pg8::EpiResid E{xlat, XW, modl + 2 * DM};
              pg8::gemm_phase<pg8::EpiResid, pg8::SchedStd>(lds, g, S, E); }
            if (cact) {
              pg8::Gemm g{512, (unsigned)(DM * 2), (unsigned)(DM * 2), (size_t)128 * DM * 2, (size_t)128 * DM * 2};
              pg8::SchedPiece S{G, bx, 16 * 8, 8, 0, (const char*)(MIX + (size_t)SEQ * DM), (const char*)(WOUT + (size_t)l * DM * DM), (size_t)256 * DM * 2, (size_t)512 * 2};
              pg8::EpiSlab E{SLAB, DM};
              pg8::gemm_phase<pg8::EpiSlab, pg8::SchedPiece>(lds, g, S, E); }
        }
        SEAM(pb + 7);
        for (int rep = 0; rep < NREP(10); ++rep) if (EN(10) && IN(pb + 8)) {
            LANEVARS
            const float* g = args.g_mlp + (size_t)l * DM;
            for (int m = gw; m < SEQ; m += NGW) norm_mod_row(XW + (size_t)m * DM, g, modl + 4 * DM, modl + 3 * DM, HX + (size_t)m * DM, lane);
            if (cact) { for (int r = bx; r < CTX; r += G)
                            ctx_fold_norm_row<8>((LAS float*)lds, (l == 0 ? args.ctx : XWC) + (size_t)r * DM, XWC + (size_t)r * DM, SLAB + (size_t)r * DM, (size_t)256 * DM, modc + 2 * DM,
                                                 g, modc + 4 * DM, modc + 3 * DM, HX + (size_t)(SEQ + r) * DM, lane, wave); }
        }
        SEAM(pb + 8);
        for (int rep = 0; rep < NREP(11); ++rep) if (EN(11) && IN(pb + 9)) {
            { pg8::Gemm g{DM, (unsigned)(DM * 2), (unsigned)(DM * 2), (size_t)128 * DM * 2, (size_t)128 * DM * 2};
              pg8::SchedStd S; S.init(SEQ / 256, DFF / 256, G, bx, HX, (size_t)256 * DM * 2, W1T + (size_t)l * DFF * DM, (size_t)256 * DM * 2);
              pg8::EpiRelu2 E{HB};
              pg8::gemm_phase<pg8::EpiRelu2, pg8::SchedStd>(lds, g, S, E); }
            if (cact) {
              pg8::Gemm g{1024, (unsigned)(DM * 2), (unsigned)(DM * 2), (size_t)128 * DM * 2, (size_t)128 * DM * 2};
              pg8::SchedPiece S{G, bx, 64 * 4, 4, 0, (const char*)(HX + (size_t)SEQ * DM), (const char*)(W1T + (size_t)l * DFF * DM), (size_t)256 * DM * 2, (size_t)1024 * 2};
              pg8::EpiSlab E{SLAB, DFF};
              pg8::gemm_phase<pg8::EpiSlab, pg8::SchedPiece>(lds, g, S, E); }
        }
        SEAM(pb + 9);
        if (EN(12) && IN(pb + 10) && cact) {
            LANEVARS
            for (int i = bx * (NWAVES * 64) + tid; i < 256 * (DFF / 4); i += G * NWAVES * 64) {
                const int r = i / (DFF / 4), c4 = (i % (DFF / 4)) * 4;
                f32x4 a = (f32x4){0.f, 0.f, 0.f, 0.f};
#pragma unroll
                for (int ks = 0; ks < 4; ++ks) a += *(const f32x4*)(SLAB + ((size_t)ks * 256 + r) * DFF + c4);
#pragma unroll
                for (int e = 0; e < 4; ++e) { const float t = fmaxf(a[e], 0.f); a[e] = t * t; }
                *(u32x2*)(HB + (size_t)(SEQ + r) * DFF + c4) = pg8::pack4(a);
            }
        }
        SEAM(pb + 10);
        if (EN(13) && IN(pb + 11)) {
            { pg8::Gemm g{DFF, (unsigned)(DFF * 2), (unsigned)(DFF * 2), (size_t)128 * DFF * 2, (size_t)128 * DFF * 2};
              pg8::SchedStd S; S.init(SEQ / 256, DM / 256, G, bx, HB, (size_t)256 * DFF * 2, W2T + (size_t)l * DM * DFF, (size_t)256 * DFF * 2);
              pg8::EpiResid E{XW, XW, modl + 5 * DM};
              pg8::gemm_phase<pg8::EpiResid, pg8::SchedStd>(lds, g, S, E); }
            if (cact) {
              pg8::Gemm g{1024, (unsigned)(DFF * 2), (unsigned)(DFF * 2), (size_t)128 * DFF * 2, (size_t)128 * DFF * 2};
              pg8::SchedPiece S{G, bx, 16 * 16, 16, 0, (const char*)(HB + (size_t)SEQ * DFF), (const char*)(W2T + (size_t)l * DM * DFF), (size_t)256 * DFF * 2, (size_t)1024 * 2};
              pg8::EpiSlab E{SLAB, DM};
              pg8::gemm_phase<pg8::EpiSlab, pg8::SchedPiece>(lds, g, S, E); }
        }
        SEAM(pb + 11);
    }
    if (EN(14) && IN(NPH - 1)) {
        LANEVARS
        for (int m = gw; m < SEQ; m += NGW) norm_final_row(XW + (size_t)m * DM, args.g_final, args.out + (size_t)m * DM, lane);
    }
#undef IN
#undef SEAM
#undef GRID_BAR
}

extern "C" void kernel_launch(void* const* d_in, const int* in_sizes, int n_in, void* d_out, int out_size, void* d_ws, size_t ws_size, hipStream_t stream) {
    static int grid = 0;
    if (grid == 0) {
        if (n_in != 18 || out_size != SEQ * DM || ws_size < WS_END) { fprintf(stderr, "kernel_launch: unexpected shapes: n_in %d out %d ws %zu (need %zu)\n", n_in, out_size, ws_size, (size_t)WS_END); grid = -1; return; }
        int dev = 0, cus = 0, per_cu = 0;
        if (hipGetDevice(&dev) != hipSuccess || hipDeviceGetAttribute(&cus, hipDeviceAttributeMultiprocessorCount, dev) != hipSuccess) { grid = -1; return; }
        if (hipFuncSetAttribute((const void*)fwd_kernel, hipFuncAttributeMaxDynamicSharedMemorySize, LDS_BYTES) != hipSuccess) { fprintf(stderr, "kernel_launch: hipFuncSetAttribute failed\n"); grid = -1; return; }
        if (hipOccupancyMaxActiveBlocksPerMultiprocessor(&per_cu, (const void*)fwd_kernel, NWAVES * 64, LDS_BYTES) != hipSuccess || per_cu < 1) { fprintf(stderr, "kernel_launch: occupancy query says %d\n", per_cu); }
        (void)hipGetLastError();
        grid = cus;
    }
    if (grid < 0) return;
    (void)hipMemsetAsync((char*)d_ws + WS_CTL, 0, CTL_ZERO_BYTES, stream);
    Args a{};
    a.x = (const float*)d_in[0]; a.c = (const float*)d_in[1]; a.ctx = (const float*)d_in[2]; a.c_ctx = (const float*)d_in[3];
    a.ada_a = (const float*)d_in[4]; a.ada_b = (const float*)d_in[5]; a.ada_bias = (const float*)d_in[6]; a.g_mix = (const float*)d_in[7];
    a.w_in = (const float*)d_in[8]; a.sink = (const float*)d_in[9]; a.w_f = (const float*)d_in[10]; a.g_attn = (const float*)d_in[11];
    a.g_four = (const float*)d_in[12]; a.w_out = (const float*)d_in[13]; a.g_mlp = (const float*)d_in[14]; a.w1 = (const float*)d_in[15];
    a.w2 = (const float*)d_in[16]; a.g_final = (const float*)d_in[17];
    a.out = (float*)d_out; a.ws = (unsigned char*)d_ws;
#if MK_PER_PHASE
    for (int p = 0; p < NPH; ++p) { a.ph_lo = p; a.ph_hi = p + 1; hipLaunchKernelGGL(fwd_kernel, dim3(grid), dim3(NWAVES * 64), LDS_BYTES, stream, a); }
#else
    a.ph_lo = 0; a.ph_hi = NPH;
    hipLaunchKernelGGL(fwd_kernel, dim3(grid), dim3(NWAVES * 64), LDS_BYTES, stream, a);
#endif
    const hipError_t le = hipPeekAtLastError();
    if (le != hipSuccess) fprintf(stderr, "kernel_launch: launch failed: %s\n", hipGetErrorName(le));
}
```

```cpp
#include <hip/hip_runtime.h>
#include <cstdio>
#include <cstdint>

#ifndef MK_PER_PHASE
#define MK_PER_PHASE 0
#endif

#define LAS __attribute__((address_space(3)))
typedef unsigned short bf16_t;
typedef short bf16x8 __attribute__((ext_vector_type(8)));
typedef short s16x4 __attribute__((ext_vector_type(4)));
typedef float f32x2 __attribute__((ext_vector_type(2)));
typedef float f32x4 __attribute__((ext_vector_type(4)));
typedef float f32x16 __attribute__((ext_vector_type(16)));
typedef unsigned u32x2 __attribute__((ext_vector_type(2)));
typedef unsigned u32x4 __attribute__((ext_vector_type(4)));

constexpr int DM = 4096, SEQ = 16384, CTX = 256, MT = SEQ + CTX, DEPTH = 4;
constexpr int NHEAD = 16, NKVH = 4, HD = 128, QW = 2048, FW = 2048, INW = 5120, DFF = 16384, ARANK = 512, NMOD = 6;
constexpr int K_LO = 2048, V_LO = 2560, F_LO = 3072;
constexpr float EPS = 1e-6f;

constexpr size_t MiB = 1u << 20;
constexpr size_t WS_CTL = 0, CTL_ZERO_BYTES = 1 * MiB;
constexpr size_t WS_MOD = 1 * MiB;
constexpr size_t WS_TPART = 2 * MiB;
constexpr size_t WS_ROPE = 2 * MiB + 256 * 1024;
constexpr size_t WS_TW = 2 * MiB + 512 * 1024;
constexpr size_t WS_FM1 = 3 * MiB, WS_FM2 = 3 * MiB + 128 * 1024, WS_FC = 3 * MiB + 256 * 1024, WS_CS = 3 * MiB + 512 * 1024;
constexpr size_t WS_WFRAW = 5 * MiB;
constexpr size_t WS_WFT = 13 * MiB;
constexpr size_t WS_GAM = 29 * MiB;
constexpr size_t WS_BIASIN = 29 * MiB + 256 * 1024;
constexpr size_t WS_BIAS1 = 29 * MiB + 512 * 1024;
constexpr size_t WS_SS = 30 * MiB;
constexpr size_t WS_WIN = 32 * MiB;
constexpr size_t WS_WOUT = 192 * MiB;
constexpr size_t WS_W1 = 320 * MiB;
constexpr size_t WS_W2 = 832 * MiB;
constexpr size_t WS_XW = 1344 * MiB;
constexpr size_t WS_HX = 1604 * MiB;
constexpr size_t WS_PX = 1734 * MiB;
constexpr size_t WS_MIX = 1897 * MiB;
constexpr size_t WS_ZT2 = 2027 * MiB;
constexpr size_t WS_Y2 = 2155 * MiB;
constexpr size_t WS_ZTC = 2283 * MiB;
constexpr size_t WS_H = 2285 * MiB;
constexpr size_t WS_SLAB = 2805 * MiB;
constexpr size_t WS_XB = 2873 * MiB;
constexpr size_t WS_END = 3129 * MiB;
static_assert(WS_XW + (size_t)MT * DM * 4 <= WS_HX && WS_HX + (size_t)MT * DM * 2 <= WS_PX && WS_PX + (size_t)MT * INW * 2 <= WS_MIX && WS_MIX + (size_t)MT * DM * 2 <= WS_ZT2 && WS_H + (size_t)MT * DFF * 2 <= WS_SLAB, "ws map");

constexpr int CW_BAR = 4096;

constexpr int RING_BYTES = 131072, LDSCTL_OFF = RING_BYTES, MISC_OFF = LDSCTL_OFF + 320, LDS_BYTES = 147456;
constexpr int NWAVES = 8;

__device__ __forceinline__ unsigned cvt_pk_bf16(float lo, float hi) { unsigned r; asm volatile("v_cvt_pk_bf16_f32 %0, %1, %2" : "=v"(r) : "v"(lo), "v"(hi)); return r; }
__device__ __forceinline__ unsigned f2bf(float f) { unsigned u = __builtin_bit_cast(unsigned, f); return (u + 0x7fffu + ((u >> 16) & 1u)) >> 16; }
__device__ __forceinline__ unsigned pk2(float lo, float hi) { return f2bf(lo) | (f2bf(hi) << 16); }
__device__ __forceinline__ float bf2f(unsigned short b) { return __builtin_bit_cast(float, ((unsigned)b) << 16); }
__device__ __forceinline__ float wave_sum(float v) {
#pragma unroll
    for (int o = 1; o < 64; o <<= 1) v += __shfl_xor(v, o);
    return v;
}
__device__ __forceinline__ float cos_rev(float x) { return __builtin_amdgcn_cosf(x); }
__device__ __forceinline__ float sin_rev(float x) { return __builtin_amdgcn_sinf(x); }

namespace pg8 {
constexpr int BM = 256, BK = 64, HALF = 128, HTB = HALF * BK * 2, STAGE_BYTES = 8 * HTB, NXCD = 8, WGM = 8;
__host__ __device__ __forceinline__ int lds_byte(int r, int c) { const int st = (r >> 4) * 2 + (c >> 5), rr = r & 15, cc = c & 31, ob = rr * 64 + cc * 2; return st * 1024 + (ob ^ (((ob >> 9) & 1) << 5)); }
__host__ __device__ __forceinline__ void stage_rc(int b, int& R, int& C) { const int st = b / 1024, sb = b % 1024, swz = sb ^ (((sb >> 9) & 1) << 5); R = (st >> 1) * 16 + swz / 64; C = (st & 1) * 32 + (swz % 64) / 2; }
__host__ __device__ __forceinline__ int perm32(int rho) { const int n = rho >> 4, i = rho & 15; return 8 * (i >> 2) + 4 * n + (i & 3); }

struct Unit { int pm, pn, g; };
struct Gemm { int K; unsigned rsA, rsB; size_t hsA, hsB; };

template <class Epi, class Sched>
__device__ __forceinline__ void gemm_phase(LAS unsigned char* lds, const Gemm g, const Sched& S, const Epi& E) {
    int tid = threadIdx.x; asm volatile("" : "+v"(tid));
    const int wid = __builtin_amdgcn_readfirstlane(tid >> 6), lane = tid & 63, wr = wid >> 2, wc = wid & 3, fr = lane & 15, fq = lane >> 4;
    const int K = g.K, nt = K / BK;
    unsigned voffA[2], voffB[2];
#pragma unroll
    for (int i = 0; i < 2; ++i) { int R, C; stage_rc(tid * 16 + i * 8192, R, C); const int Rb = Epi::PERM ? ((R & ~31) + perm32(R & 31)) : R;
        voffA[i] = (unsigned)R * g.rsA + (unsigned)C * 2u; voffB[i] = (unsigned)Rb * g.rsB + (unsigned)C * 2u; }
    const size_t kstep = (size_t)(BK * 2);
    const size_t hA = g.hsA, hB = g.hsB;
    const unsigned ldsw = (unsigned)wid * 1024u;
    const int aoff = lds_byte(wr * 64 + fr, fq * 8), boff = lds_byte(wc * 32 + fr, fq * 8);
#define PG8_SA(b, h) (((b) * 2 + (h)) * HTB)
#define PG8_SB(b, h) ((4 + (b) * 2 + (h)) * HTB)
#define PG8_STAGE(bufoff, gbase, voff) do { _Pragma("unroll") for (int _i = 0; _i < 2; ++_i) \
        __builtin_amdgcn_global_load_lds((const unsigned*)((const char*)(gbase) + (voff)[_i]), (LAS unsigned*)(lds + (bufoff) + ldsw + _i * 8192), 16, 0, 0); } while (0)
#define PG8_LDA(dst, b, h) do { _Pragma("unroll") for (int m = 0; m < 4; ++m) _Pragma("unroll") for (int k = 0; k < 2; ++k) dst[m][k] = *(const LAS bf16x8*)(lds + PG8_SA(b, h) + aoff + m * 2048 + k * 1024); } while (0)
#define PG8_LDB(dst, b, h) do { _Pragma("unroll") for (int n = 0; n < 2; ++n) _Pragma("unroll") for (int k = 0; k < 2; ++k) dst[n][k] = *(const LAS bf16x8*)(lds + PG8_SB(b, h) + boff + n * 2048 + k * 1024); } while (0)
#define PG8_MMA(ai, bj, At, Bt) do { __builtin_amdgcn_s_setprio(1); _Pragma("unroll") for (int m = 0; m < 4; ++m) _Pragma("unroll") for (int n = 0; n < 2; ++n) _Pragma("unroll") for (int k = 0; k < 2; ++k) \
        acc[ai][bj][m][n] = __builtin_amdgcn_mfma_f32_16x16x32_bf16(Bt[n][k], At[m][k], acc[ai][bj][m][n], 0, 0, 0); __builtin_amdgcn_s_setprio(0); } while (0)
#define PG8_WAIT_V(n) asm volatile("s_waitcnt vmcnt(" #n ")" ::: "memory")
#define PG8_WAIT_L(n) asm volatile("s_waitcnt lgkmcnt(" #n ")" ::: "memory")
#define PG8_BAR __builtin_amdgcn_s_barrier()
#define PG8_SCHED __builtin_amdgcn_sched_barrier(0)
    Unit cur, nxt; int ui = 0;
    if (!S.next(0, cur)) return;
    f32x4 acc[2][2][4][2];
#pragma unroll
    for (int a = 0; a < 2; ++a)
#pragma unroll
        for (int b = 0; b < 2; ++b)
#pragma unroll
            for (int m = 0; m < 4; ++m)
#pragma unroll
                for (int n = 0; n < 2; ++n) acc[a][b][m][n] = (f32x4){0.f, 0.f, 0.f, 0.f};
    bf16x8 At[4][2], B0[2][2], B1[2][2];
    const char* cA = S.abase(cur); const char* cB = S.bbase(cur);
    PG8_STAGE(PG8_SB(0, 0), cB, voffB); PG8_STAGE(PG8_SB(0, 1), cB + hB, voffB); PG8_STAGE(PG8_SA(0, 0), cA, voffA); PG8_STAGE(PG8_SA(0, 1), cA + hA, voffA);
    if (wr == 1) PG8_BAR;
    PG8_WAIT_V(2); PG8_BAR;
    PG8_STAGE(PG8_SB(1, 0), cB + kstep, voffB); PG8_STAGE(PG8_SA(1, 0), cA + kstep, voffA); PG8_STAGE(PG8_SB(1, 1), cB + hB + kstep, voffB);
    PG8_WAIT_V(6); PG8_BAR;
    for (;;) {
        const bool has_next = S.next(ui + 1, nxt);
        const char* nA = has_next ? S.abase(nxt) : cA; const char* nB = has_next ? S.bbase(nxt) : cB;
#pragma nounroll
        for (int t = 0; t < nt; t += 2) {
            const bool last = (t == nt - 2);
            const char* a1 = cA + (size_t)(t + 1) * kstep;
            const char* a2 = last ? nA : cA + (size_t)(t + 2) * kstep; const char* b2 = last ? nB : cB + (size_t)(t + 2) * kstep;
            const char* a3 = a2 + kstep; const char* b3 = b2 + kstep;
            PG8_LDB(B0, 0, 0); PG8_LDB(B1, 0, 1); PG8_SCHED; PG8_LDA(At, 0, 0); PG8_STAGE(PG8_SA(1, 1), a1 + hA, voffA);
            PG8_WAIT_V(8); PG8_WAIT_L(0); PG8_BAR; PG8_MMA(0, 0, At, B0); PG8_MMA(0, 1, At, B1); PG8_BAR; PG8_SCHED;
            PG8_LDA(At, 0, 1); PG8_STAGE(PG8_SB(0, 0), b2, voffB); PG8_STAGE(PG8_SB(0, 1), b2 + hB, voffB); PG8_STAGE(PG8_SA(0, 0), a2, voffA);
            PG8_WAIT_V(8); PG8_WAIT_L(0); PG8_BAR; PG8_MMA(1, 0, At, B0); PG8_MMA(1, 1, At, B1); PG8_BAR; PG8_SCHED;
            PG8_LDB(B0, 1, 0); PG8_LDB(B1, 1, 1); PG8_SCHED; PG8_LDA(At, 1, 0); PG8_STAGE(PG8_SA(0, 1), a2 + hA, voffA);
            PG8_WAIT_V(8); PG8_WAIT_L(0); PG8_BAR; PG8_MMA(0, 0, At, B0); PG8_MMA(0, 1, At, B1); PG8_BAR; PG8_SCHED;
            PG8_LDA(At, 1, 1); PG8_STAGE(PG8_SB(1, 0), b3, voffB); PG8_STAGE(PG8_SB(1, 1), b3 + hB, voffB); PG8_STAGE(PG8_SA(1, 0), a3, voffA);
            PG8_WAIT_V(8); PG8_WAIT_L(0); PG8_BAR; PG8_MMA(1, 0, At, B0); PG8_MMA(1, 1, At, B1); PG8_BAR; PG8_SCHED;
        }
        if (wr == 0) PG8_BAR;
        { int efr = fr, efq = fq; asm volatile("" : "+v"(efr), "+v"(efq));
          E(acc, cur, wr, wc, efr, efq); }
        if (!has_next) break;
#pragma unroll
        for (int a = 0; a < 2; ++a)
#pragma unroll
            for (int b = 0; b < 2; ++b)
#pragma unroll
                for (int m = 0; m < 4; ++m)
#pragma unroll
                    for (int n = 0; n < 2; ++n) acc[a][b][m][n] = (f32x4){0.f, 0.f, 0.f, 0.f};
        cur = nxt; cA = nA; cB = nB; ++ui;
        if (wr == 1) PG8_BAR;
    }
    PG8_WAIT_V(0);
    PG8_BAR;
#undef PG8_SA
#undef PG8_SB
#undef PG8_STAGE
#undef PG8_LDA
#undef PG8_LDB
#undef PG8_MMA
#undef PG8_WAIT_V
#undef PG8_WAIT_L
#undef PG8_BAR
#undef PG8_SCHED
}

struct SchedStd {
    int nM, nN, nwg, G, c; const char* A; const char* B; size_t tsA, tsB;
    __device__ __forceinline__ void init(int nM_, int nN_, int G_, int c_, const void* A_, size_t tsA_, const void* B_, size_t tsB_) { nM = nM_; nN = nN_; nwg = nM * nN; G = G_; c = c_; A = (const char*)A_; B = (const char*)B_; tsA = tsA_; tsB = tsB_; }
    __device__ __forceinline__ bool next(int i, Unit& u) const {
        const long L = (long)i * G + c; if (L >= nwg) return false;
        int wgid = (int)L; { const int q = nwg / NXCD, r = nwg % NXCD, xcd = wgid % NXCD, off = wgid / NXCD; wgid = (xcd < r ? xcd * (q + 1) : r * (q + 1) + (xcd - r) * q) + off; }
        const int nig = WGM * nN, gid = wgid / nig, fm = gid * WGM, gsz = (nM - fm) < WGM ? (nM - fm) : WGM;
        u.pm = fm + ((wgid % nig) % gsz); u.pn = (wgid % nig) / gsz; u.g = 0; return true;
    }
    __device__ __forceinline__ const char* abase(const Unit& u) const { return A + (size_t)u.pm * tsA; }
    __device__ __forceinline__ const char* bbase(const Unit& u) const { return B + (size_t)u.pn * tsB; }
};
struct SchedGa {
    int G, c; const char* WfT; const char* PXf;
    __device__ __forceinline__ bool next(int i, Unit& u) const { const int L = i * G + c; if (L >= 1024) return false; u.pn = L >> 4; u.g = (L >> 2) & 3; u.pm = L & 3; return true; }
    __device__ __forceinline__ const char* abase(const Unit& u) const { return WfT + (size_t)u.g * (512 * 1024 * 2) + ((size_t)(u.pm & 1) * 256 * 1024 + (size_t)(u.pm >> 1) * 512) * 2; }
    __device__ __forceinline__ const char* bbase(const Unit& u) const { return PXf + ((size_t)(2 * u.pn) * INW + 512 * u.g) * 2; }
};
struct SchedGaCtx {
    int G, c; const char* WfT; const char* PXf;
    __device__ __forceinline__ bool next(int i, Unit& u) const { const int L = i * G + c; if (L >= 16) return false; u.pn = 0; u.g = L >> 2; u.pm = L & 3; return true; }
    __device__ __forceinline__ const char* abase(const Unit& u) const { return WfT + (size_t)u.g * (512 * 1024 * 2) + ((size_t)(u.pm & 1) * 256 * 1024 + (size_t)(u.pm >> 1) * 512) * 2; }
    __device__ __forceinline__ const char* bbase(const Unit& u) const { return PXf + ((size_t)SEQ * INW + 512 * u.g) * 2; }
};
struct SchedN {
    int G, c, ntile; const char* A; const char* B; size_t tsB;
    __device__ __forceinline__ bool next(int i, Unit& u) const { const int L = i * G + c; if (L >= ntile) return false; u.pn = L; u.pm = 0; u.g = 0; return true; }
    __device__ __forceinline__ const char* abase(const Unit&) const { return A; }
    __device__ __forceinline__ const char* bbase(const Unit& u) const { return B + (size_t)u.pn * tsB; }
};
struct SchedWf {
    int G, c; const char* WfRaw; const char* CS;
    __device__ __forceinline__ bool next(int i, Unit& u) const { const int L = i * G + c; if (L >= 128) return false; u.g = L >> 3; u.pm = (L >> 2) & 1; u.pn = L & 3; return true; }
    __device__ __forceinline__ const char* abase(const Unit& u) const { return WfRaw + (size_t)u.g * (512 * 512 * 2) + (size_t)u.pm * 256 * 1024; }
    __device__ __forceinline__ const char* bbase(const Unit& u) const { return CS + (size_t)u.pn * 256 * 1024; }
};

#define ACC_T const f32x4 (&acc)[2][2][4][2]
__device__ __forceinline__ u32x4 pack8(const f32x4 a, const f32x4 b) { u32x4 w; w.x = cvt_pk_bf16(a[0], a[1]); w.y = cvt_pk_bf16(a[2], a[3]); w.z = cvt_pk_bf16(b[0], b[1]); w.w = cvt_pk_bf16(b[2], b[3]); return w; }
__device__ __forceinline__ u32x2 pack4(const f32x4 a) { u32x2 w; w.x = cvt_pk_bf16(a[0], a[1]); w.y = cvt_pk_bf16(a[2], a[3]); return w; }

struct EpiInproj {
    static constexpr bool PERM = true;
    bf16_t* PX; const float* COS; const float* SIN; const float* SSr; const float* bias;
    __device__ __forceinline__ void operator()(ACC_T, const Unit& u, int wr, int wc, int fr, int fq) const {
        const int row0 = u.pm * BM + wr * 64 + fr;
        f32x4 bv[2][2];
#pragma unroll
        for (int bj = 0; bj < 2; ++bj)
#pragma unroll
            for (int n = 0; n < 2; ++n) bv[bj][n] = *(const f32x4*)(bias + u.pn * BM + bj * HALF + wc * 32 + 8 * fq + 4 * n);
        if (u.pn < 10) {
            const int a = wc >> 1, b = wc & 1, jj = 16 * b + 4 * fq, dcol = 64 * a + jj;
            const bool rot = u.pm < 64;
#pragma unroll
            for (int ai = 0; ai < 2; ++ai)
#pragma unroll
                for (int m = 0; m < 4; ++m) {
                    const int row = row0 + ai * HALF + m * 16; const int pos = a ? (row & 63) : ((row >> 6) & 255);
                    const float rstd = 1.0f / sqrtf(SSr[row] * (1.0f / DM) + EPS);
                    f32x4 cs = (f32x4){1.f, 1.f, 1.f, 1.f}, sn = (f32x4){0.f, 0.f, 0.f, 0.f};
                    if (rot) { cs = *(const f32x4*)(COS + pos * 32 + jj); sn = *(const f32x4*)(SIN + pos * 32 + jj); }
                    bf16_t* rowp = PX + (size_t)row * INW + u.pn * BM + dcol;
#pragma unroll
                    for (int bj = 0; bj < 2; ++bj) { const f32x4 x1 = acc[ai][bj][m][0] * rstd + bv[bj][0], x2 = acc[ai][bj][m][1] * rstd + bv[bj][1];
                        const f32x4 o1 = x1 * cs - x2 * sn, o2 = x2 * cs + x1 * sn;
                        *(u32x2*)(rowp + bj * HALF) = pack4(o1); *(u32x2*)(rowp + bj * HALF + 32) = pack4(o2); }
                }
        } else {
            const int col0 = u.pn * BM + wc * 32 + 8 * fq;
#pragma unroll
            for (int ai = 0; ai < 2; ++ai)
#pragma unroll
                for (int m = 0; m < 4; ++m) { const int row = row0 + ai * HALF + m * 16; bf16_t* rowp = PX + (size_t)row * INW + col0;
                    const float rstd = 1.0f / sqrtf(SSr[row] * (1.0f / DM) + EPS);
#pragma unroll
                    for (int bj = 0; bj < 2; ++bj) *(u32x4*)(rowp + bj * HALF) = pack8(acc[ai][bj][m][0] * rstd + bv[bj][0], acc[ai][bj][m][1] * rstd + bv[bj][1]); }
        }
    }
};
struct EpiResid {
    static constexpr bool PERM = false;
    const float* base; float* XW; const float* gate; const float* gam; bf16_t* HXo; float* SSo;
    __device__ __forceinline__ void operator()(ACC_T, const Unit& u, int wr, int wc, int fr, int fq) const {
        const int row0 = u.pm * BM + wr * 64 + fr, col0 = u.pn * BM + wc * 32 + 4 * fq;
        const bool nxt = (gam != nullptr);
        f32x4 gv[2][2], gm[2][2];
#pragma unroll
        for (int bj = 0; bj < 2; ++bj)
#pragma unroll
            for (int n = 0; n < 2; ++n) { gv[bj][n] = *(const f32x4*)(gate + col0 + bj * HALF + n * 16); gm[bj][n] = nxt ? *(const f32x4*)(gam + col0 + bj * HALF + n * 16) : (f32x4){0.f, 0.f, 0.f, 0.f}; }
#pragma unroll
        for (int ai = 0; ai < 2; ++ai)
#pragma unroll
            for (int m = 0; m < 4; ++m) { const int row = row0 + ai * HALF + m * 16; const size_t off = (size_t)row * DM + col0; float s = 0.f;
#pragma unroll
                for (int bj = 0; bj < 2; ++bj)
#pragma unroll
                    for (int n = 0; n < 2; ++n) { const f32x4 x = *(const f32x4*)(base + off + bj * HALF + n * 16) + gv[bj][n] * acc[ai][bj][m][n];
                        *(f32x4*)(XW + off + bj * HALF + n * 16) = x;
                        if (nxt) { s += (x[0] * x[0] + x[1] * x[1]) + (x[2] * x[2] + x[3] * x[3]); *(u32x2*)(HXo + off + bj * HALF + n * 16) = pack4(x * gm[bj][n]); } }
                if (nxt) { s += __shfl_xor(s, 16); s += __shfl_xor(s, 32); if (fq == 0) atomicAdd(SSo + row, s); } }
    }
};
struct EpiRelu2 {
    static constexpr bool PERM = true;
    bf16_t* H; const float* SSr; const float* bias;
    __device__ __forceinline__ void operator()(ACC_T, const Unit& u, int wr, int wc, int fr, int fq) const {
        const int row0 = u.pm * BM + wr * 64 + fr, col0 = u.pn * BM + wc * 32 + 8 * fq;
        f32x4 bv[2][2];
#pragma unroll
        for (int bj = 0; bj < 2; ++bj)
#pragma unroll
            for (int n = 0; n < 2; ++n) bv[bj][n] = *(const f32x4*)(bias + col0 + bj * HALF + 4 * n);
#pragma unroll
        for (int ai = 0; ai < 2; ++ai)
#pragma unroll
            for (int m = 0; m < 4; ++m) { const int row = row0 + ai * HALF + m * 16; bf16_t* rowp = H + (size_t)row * DFF + col0;
                const float rstd = 1.0f / sqrtf(SSr[row] * (1.0f / DM) + EPS);
#pragma unroll
                for (int bj = 0; bj < 2; ++bj) { f32x4 v0 = acc[ai][bj][m][0] * rstd + bv[bj][0], v1 = acc[ai][bj][m][1] * rstd + bv[bj][1];
#pragma unroll
                    for (int e = 0; e < 4; ++e) { const float a0 = fmaxf(v0[e], 0.f), a1 = fmaxf(v1[e], 0.f); v0[e] = a0 * a0; v1[e] = a1 * a1; }
                    *(u32x4*)(rowp + bj * HALF) = pack8(v0, v1); } }
    }
};
struct EpiWf {
    static constexpr bool PERM = true;
    bf16_t* WfT;
    __device__ __forceinline__ void operator()(ACC_T, const Unit& u, int wr, int wc, int fr, int fq) const {
        const int row0 = u.pm * BM + wr * 64 + fr, col0 = u.pn * BM + wc * 32 + 8 * fq;
        bf16_t* base = WfT + (size_t)u.g * (512 * 1024);
#pragma unroll
        for (int ai = 0; ai < 2; ++ai)
#pragma unroll
            for (int m = 0; m < 4; ++m) { bf16_t* rowp = base + (size_t)(row0 + ai * HALF + m * 16) * 1024 + col0;
#pragma unroll
                for (int bj = 0; bj < 2; ++bj) *(u32x4*)(rowp + bj * HALF) = pack8(acc[ai][bj][m][0], acc[ai][bj][m][1]); }
    }
};
struct EpiGa {
    static constexpr bool PERM = true;
    bf16_t* ZT2;
    __device__ __forceinline__ void operator()(ACC_T, const Unit& u, int wr, int wc, int fr, int fq) const {
        const int reim = u.pm >> 1, d0 = (u.pm & 1) * 256 + wr * 64 + fr, l1 = wc * 32 + 8 * fq;
#pragma unroll
        for (int ai = 0; ai < 2; ++ai)
#pragma unroll
            for (int m = 0; m < 4; ++m) { const int j = u.g * 512 + d0 + ai * HALF + m * 16;
#pragma unroll
                for (int bj = 0; bj < 2; ++bj) { const int l2 = 2 * u.pn + bj;
                    *(u32x4*)(ZT2 + ((size_t)(j * 128 + l2) * 256 + reim * 128 + l1)) = pack8(acc[ai][bj][m][0], acc[ai][bj][m][1]); } }
    }
};
struct EpiGaCtx {
    static constexpr bool PERM = true;
    bf16_t* ZTc;
    __device__ __forceinline__ void operator()(ACC_T, const Unit& u, int wr, int wc, int fr, int fq) const {
        const int reim = u.pm >> 1, d0 = (u.pm & 1) * 256 + wr * 64 + fr, l0 = wc * 32 + 8 * fq;
#pragma unroll
        for (int ai = 0; ai < 2; ++ai)
#pragma unroll
            for (int m = 0; m < 4; ++m) { const int j = u.g * 512 + d0 + ai * HALF + m * 16;
#pragma unroll
                for (int bj = 0; bj < 2; ++bj)
                    *(u32x4*)(ZTc + ((size_t)j * 512 + reim * 256 + bj * HALF + l0)) = pack8(acc[ai][bj][m][0], acc[ai][bj][m][1]); }
    }
};
struct EpiGb {
    static constexpr bool PERM = true;
    bf16_t* Y2; const f32x2* TW;
    __device__ __forceinline__ void operator()(ACC_T, const Unit& u, int wr, int wc, int fr, int fq) const {
        const int l2b = wc * 32 + 8 * fq;
#pragma unroll
        for (int m = 0; m < 4; ++m) { const int k1 = wr * 64 + m * 16 + fr;
            f32x2 t[8];
#pragma unroll
            for (int e = 0; e < 8; ++e) t[e] = TW[(unsigned)(k1 * (l2b + e))];
#pragma unroll
            for (int bj = 0; bj < 2; ++bj) { const int j = 2 * u.pn + bj;
                f32x4 r0, r1, i0, i1;
#pragma unroll
                for (int e = 0; e < 4; ++e) {
                    const float yr0 = acc[0][bj][m][0][e], yi0 = acc[1][bj][m][0][e], yr1 = acc[0][bj][m][1][e], yi1 = acc[1][bj][m][1][e];
                    r0[e] = yr0 * t[e].x + yi0 * t[e].y; i0[e] = yi0 * t[e].x - yr0 * t[e].y;
                    r1[e] = yr1 * t[4 + e].x + yi1 * t[4 + e].y; i1[e] = yi1 * t[4 + e].x - yr1 * t[4 + e].y; }
                bf16_t* p = Y2 + ((size_t)(k1 * 2048 + j) * 256 + l2b);
                *(u32x4*)p = pack8(r0, r1); *(u32x4*)(p + 128) = pack8(i0, i1); }
            asm volatile("" ::: "memory"); }
    }
};
struct EpiGc {
    static constexpr bool PERM = true;
    bf16_t* MIX;
    __device__ __forceinline__ void operator()(ACC_T, const Unit& u, int wr, int wc, int fr, int fq) const {
        const int k1 = u.pn >> 3, j0 = (u.pn & 7) * 256 + wc * 32 + 8 * fq;
#pragma unroll
        for (int m = 0; m < 4; ++m) { const int k2 = wr * 64 + m * 16 + fr; const int pos = k1 + 128 * k2;
#pragma unroll
            for (int bj = 0; bj < 2; ++bj) *(u32x4*)(MIX + (size_t)pos * DM + QW + j0 + bj * HALF) = pack8(acc[0][bj][m][0], acc[0][bj][m][1]); }
    }
};
struct EpiGctx {
    static constexpr bool PERM = true;
    bf16_t* MIX;
    __device__ __forceinline__ void operator()(ACC_T, const Unit& u, int wr, int wc, int fr, int fq) const {
        const int j0 = u.pn * 256 + wc * 32 + 8 * fq;
#pragma unroll
        for (int ai = 0; ai < 2; ++ai)
#pragma unroll
            for (int m = 0; m < 4; ++m) { const int k = ai * HALF + wr * 64 + m * 16 + fr;
#pragma unroll
                for (int bj = 0; bj < 2; ++bj) *(u32x4*)(MIX + (size_t)(SEQ + k) * DM + QW + j0 + bj * HALF) = pack8(acc[ai][bj][m][0], acc[ai][bj][m][1]); }
    }
};

struct SchedPiece {
    int G, c, npiece, nks, pn0; const char* A; const char* B; size_t tsB, kbytes;
    __device__ __forceinline__ bool next(int i, Unit& u) const { const int L = i * G + c; if (L >= npiece) return false; u.pn = pn0 + L / nks; u.g = L % nks; u.pm = 0; return true; }
    __device__ __forceinline__ const char* abase(const Unit& u) const { return A + (size_t)u.g * kbytes; }
    __device__ __forceinline__ const char* bbase(const Unit& u) const { return B + (size_t)u.pn * tsB + (size_t)u.g * kbytes; }
};
struct EpiSlab {
    static constexpr bool PERM = false;
    float* SLAB; int ldn;
    __device__ __forceinline__ void operator()(ACC_T, const Unit& u, int wr, int wc, int fr, int fq) const {
        const int row0 = wr * 64 + fr, col0 = u.pn * BM + wc * 32 + 4 * fq;
        float* base = SLAB + (size_t)u.g * 256 * ldn;
#pragma unroll
        for (int ai = 0; ai < 2; ++ai)
#pragma unroll
            for (int m = 0; m < 4; ++m) { float* rowp = base + (size_t)(row0 + ai * HALF + m * 16) * ldn + col0;
#pragma unroll
                for (int bj = 0; bj < 2; ++bj)
#pragma unroll
                    for (int n = 0; n < 2; ++n) *(f32x4*)(rowp + bj * HALF + n * 16) = acc[ai][bj][m][n]; }
    }
};
#undef ACC_T
}

namespace att {
constexpr float SCALE = 0.08838834764831845f;
constexpr float THR = 0.f;
constexpr int SHM_K = 16384, SHM_V = 16384, OFF_V = 0, OFF_K = 2 * SHM_V, OFF_WS = 2 * SHM_V + 2 * SHM_K;
#define KSWZ(row, colB) ((row) * 256 + ((colB) ^ (((row) & 7) << 4)))
#define SBAR() __builtin_amdgcn_sched_barrier(0)
__device__ __forceinline__ int v_st(int k, int c) { const int kk = (k & ~0xC) | ((k & 4) << 1) | ((k & 8) >> 1); return ((kk >> 3) * 4 + (c >> 5)) * 512 + ((kk & 7) * 32 + (c & 31)) * 2; }
__device__ __forceinline__ int v_rd_base(int lane) { return ((lane & 3) << 3) | (((lane >> 2) & 3) << 6) | (((lane >> 4) & 1) << 5) | (((lane >> 5) & 1) << 8); }
constexpr int v_rd_off(int d0, int ks, int half) { return d0 * 512 + ks * 4096 + half * 2048; }
__device__ __forceinline__ int crow(int r, int hi) { return (r & 3) + 8 * (r >> 2) + 4 * hi; }
__device__ __forceinline__ unsigned cvtpk(float lo, float hi) { unsigned r; asm volatile("v_cvt_pk_bf16_f32 %0, %1, %2" : "=v"(r) : "v"(lo), "v"(hi)); return r; }
__device__ __forceinline__ void mask_tile(f32x16& p0, f32x16& p1, int dq, unsigned W) {
    const float NEG = -__builtin_inff();
#pragma unroll
    for (int r = 0; r < 16; ++r) {
        const int c = (r & 3) + 8 * (r >> 2);
        if ((unsigned)(dq - c) >= W) p0[r] = NEG;
        if ((unsigned)(dq - c - 32) >= W) p1[r] = NEG;
    }
}
__device__ __forceinline__ void partialSM(f32x16& p0, f32x16& p1, float& m_reg, float& mn, float& alpha) {
    float pmax = p0[0];
#pragma unroll
    for (int r = 1; r < 16; ++r) pmax = fmaxf(pmax, p0[r]);
#pragma unroll
    for (int r = 0; r < 16; ++r) pmax = fmaxf(pmax, p1[r]);
    { auto rr = __builtin_amdgcn_permlane32_swap(__float_as_uint(pmax), __float_as_uint(pmax), false, false);
      pmax = fmaxf(__uint_as_float(rr[0]), __uint_as_float(rr[1])); }
    constexpr float C2 = 1.4426950408889634f * SCALE;
    if (__all((pmax - m_reg) * SCALE <= THR)) { mn = m_reg; alpha = 1.f; }
    else { mn = fmaxf(m_reg, pmax); alpha = __builtin_amdgcn_exp2f((m_reg - mn) * C2); m_reg = mn; }
    const float mnL = -mn * C2;
#pragma unroll
    for (int r = 0; r < 16; ++r) p0[r] = fmaf(p0[r], C2, mnL);
#pragma unroll
    for (int r = 0; r < 16; ++r) p1[r] = fmaf(p1[r], C2, mnL);
#pragma unroll
    for (int r = 0; r < 16; ++r) p0[r] = __builtin_amdgcn_exp2f(p0[r]);
}
__device__ __forceinline__ void finishSM(f32x16& p0, f32x16& p1, float alpha, float& l_reg, bf16x8& pa0, bf16x8& pa1, bf16x8& pa2, bf16x8& pa3) {
#pragma unroll
    for (int r = 0; r < 16; ++r) p1[r] = __builtin_amdgcn_exp2f(p1[r]);
    float ps = 0;
#pragma unroll
    for (int r = 0; r < 16; ++r) ps += p0[r];
#pragma unroll
    for (int r = 0; r < 16; ++r) ps += p1[r];
    { auto rr = __builtin_amdgcn_permlane32_swap(__float_as_uint(ps), __float_as_uint(ps), false, false);
      ps = __uint_as_float(rr[0]) + __uint_as_float(rr[1]); }
    l_reg = l_reg * alpha + ps;
#define PK4(P, B_, OUT) do { unsigned a0 = cvtpk(P[B_+0], P[B_+1]), a1 = cvtpk(P[B_+2], P[B_+3]);                          \
        unsigned b0 = cvtpk(P[B_+4], P[B_+5]), b1 = cvtpk(P[B_+6], P[B_+7]);                                             \
        auto r0 = __builtin_amdgcn_permlane32_swap(a0, b0, false, false); auto r1 = __builtin_amdgcn_permlane32_swap(a1, b1, false, false); \
        u32x4 w = {r0[0], r1[0], r0[1], r1[1]}; OUT = __builtin_bit_cast(bf16x8, w); } while (0)
    PK4(p0, 0, pa0); PK4(p0, 8, pa1); PK4(p1, 0, pa2); PK4(p1, 8, pa3);
#undef PK4
}
template <int KB>
__device__ __forceinline__ void qkt(f32x16& p0, f32x16& p1, const LAS char* K_lds, int r32, int hi, const bf16x8* qr) {
    p0 = f32x16{}; p1 = f32x16{};
    const LAS char* kb[4];
#pragma unroll
    for (int dd = 0; dd < 4; ++dd) kb[dd] = K_lds + KB * SHM_K + KSWZ(r32, (dd * 16 + hi * 8) * 2);
#pragma unroll
    for (int d0 = 0; d0 < 8; ++d0) { const LAS char* a = kb[d0 & 3] + (d0 >> 2) * 128;
        bf16x8 b0 = *(const LAS bf16x8*)(a);
        bf16x8 b1 = *(const LAS bf16x8*)(a + 32 * 256);
        p0 = __builtin_amdgcn_mfma_f32_32x32x16_bf16(b0, qr[d0], p0, 0, 0, 0);
        p1 = __builtin_amdgcn_mfma_f32_32x32x16_bf16(b1, qr[d0], p1, 0, 0, 0); }
}
template <int VB>
__device__ __forceinline__ void pv_tile(f32x16* o, int vb0, bf16x8 pa0, bf16x8 pa1, bf16x8 pa2, bf16x8 pa3) {
#define TRRD(dst, off) asm volatile("ds_read_b64_tr_b16 %0, %1 offset:%2" : "=&v"(dst) : "v"(vb0), "i"(off) : "memory")
#define PV_D0(d0) do { s16x4 l0, l1, l2, l3, h0, h1, h2, h3; constexpr int b_ = VB * SHM_V + v_rd_off(d0, 0, 0); \
        TRRD(l0, b_); TRRD(h0, b_ + 2048); TRRD(l1, b_ + 4096); TRRD(h1, b_ + 6144); TRRD(l2, b_ + 8192); TRRD(h2, b_ + 10240); TRRD(l3, b_ + 12288); TRRD(h3, b_ + 14336); \
        asm volatile("s_waitcnt lgkmcnt(0)" ::: "memory"); SBAR();   \
        o[d0] = __builtin_amdgcn_mfma_f32_32x32x16_bf16(pa0, (bf16x8){l0[0], l0[1], l0[2], l0[3], h0[0], h0[1], h0[2], h0[3]}, o[d0], 0, 0, 0);   \
        o[d0] = __builtin_amdgcn_mfma_f32_32x32x16_bf16(pa1, (bf16x8){l1[0], l1[1], l1[2], l1[3], h1[0], h1[1], h1[2], h1[3]}, o[d0], 0, 0, 0);   \
        o[d0] = __builtin_amdgcn_mfma_f32_32x32x16_bf16(pa2, (bf16x8){l2[0], l2[1], l2[2], l2[3], h2[0], h2[1], h2[2], h2[3]}, o[d0], 0, 0, 0);   \
        o[d0] = __builtin_amdgcn_mfma_f32_32x32x16_bf16(pa3, (bf16x8){l3[0], l3[1], l3[2], l3[3], h3[0], h3[1], h3[2], h3[3]}, o[d0], 0, 0, 0); } while (0)
    PV_D0(0); PV_D0(1); PV_D0(2); PV_D0(3);
#undef PV_D0
#undef TRRD
}

__device__ __forceinline__ void attn_item(LAS char* lds, const bf16_t* PX, bf16_t* MIX, const float* sink, int qrow0, int kvh, int hp, int nt, int wstart) {
    int tid = threadIdx.x; asm volatile("" : "+v"(tid));
    const int wid = __builtin_amdgcn_readfirstlane(tid >> 6), lane = tid & 63, r32 = lane & 31, hi = lane >> 5;
    const int hq = 4 * kvh + 2 * hp + (wid >> 2);
    const int qw0 = qrow0 + 32 * (wid & 3), qrow = qw0 + r32;
    LAS char* V_lds = lds + OFF_V; LAS char* K_lds = lds + OFF_K;
    LAS float* ws = (LAS float*)(lds + OFF_WS) + wid * 64; LAS float* li_l = ws; LAS float* al_l = ws + 32;
    bf16x8 qr[8];
    { const bf16_t* qp = PX + (size_t)qrow * INW + hq * HD + hi * 8;
#pragma unroll
      for (int d0 = 0; d0 < 8; ++d0) qr[d0] = *(const bf16x8*)(qp + d0 * 16); }
    const int sr = tid >> 4, sc = (tid & 15) * 8, vst0 = v_st(sr, sc), vst1 = v_st(32 + sr, sc), kws = KSWZ(sr, sc * 2);
    const int vb0 = (int)(unsigned)(size_t)V_lds + v_rd_base(lane);
    const bf16_t* Kg = PX + K_LO + kvh * HD + sc; const bf16_t* Vg = PX + V_LO + kvh * HD + sc;
    float m_reg = sink[hq] * (1.0f / SCALE), l_reg = 1.f; f32x16 o[4] = {};
    bf16x8 st_k0, st_k1, st_v0, st_v1;
#define TROW(t_) ((t_) < 4 ? SEQ + 64 * (t_) : wstart + 64 * ((t_) - 4))
#define LOADT(t_) do { const size_t rb_ = (size_t)(TROW(t_) + sr); st_k0 = *(const bf16x8*)(Kg + rb_ * INW); st_k1 = *(const bf16x8*)(Kg + (rb_ + 32) * INW); \
                       st_v0 = *(const bf16x8*)(Vg + rb_ * INW); st_v1 = *(const bf16x8*)(Vg + (rb_ + 32) * INW); } while (0)
#define WRITET(b_) do { *(LAS bf16x8*)(K_lds + (b_) * SHM_K + kws) = st_k0; *(LAS bf16x8*)(K_lds + (b_) * SHM_K + kws + 32 * 256) = st_k1; \
                        *(LAS bf16x8*)(V_lds + (b_) * SHM_V + vst0) = st_v0; *(LAS bf16x8*)(V_lds + (b_) * SHM_V + vst1) = st_v1; } while (0)
#define RESC(a) do { if (__any((a) < 1.f)) { if (hi == 0) al_l[r32] = (a); asm volatile("s_waitcnt lgkmcnt(0)" ::: "memory"); \
        _Pragma("unroll") for (int d_ = 0; d_ < 4; ++d_) _Pragma("unroll") for (int r = 0; r < 16; ++r) o[d_][r] *= al_l[crow(r, hi)]; } } while (0)
#define STEP(B_, t_) do { const int tt_ = (t_); f32x16 p0, p1; float mn, alpha; bf16x8 pa0, pa1, pa2, pa3; \
        if (tt_ + 1 < nt) LOADT(tt_ + 1); \
        SBAR(); qkt<B_>(p0, p1, K_lds, r32, hi, qr); \
        if (tt_ >= 4) mask_tile(p0, p1, qrow + 128 - TROW(tt_) - 4 * hi, 257u); \
        partialSM(p0, p1, m_reg, mn, alpha); RESC(alpha); \
        finishSM(p0, p1, alpha, l_reg, pa0, pa1, pa2, pa3); SBAR(); \
        pv_tile<B_>(o, vb0, pa0, pa1, pa2, pa3); \
        if (tt_ + 1 < nt) WRITET((B_) ^ 1); \
        __syncthreads(); } while (0)
    LOADT(0); WRITET(0); __syncthreads();
    for (int t = 0; t < nt; t += 2) { STEP(0, t); STEP(1, t + 1); }
    if (hi == 0) li_l[r32] = l_reg;
    asm volatile("s_waitcnt lgkmcnt(0)" ::: "memory");
    float rli[16];
#pragma unroll
    for (int r = 0; r < 16; ++r) rli[r] = 1.0f / li_l[crow(r, hi)];
    bf16_t* Ow = MIX + (size_t)qw0 * DM + hq * HD;
#pragma unroll
    for (int r = 0; r < 16; ++r) { const int orow = crow(r, hi);
#pragma unroll
        for (int d0 = 0; d0 < 4; ++d0) { const float v = o[d0][r] * rli[r]; const float vn = __shfl_xor(v, 1);
            if ((r32 & 1) == 0) *(unsigned*)(Ow + (size_t)orow * DM + d0 * 32 + r32) = cvtpk(v, vn); } }
    __syncthreads();
#undef TROW
#undef LOADT
#undef WRITET
#undef RESC
#undef STEP
}
}

#define XB_TMO      128
#define XB_XCNT(j)  (256  + 64 * (j))
#define XB_XSUB(j)  (1280 + 64 * (j))
#define XB_XGEN(j)  (2304 + 64 * (j))
#define XB_TOP      3328
#define XB_TOPGEN   3392
#define XCD_BAR_WORDS 3456
#define XB_SPIN_CAP (1u << 22)
__device__ __forceinline__ unsigned xb_ld(unsigned* p)              { return __hip_atomic_load(p, __ATOMIC_RELAXED, __HIP_MEMORY_SCOPE_AGENT); }
__device__ __forceinline__ unsigned xb_add(unsigned* p, unsigned v) { return __hip_atomic_fetch_add(p, v, __ATOMIC_RELAXED, __HIP_MEMORY_SCOPE_AGENT); }
__device__ __forceinline__ unsigned xb_xcc_id() { return (unsigned)__builtin_amdgcn_s_getreg((3 << 11) | 20) & 0xFu; }
#define XB_SPIN(cond, bar) do { unsigned _sp = 0; while (cond) { __builtin_amdgcn_s_sleep(1); \
    if ((++_sp & 255u) == 0u) { if (xb_ld(&(bar)[XB_TMO])) break; if (_sp > XB_SPIN_CAP) { atomicAdd(&(bar)[XB_TMO], 1u); break; } } } } while (0)
struct XcdBarrier { unsigned* bar; unsigned x; volatile LAS unsigned* st; };
__device__ __forceinline__ XcdBarrier xcd_barrier_post(unsigned* bar, volatile LAS unsigned* st) {
    XcdBarrier b; b.bar = bar; b.x = xb_xcc_id(); b.st = st;
    if (threadIdx.x == 0) (void)xb_add(&bar[XB_XCNT(b.x)], 1u);
    return b;
}
__device__ __forceinline__ void xcd_barrier_complete(unsigned* bar, unsigned x, unsigned& nloc, unsigned& nx) {
    const unsigned G = gridDim.x * gridDim.y * gridDim.z;
    unsigned sum, cnt, mine, sp = 0u;
    for (;;) {
        sum = 0u; cnt = 0u; mine = 0u;
#pragma unroll
        for (unsigned j = 0; j < 16; ++j) { const unsigned c = xb_ld(&bar[XB_XCNT(j)]); sum += c; cnt += (c > 0u) ? 1u : 0u; mine = (j == x) ? c : mine; }
        if (sum == G) break;
        __builtin_amdgcn_s_sleep(1);
        if ((++sp & 255u) == 0u) { if (xb_ld(&bar[XB_TMO])) break; if (sp > XB_SPIN_CAP) { atomicAdd(&bar[XB_TMO], 1u); break; } }
    }
    nloc = mine > 0u ? mine : 1u; nx = cnt > 0u ? cnt : 1u;
}
__device__ __forceinline__ void xcd_barrier(const XcdBarrier& b) {
    asm volatile("s_waitcnt vmcnt(0)" ::: "memory");
    __syncthreads();
    if (threadIdx.x == 0) {
        unsigned* bar = b.bar;
        __builtin_amdgcn_s_waitcnt(0);
        unsigned nloc = b.st[0], nx = b.st[1];
        if (nloc == 0u) { xcd_barrier_complete(bar, b.x, nloc, nx); b.st[0] = nloc; b.st[1] = nx; }
        const unsigned old = xb_add(&bar[XB_XSUB(b.x)], 1u);
        const unsigned gen = old / nloc;
        if (old + 1u == (gen + 1u) * nloc) {
            __builtin_amdgcn_fence(__ATOMIC_RELEASE, "agent");
            asm volatile("s_waitcnt vmcnt(0)" ::: "memory");
            const unsigned og = xb_add(&bar[XB_TOP], 1u);
            const unsigned tg = og / nx;
            if (og + 1u == (tg + 1u) * nx) xb_add(&bar[XB_TOPGEN], 1u);
            else XB_SPIN(xb_ld(&bar[XB_TOPGEN]) == tg, bar);
            __builtin_amdgcn_fence(__ATOMIC_ACQUIRE, "agent");
            xb_add(&bar[XB_XGEN(b.x)], 1u);
            asm volatile("s_waitcnt vmcnt(0)" ::: "memory");
        } else {
            XB_SPIN(xb_ld(&bar[XB_XGEN(b.x)]) == gen, bar);
            __builtin_amdgcn_fence(__ATOMIC_ACQUIRE, "agent");
            asm volatile("s_waitcnt vmcnt(0)" ::: "memory");
        }
    }
    __syncthreads();
}

__device__ __forceinline__ int vcol_qk(int nt) {
    const int d = nt & 127, a = d >> 6, nn = (d >> 5) & 1, b = (d >> 4) & 1, fq = (d >> 2) & 3, e = d & 3;
    return (nt & ~127) + 32 * (2 * a + b) + 8 * fq + 4 * nn + e;
}
template <bool PERMQK, bool BIAS>
__device__ __forceinline__ void transpose_item(const float* W, int K, int N, bf16_t* WT, LAS float* scr, int item, int lane, const float* sh = nullptr, float* bias = nullptr) {
    const int nblk = N / 32, kb = item / nblk, nb = item % nblk, k0 = 64 * kb, n0 = 32 * nb;
#pragma unroll 8
    for (int i = 0; i < 32; ++i) { const int kk = 2 * i + (lane >> 5); scr[kk * 33 + (lane & 31)] = W[(size_t)(k0 + kk) * N + n0 + (lane & 31)]; }
    asm volatile("s_waitcnt lgkmcnt(0)" ::: "memory");
    if (BIAS) {
        const int n = lane & 31, hh = lane >> 5; float sacc = 0.f;
#pragma unroll 8
        for (int i = 0; i < 32; ++i) sacc += scr[(32 * hh + i) * 33 + n] * sh[k0 + 32 * hh + i];
        sacc += __shfl_xor(sacc, 32);
        if (lane < 32) { int nt = n0 + n; if (PERMQK && nt < K_LO + 512) nt = vcol_qk(nt); atomicAdd(bias + nt, sacc); }
    }
    const int c = lane & 7;
#pragma unroll
    for (int j = 0; j < 4; ++j) { const int n = (lane >> 3) + 8 * j; const LAS float* s = scr + (8 * c) * 33 + n;
        u32x4 o; o.x = pk2(s[0 * 33], s[1 * 33]); o.y = pk2(s[2 * 33], s[3 * 33]); o.z = pk2(s[4 * 33], s[5 * 33]); o.w = pk2(s[6 * 33], s[7 * 33]);
        int nt = n0 + n;
        if (PERMQK && nt < K_LO + 512) nt = vcol_qk(nt);
        *(u32x4*)(WT + (size_t)nt * K + k0 + 8 * c) = o; }
    asm volatile("s_waitcnt lgkmcnt(0)" ::: "memory");
}

__device__ __forceinline__ void norm_mod_row(const float* xrow, const float* g, const float* sc, const float* sh, bf16_t* orow, int lane) {
    const f32x4* xr = (const f32x4*)xrow + lane;
    f32x4 v[16]; float s = 0.f;
#pragma unroll
    for (int j = 0; j < 16; ++j) { v[j] = xr[64 * j]; s += (v[j].x * v[j].x + v[j].y * v[j].y) + (v[j].z * v[j].z + v[j].w * v[j].w); }
    const float rstd = 1.0f / sqrtf(wave_sum(s) * (1.0f / DM) + EPS);
    u32x2* o8 = (u32x2*)orow + lane;
#pragma unroll
    for (int j = 0; j < 16; ++j) { const f32x4 gg = ((const f32x4*)g)[lane + 64 * j], ss = ((const f32x4*)sc)[lane + 64 * j], hh = ((const f32x4*)sh)[lane + 64 * j];
        const f32x4 y = (v[j] * rstd) * gg * (ss + 1.0f) + hh; o8[64 * j] = pg8::pack4(y); }
}

template <int NKS>
__device__ __forceinline__ void ctx_fold_norm_row(LAS float* red, const float* xrow, float* xout, const float* slab, size_t kstride, const float* gate,
                                                  const float* g, const float* sc, const float* sh, bf16_t* orow, int lane, int wave) {
    f32x4 v[2]; float s = 0.f;
#pragma unroll
    for (int q = 0; q < 2; ++q) { const int idx = lane + 64 * (2 * wave + q);
        f32x4 a = (f32x4){0.f, 0.f, 0.f, 0.f};
#pragma unroll
        for (int ks = 0; ks < NKS; ++ks) a += ((const f32x4*)(slab + (size_t)ks * kstride))[idx];
        v[q] = ((const f32x4*)xrow)[idx] + ((const f32x4*)gate)[idx] * a;
        ((f32x4*)xout)[idx] = v[q];
        s += (v[q].x * v[q].x + v[q].y * v[q].y) + (v[q].z * v[q].z + v[q].w * v[q].w); }
    s = wave_sum(s);
    if (lane == 0) red[wave] = s;
    __syncthreads();
    float tot = 0.f;
#pragma unroll
    for (int w = 0; w < 8; ++w) tot += red[w];
    const float rstd = 1.0f / sqrtf(tot * (1.0f / DM) + EPS);
#pragma unroll
    for (int q = 0; q < 2; ++q) { const int idx = lane + 64 * (2 * wave + q);
        const f32x4 gg = ((const f32x4*)g)[idx], ss = ((const f32x4*)sc)[idx], hh = ((const f32x4*)sh)[idx];
        const f32x4 y = (v[q] * rstd) * gg * (ss + 1.0f) + hh; ((u32x2*)orow)[idx] = pg8::pack4(y); }
    __syncthreads();
}
__device__ __forceinline__ void scale_row(const float* xrow, const float* gam, bf16_t* orow, float* ss, int lane) {
    const f32x4* xr = (const f32x4*)xrow + lane; u32x2* o8 = (u32x2*)orow + lane; float s = 0.f;
#pragma unroll
    for (int j = 0; j < 16; ++j) { const f32x4 v = xr[64 * j]; s += (v.x * v.x + v.y * v.y) + (v.z * v.z + v.w * v.w);
        o8[64 * j] = pg8::pack4(v * ((const f32x4*)gam)[lane + 64 * j]); }
    s = wave_sum(s);
    if (lane == 0) *ss = s;
}
__device__ __forceinline__ void norm_final_row(const float* xrow, const float* g, float* orow, int lane) {
    const f32x4* xr = (const f32x4*)xrow + lane;
    f32x4 v[16]; float s = 0.f;
#pragma unroll
    for (int j = 0; j < 16; ++j) { v[j] = xr[64 * j]; s += (v[j].x * v[j].x + v[j].y * v[j].y) + (v[j].z * v[j].z + v[j].w * v[j].w); }
    const float rstd = 1.0f / sqrtf(wave_sum(s) * (1.0f / DM) + EPS);
    f32x4* o = (f32x4*)orow + lane;
#pragma unroll
    for (int j = 0; j < 16; ++j) { const f32x4 gg = ((const f32x4*)g)[lane + 64 * j]; o[64 * j] = (v[j] * rstd) * gg; }
}
__device__ __forceinline__ void mixnorm_row(bf16_t* row, const float* ga, const float* gf, int lane) {
    u32x4* p = (u32x4*)row + lane;
    u32x4 w[8]; float sa = 0.f, sf = 0.f;
#pragma unroll
    for (int i = 0; i < 8; ++i) { w[i] = p[64 * i];
        float s = 0.f;
#pragma unroll
        for (int e = 0; e < 4; ++e) { const float lo = __builtin_bit_cast(float, w[i][e] << 16), hi = __builtin_bit_cast(float, w[i][e] & 0xffff0000u); s += lo * lo + hi * hi; }
        if (i < 4) sa += s; else sf += s; }
    const float ra = 1.0f / sqrtf(wave_sum(sa) * (1.0f / QW) + EPS), rf = 1.0f / sqrtf(wave_sum(sf) * (1.0f / FW) + EPS);
#pragma unroll
    for (int i = 0; i < 8; ++i) { const float rs = i < 4 ? ra : rf; const float* g = (i < 4 ? ga + 512 * i : gf + 512 * (i - 4)) + 8 * lane;
        const f32x4 g0 = *(const f32x4*)g, g1 = *(const f32x4*)(g + 4);
        u32x4 o;
#pragma unroll
        for (int e = 0; e < 4; ++e) { const float lo = __builtin_bit_cast(float, w[i][e] << 16), hi = __builtin_bit_cast(float, w[i][e] & 0xffff0000u);
            const float glo = e < 2 ? g0[2 * e] : g1[2 * e - 4], ghi = e < 2 ? g0[2 * e + 1] : g1[2 * e - 3];
            o[e] = cvt_pk_bf16(lo * rs * glo, hi * rs * ghi); }
        p[64 * i] = o; }
}

struct Args {
    const float* x; const float* c; const float* ctx; const float* c_ctx; const float* ada_a; const float* ada_b; const float* ada_bias; const float* g_mix;
    const float* w_in; const float* sink; const float* w_f; const float* g_attn; const float* g_four; const float* w_out; const float* g_mlp; const float* w1; const float* w2; const float* g_final;
    float* out; unsigned char* ws; int ph_lo, ph_hi;
};
constexpr int NPH_PRO = 3, NPH_LAYER = 12, NPH = NPH_PRO + DEPTH * NPH_LAYER + 1;

__global__ void __launch_bounds__(NWAVES * 64, 2) fwd_kernel(Args args) {
    extern __shared__ __attribute__((aligned(16))) unsigned char lds_raw[];
    LAS unsigned char* lds = (LAS unsigned char*)lds_raw;
    const int G = gridDim.x, bx = blockIdx.x, NGW = G * NWAVES;
#define LANEVARS int tid = threadIdx.x; asm volatile("" : "+v"(tid)); const int lane = tid & 63, wave = __builtin_amdgcn_readfirstlane(tid >> 6), gw = bx * NWAVES + wave; (void)lane; (void)gw;
    unsigned char* ws = args.ws;
    unsigned* ctl = (unsigned*)(ws + WS_CTL);
    float* MOD = (float*)(ws + WS_MOD); float* TPART = (float*)(ws + WS_TPART);
    float* COS = (float*)(ws + WS_ROPE); float* SIN = COS + 256 * 32;
    f32x2* TW = (f32x2*)(ws + WS_TW);
    bf16_t* FM1 = (bf16_t*)(ws + WS_FM1); bf16_t* FM2 = (bf16_t*)(ws + WS_FM2); bf16_t* FC = (bf16_t*)(ws + WS_FC); bf16_t* CS = (bf16_t*)(ws + WS_CS);
    bf16_t* WFRAW = (bf16_t*)(ws + WS_WFRAW); bf16_t* WFT = (bf16_t*)(ws + WS_WFT);
    bf16_t* WIN = (bf16_t*)(ws + WS_WIN); bf16_t* WOUT = (bf16_t*)(ws + WS_WOUT); bf16_t* W1T = (bf16_t*)(ws + WS_W1); bf16_t* W2T = (bf16_t*)(ws + WS_W2);
    float* GAM = (float*)(ws + WS_GAM); float* BIASIN = (float*)(ws + WS_BIASIN); float* BIAS1 = (float*)(ws + WS_BIAS1); float* SSQ = (float*)(ws + WS_SS);
    float* XW = (float*)(ws + WS_XW); bf16_t* HX = (bf16_t*)(ws + WS_HX); bf16_t* PX = (bf16_t*)(ws + WS_PX); bf16_t* MIX = (bf16_t*)(ws + WS_MIX);
    bf16_t* ZT2 = (bf16_t*)(ws + WS_ZT2); bf16_t* Y2 = (bf16_t*)(ws + WS_Y2); bf16_t* ZTC = (bf16_t*)(ws + WS_ZTC); bf16_t* HB = (bf16_t*)(ws + WS_H);

    for (int u = threadIdx.x; u < (LDS_BYTES - LDSCTL_OFF) / 4; u += NWAVES * 64) ((LAS unsigned*)(lds + LDSCTL_OFF))[u] = 0u;
    __syncthreads();
#if MK_PER_PHASE
#define GRID_BAR() do { } while (0)
#else
    XcdBarrier bar = xcd_barrier_post(ctl + CW_BAR, (volatile LAS unsigned*)(lds + MISC_OFF) + 8);
#define GRID_BAR() xcd_barrier(bar)
#endif
    const int lo = args.ph_lo, hi = args.ph_hi;
#ifndef SITEMASK
#define SITEMASK 0xFFFF
#endif
#define EN(s) (((SITEMASK) >> (s)) & 1)
#ifndef REPMASK
#define REPMASK 0
#endif
#ifndef REPLMIN
#define REPLMIN 0
#endif
#ifndef REPCOUNT
#define REPCOUNT 2
#endif
#define NREP0(s) ((((REPMASK) >> (s)) & 1) ? REPCOUNT : 1)
#ifndef REPLMAX
#define REPLMAX 99
#endif
#define NREP(s) (((((REPMASK) >> (s)) & 1) && l >= REPLMIN && l <= REPLMAX) ? REPCOUNT : 1)
#define IN(k) (lo <= (k) && (k) < hi)
#define SEAM(k) do { if (IN(k) && IN((k) + 1)) GRID_BAR(); } while (0)

    for (int rep = 0; rep < NREP0(0); ++rep) if (EN(0) && IN(0)) {
        LANEVARS
        for (int it = bx; it < DEPTH * 16 * 4; it += G) {
            const int l = it >> 6, rc = (it >> 2) & 15, dp = it & 3, rr = tid & 31, dg = tid >> 5;
            float s0 = 0.f, s1 = 0.f;
            const float* ap = args.ada_a + (size_t)l * DM * ARANK + rc * 32 + rr;
            for (int i = 0; i < 64; ++i) { const int d = dp * 1024 + dg + 16 * i; const float av = ap[(size_t)d * ARANK];
                const float c0 = args.c[d], c1 = args.c_ctx[d];
                s0 += (c0 / (1.0f + __expf(-c0))) * av; s1 += (c1 / (1.0f + __expf(-c1))) * av; }
            LAS float* red = (LAS float*)lds;
            red[(dg * 32 + rr) * 2 + 0] = s0; red[(dg * 32 + rr) * 2 + 1] = s1;
            __syncthreads();
            if (tid < 64) { const int r2 = tid & 31, v = tid >> 5; float s = 0.f;
                for (int q = 0; q < 16; ++q) s += red[(q * 32 + r2) * 2 + v];
                TPART[((l * 4 + dp) * 2 + v) * ARANK + rc * 32 + r2] = s; }
            __syncthreads();
        }
        const int gt = bx * (NWAVES * 64) + tid, NT = G * NWAVES * 64;
        for (int i = gt; i < DEPTH * 2 * SEQ; i += NT) SSQ[i] = 0.f;
        for (int i = gt; i < DEPTH * INW; i += NT) BIASIN[i] = 0.f;
        for (int i = gt; i < DEPTH * DFF; i += NT) BIAS1[i] = 0.f;
        for (int i = gt; i < 256 * 32; i += NT) { const int pos = i >> 5, j = i & 31;
            const float inv = __builtin_amdgcn_exp2f(-(float)j * (13.287712379549449f / 32.0f));
            const float rev = (float)pos * inv * 0.15915494309189535f;
            COS[i] = cos_rev(rev); SIN[i] = sin_rev(rev); }
        for (int i = gt; i < 16384; i += NT) { const float rev = (float)i * (1.0f / 16384.0f); TW[i] = (f32x2){cos_rev(rev), sin_rev(rev)}; }
        for (int i = gt; i < 256 * 256; i += NT) { const int m = i >> 8, k = i & 255, ro = m >> 7, kk = m & 127, ri = k >> 7, ll = k & 127;
            const float rev = (float)((kk * ll) & 127) * (1.0f / 128.0f); const float cv = cos_rev(rev) * 0.08838834764831845f, sv = sin_rev(rev) * 0.08838834764831845f;
            FM1[i] = (bf16_t)f2bf(ro == 0 ? (ri == 0 ? cv : sv) : (ri == 0 ? -sv : cv));
            FM2[i] = (bf16_t)f2bf(ro == 0 ? (ri == 0 ? cv : sv) : 0.f); }
        for (int i = gt; i < 256 * 512; i += NT) { const int k = i >> 9, q = i & 511, ri = q >> 8, ll = q & 255;
            const float rev = (float)((k * ll) & 255) * (1.0f / 256.0f);
            FC[i] = (bf16_t)f2bf((ri == 0 ? cos_rev(rev) : sin_rev(rev)) * 0.0625f); }
        for (int i = gt; i < 1024 * 512; i += NT) { const int n = i >> 9, m = i & 511, ri = n >> 9, cch = n & 511;
            const float rev = (float)((cch * m) & 511) * (1.0f / 512.0f);
            CS[i] = (bf16_t)f2bf((ri == 0 ? cos_rev(rev) : -sin_rev(rev)) * 0.04419417382415922f); }
    }
    SEAM(0);
    if (EN(1) && IN(1)) {
        LANEVARS
        for (int it = bx; it < DEPTH * 96; it += G) {
            const int l = it / 96, jc = it - l * 96;
            LAS float* tl = (LAS float*)lds;
            LAS float* red = tl + 1024;
            for (int q = tid; q < 1024; q += NWAVES * 64) { const int v = q >> 9, r = q & 511; float s = 0.f;
                for (int dp = 0; dp < 4; ++dp) s += TPART[((l * 4 + dp) * 2 + v) * ARANK + r];
                tl[q] = s; }
            __syncthreads();
            const int th = tid >> 8, jj = tid & 255, j = jc * 256 + jj;
            const float* bp = args.ada_b + (size_t)l * ARANK * (NMOD * DM) + j;
            float s0 = 0.f, s1 = 0.f;
#pragma unroll 8
            for (int r = th * 256; r < th * 256 + 256; ++r) { const float bv = bp[(size_t)r * (NMOD * DM)]; s0 += tl[r] * bv; s1 += tl[512 + r] * bv; }
            red[(th * 256 + jj) * 2 + 0] = s0; red[(th * 256 + jj) * 2 + 1] = s1;
            __syncthreads();
            if (tid < 256) { const float bias = args.ada_bias[(size_t)l * (NMOD * DM) + j];
                const float m0 = bias + red[(0 * 256 + jj) * 2 + 0] + red[(1 * 256 + jj) * 2 + 0];
                MOD[(size_t)(l * 2 + 0) * (NMOD * DM) + j] = m0;
                if (j >= 1 * DM && j < 2 * DM) GAM[(size_t)(l * 2 + 0) * DM + (j - 1 * DM)] = args.g_mix[(size_t)l * DM + (j - 1 * DM)] * (1.0f + m0);
                if (j >= 4 * DM && j < 5 * DM) GAM[(size_t)(l * 2 + 1) * DM + (j - 4 * DM)] = args.g_mlp[(size_t)l * DM + (j - 4 * DM)] * (1.0f + m0);
                MOD[(size_t)(l * 2 + 1) * (NMOD * DM) + j] = bias + red[(0 * 256 + jj) * 2 + 1] + red[(1 * 256 + jj) * 2 + 1]; }
            __syncthreads();
        }
    }
    SEAM(1);
    for (int rep = 0; rep < NREP0(15); ++rep) if (EN(15) && IN(2)) {
        LANEVARS
        LAS float* scr = (LAS float*)(lds + wave * 16384);
        constexpr int I_IN = (DM / 64) * (INW / 32), I_OUT = (DM / 64) * (DM / 32), I_1 = (DM / 64) * (DFF / 32), I_2 = (DFF / 64) * (DM / 32), I_F = (512 / 64) * (512 / 32);
        constexpr int PER_L = I_IN + I_OUT + I_1 + I_2 + 4 * I_F, NITEMS = DEPTH * PER_L;
        for (int it = gw; it < NITEMS; it += NGW) {
            const int l = it / PER_L; int r = it - l * PER_L;
            const float* modl = MOD + (size_t)(l * 2 + 0) * (NMOD * DM);
            if (r < I_IN) { transpose_item<true, true>(args.w_in + (size_t)l * DM * INW, DM, INW, WIN + (size_t)l * INW * DM, scr, r, lane, modl + 0 * DM, BIASIN + (size_t)l * INW); continue; } r -= I_IN;
            if (r < I_OUT) { transpose_item<false, false>(args.w_out + (size_t)l * DM * DM, DM, DM, WOUT + (size_t)l * DM * DM, scr, r, lane); continue; } r -= I_OUT;
            if (r < I_1) { transpose_item<false, true>(args.w1 + (size_t)l * DM * DFF, DM, DFF, W1T + (size_t)l * DFF * DM, scr, r, lane, modl + 3 * DM, BIAS1 + (size_t)l * DFF); continue; } r -= I_1;
            if (r < I_2) { transpose_item<false, false>(args.w2 + (size_t)l * DFF * DM, DFF, DM, W2T + (size_t)l * DM * DFF, scr, r, lane); continue; } r -= I_2;
            const int gq = r / I_F; r -= gq * I_F;
            transpose_item<false, false>(args.w_f + (size_t)(l * 4 + gq) * 512 * 512, 512, 512, WFRAW + (size_t)(l * 4 + gq) * 512 * 512, scr, r, lane);
        }
    }
    SEAM(2);

    float* SLAB = (float*)(ws + WS_SLAB); float* XB = (float*)(ws + WS_XB);
    float* XWC = XW + (size_t)SEQ * DM;
    for (int l = 0; l < DEPTH; ++l) {
        const int pb = NPH_PRO + l * NPH_LAYER;
        const bool cact = (l != DEPTH - 1);
        const float* modl = MOD + (size_t)(l * 2 + 0) * (NMOD * DM);
        const float* modc = MOD + (size_t)(l * 2 + 1) * (NMOD * DM);
        const float* xlat = l == 0 ? args.x : XW;
        for (int rep = 0; rep < NREP(2); ++rep) if (EN(2) && IN(pb + 0)) {
            LANEVARS
            const float* g = args.g_mix + (size_t)l * DM;
            if (l == 0) {
                for (int m = gw; m < SEQ; m += NGW) scale_row(args.x + (size_t)m * DM, GAM, HX + (size_t)m * DM, SSQ + m, lane);
                for (int r = gw; r < CTX; r += NGW) norm_mod_row(args.ctx + (size_t)r * DM, g, modc + 1 * DM, modc + 0 * DM, HX + (size_t)(SEQ + r) * DM, lane);
                __syncthreads();
                { pg8::Gemm gg{512, 1024u, 1024u, (size_t)128 * 1024, (size_t)128 * 1024};
                  pg8::SchedWf S{G, bx, (const char*)WFRAW, (const char*)CS}; pg8::EpiWf E{WFT};
                  pg8::gemm_phase<pg8::EpiWf, pg8::SchedWf>(lds, gg, S, E); }
            } else { for (int r = bx; r < CTX; r += G)
                       ctx_fold_norm_row<16>((LAS float*)lds, XWC + (size_t)r * DM, XWC + (size_t)r * DM, SLAB + (size_t)r * DM, (size_t)256 * DM, modc - 2 * (NMOD * DM) + 5 * DM,
                                             g, modc + 1 * DM, modc + 0 * DM, HX + (size_t)(SEQ + r) * DM, lane, wave); }
        }
        SEAM(pb + 0);
        for (int rep = 0; rep < NREP(3); ++rep) if (EN(3) && IN(pb + 1)) {
            { pg8::Gemm g{DM, (unsigned)(DM * 2), (unsigned)(DM * 2), (size_t)128 * DM * 2, (size_t)128 * DM * 2};
              pg8::SchedStd S; S.init(SEQ / 256, INW / 256, G, bx, HX, (size_t)256 * DM * 2, WIN + (size_t)l * INW * DM, (size_t)256 * DM * 2);
              pg8::EpiInproj E{PX, COS, SIN, SSQ + (size_t)(l * 2 + 0) * SEQ, BIASIN + (size_t)l * INW};
              pg8::gemm_phase<pg8::EpiInproj, pg8::SchedStd>(lds, g, S, E); }
            { const int nks = cact ? 8 : 16, kp = DM / nks, ntile = cact ? 20 : 4, pn0 = cact ? 0 : 8;
              pg8::Gemm g{kp, (unsigned)(DM * 2), (unsigned)(DM * 2), (size_t)128 * DM * 2, (size_t)128 * DM * 2};
              pg8::SchedPiece S{G, bx, ntile * nks, nks, pn0, (const char*)(HX + (size_t)SEQ * DM), (const char*)(WIN + (size_t)l * INW * DM), (size_t)256 * DM * 2, (size_t)kp * 2};
              pg8::EpiSlab E{SLAB, INW};
              pg8::gemm_phase<pg8::EpiSlab, pg8::SchedPiece>(lds, g, S, E); }
        }
        SEAM(pb + 1);
        for (int rep = 0; rep < NREP(4); ++rep) if (EN(4) && IN(pb + 2)) {
            LANEVARS
            const int nks = cact ? 8 : 16, c4lo = cact ? 0 : K_LO / 4, c4n = cact ? INW / 4 : 1024 / 4;
            for (int i = bx * (NWAVES * 64) + tid; i < 256 * c4n; i += G * NWAVES * 64) {
                const int r = i / c4n, cv = (c4lo + i % c4n) * 4;
                f32x4 a = (f32x4){0.f, 0.f, 0.f, 0.f};
                for (int ks = 0; ks < nks; ++ks) a += *(const f32x4*)(SLAB + ((size_t)ks * 256 + r) * INW + cv);
                int ct = cv;
                if (cv < K_LO + 512) { const int v = cv & 127, wc = v >> 5, fq = (v >> 3) & 3, n = (v >> 2) & 1; ct = (cv & ~127) + 64 * (wc >> 1) + 32 * n + 16 * (wc & 1) + 4 * fq; }
                *(u32x2*)(PX + (size_t)(SEQ + r) * INW + ct) = pg8::pack4(a);
            }
        }
        SEAM(pb + 2);
        for (int rep = 0; rep < NREP(5); ++rep) if (EN(5) && IN(pb + 3)) {
            const float* sk = args.sink + l * NHEAD;
            const int nitems = cact ? 1040 : 1024;
            for (int it = bx; it < nitems; it += G) {
                int qrow0, ntile, w0; const int kvh = (it >> 1) & 3, hp = it & 1;
                if (it < 1024) { const int n = it >> 3; w0 = n == 0 ? 0 : 128 * (n - 1); const int w1 = n == 127 ? SEQ : 128 * (n + 2); qrow0 = 128 * n; ntile = 4 + (w1 - w0) / 64; }
                else { qrow0 = SEQ + 128 * ((it - 1024) >> 3); ntile = 4; w0 = 0; }
                att::attn_item((LAS char*)lds, PX, MIX, sk, qrow0, kvh, hp, ntile, w0);
            }
            { pg8::Gemm g{512, 2048u, (unsigned)(128 * INW * 2), (size_t)128 * 2048, (size_t)INW * 2};
              pg8::SchedGa S{G, bx, (const char*)(WFT + (size_t)l * 4 * 512 * 1024), (const char*)(PX + F_LO)}; pg8::EpiGa E{ZT2};
              pg8::gemm_phase<pg8::EpiGa, pg8::SchedGa>(lds, g, S, E); }
            if (cact) {
              pg8::Gemm g{512, 2048u, (unsigned)(INW * 2), (size_t)128 * 2048, (size_t)128 * INW * 2};
              pg8::SchedGaCtx S{G, bx, (const char*)(WFT + (size_t)l * 4 * 512 * 1024), (const char*)(PX + F_LO)}; pg8::EpiGaCtx E{ZTC};
              pg8::gemm_phase<pg8::EpiGaCtx, pg8::SchedGaCtx>(lds, g, S, E); }
        }
        SEAM(pb + 3);
        for (int rep = 0; rep < NREP(6); ++rep) if (EN(6) && IN(pb + 4)) {
            { pg8::Gemm g{256, 512u, 512u, (size_t)128 * 512, (size_t)128 * 512};
              pg8::SchedN S{G, bx, 1024, (const char*)FM1, (const char*)ZT2, (size_t)256 * 512}; pg8::EpiGb E{Y2, TW};
              pg8::gemm_phase<pg8::EpiGb, pg8::SchedN>(lds, g, S, E); }
            if (cact) {
              pg8::Gemm g{512, 1024u, 1024u, (size_t)128 * 1024, (size_t)128 * 1024};
              pg8::SchedN S{G, bx, 8, (const char*)FC, (const char*)ZTC, (size_t)256 * 1024}; pg8::EpiGctx E{MIX};
              pg8::gemm_phase<pg8::EpiGctx, pg8::SchedN>(lds, g, S, E); }
        }
        SEAM(pb + 4);
        for (int rep = 0; rep < NREP(7); ++rep) if (EN(7) && IN(pb + 5)) {
            pg8::Gemm g{256, 512u, 512u, (size_t)128 * 512, (size_t)128 * 512};
            pg8::SchedN S{G, bx, 1024, (const char*)FM2, (const char*)Y2, (size_t)256 * 512}; pg8::EpiGc E{MIX};
            pg8::gemm_phase<pg8::EpiGc, pg8::SchedN>(lds, g, S, E);
        }
        SEAM(pb + 5);
        if (EN(8) && IN(pb + 6)) {
            LANEVARS
            const int nrows = cact ? MT : SEQ;
            for (int m = gw; m < nrows; m += NGW) mixnorm_row(MIX + (size_t)m * DM, args.g_attn + (size_t)l * QW, args.g_four + (size_t)l * FW, lane);
        }
        SEAM(pb + 6);
        for (int rep = 0; rep < NREP(9); ++rep) if (EN(9) && IN(pb + 7)) {
            { pg8::Gemm g{DM, (unsigned)(DM * 2), (unsigned)(DM * 2), (size_t)128 * DM * 2, (size_t)128 * DM * 2};
              pg8::SchedStd S; S.init(SEQ / 256, DM / 256, G, bx, MIX, (size_t)256 * DM * 2, WOUT + (size_t)l * DM * DM, (size_t)256 * DM * 2);
              pg8::EpiResid E{xlat, XB, modl + 2 * DM, GAM + (size_t)(l * 2 + 1) * DM, HX, SSQ + (size_t)(l * 2 + 1) * SEQ};
              pg8::gemm_phase<pg8::EpiResid, pg8::SchedStd>(lds, g, S, E); }
            if (cact) {
              pg8::Gemm g{512, (unsigned)(DM * 2), (unsigned)(DM * 2), (size_t)128 * DM * 2, (size_t)128 * DM * 2};
              pg8::SchedPiece S{G, bx, 16 * 8, 8, 0, (const char*)(MIX + (size_t)SEQ * DM), (const char*)(WOUT + (size_t)l * DM * DM), (size_t)256 * DM * 2, (size_t)512 * 2};
              pg8::EpiSlab E{SLAB, DM};
              pg8::gemm_phase<pg8::EpiSlab, pg8::SchedPiece>(lds, g, S, E); }
        }
        SEAM(pb + 7);
        for (int rep = 0; rep < NREP(10); ++rep) if (EN(10) && IN(pb + 8)) {
            LANEVARS
            const float* g = args.g_mlp + (size_t)l * DM;
            if (cact) { for (int r = bx; r < CTX; r += G)
                            ctx_fold_norm_row<8>((LAS float*)lds, (l == 0 ? args.ctx : XWC) + (size_t)r * DM, XWC + (size_t)r * DM, SLAB + (size_t)r * DM, (size_t)256 * DM, modc + 2 * DM,
                                                 g, modc + 4 * DM, modc + 3 * DM, HX + (size_t)(SEQ + r) * DM, lane, wave); }
        }
        SEAM(pb + 8);
        for (int rep = 0; rep < NREP(11); ++rep) if (EN(11) && IN(pb + 9)) {
            { pg8::Gemm g{DM, (unsigned)(DM * 2), (unsigned)(DM * 2), (size_t)128 * DM * 2, (size_t)128 * DM * 2};
              pg8::SchedStd S; S.init(SEQ / 256, DFF / 256, G, bx, HX, (size_t)256 * DM * 2, W1T + (size_t)l * DFF * DM, (size_t)256 * DM * 2);
              pg8::EpiRelu2 E{HB, SSQ + (size_t)(l * 2 + 1) * SEQ, BIAS1 + (size_t)l * DFF};
              pg8::gemm_phase<pg8::EpiRelu2, pg8::SchedStd>(lds, g, S, E); }
            if (cact) {
              pg8::Gemm g{1024, (unsigned)(DM * 2), (unsigned)(DM * 2), (size_t)128 * DM * 2, (size_t)128 * DM * 2};
              pg8::SchedPiece S{G, bx, 64 * 4, 4, 0, (const char*)(HX + (size_t)SEQ * DM), (const char*)(W1T + (size_t)l * DFF * DM), (size_t)256 * DM * 2, (size_t)1024 * 2};
              pg8::EpiSlab E{SLAB, DFF};
              pg8::gemm_phase<pg8::EpiSlab, pg8::SchedPiece>(lds, g, S, E); }
        }
        SEAM(pb + 9);
        if (EN(12) && IN(pb + 10) && cact) {
            LANEVARS
            for (int i = bx * (NWAVES * 64) + tid; i < 256 * (DFF / 4); i += G * NWAVES * 64) {
                const int r = i / (DFF / 4), c4 = (i % (DFF / 4)) * 4;
                f32x4 a = (f32x4){0.f, 0.f, 0.f, 0.f};
#pragma unroll
                for (int ks = 0; ks < 4; ++ks) a += *(const f32x4*)(SLAB + ((size_t)ks * 256 + r) * DFF + c4);
#pragma unroll
                for (int e = 0; e < 4; ++e) { const float t = fmaxf(a[e], 0.f); a[e] = t * t; }
                *(u32x2*)(HB + (size_t)(SEQ + r) * DFF + c4) = pg8::pack4(a);
            }
        }
        SEAM(pb + 10);
        for (int rep = 0; rep < NREP(13); ++rep) if (EN(13) && IN(pb + 11)) {
            { pg8::Gemm g{DFF, (unsigned)(DFF * 2), (unsigned)(DFF * 2), (size_t)128 * DFF * 2, (size_t)128 * DFF * 2};
              pg8::SchedStd S; S.init(SEQ / 256, DM / 256, G, bx, HB, (size_t)256 * DFF * 2, W2T + (size_t)l * DM * DFF, (size_t)256 * DFF * 2);
              pg8::EpiResid E{XB, XW, modl + 5 * DM, l < DEPTH - 1 ? GAM + (size_t)((l + 1) * 2 + 0) * DM : nullptr, HX, SSQ + (size_t)((l + 1 < DEPTH ? l + 1 : l) * 2 + 0) * SEQ};
              pg8::gemm_phase<pg8::EpiResid, pg8::SchedStd>(lds, g, S, E); }
            if (cact) {
              pg8::Gemm g{1024, (unsigned)(DFF * 2), (unsigned)(DFF * 2), (size_t)128 * DFF * 2, (size_t)128 * DFF * 2};
              pg8::SchedPiece S{G, bx, 16 * 16, 16, 0, (const char*)(HB + (size_t)SEQ * DFF), (const char*)(W2T + (size_t)l * DM * DFF), (size_t)256 * DFF * 2, (size_t)1024 * 2};
              pg8::EpiSlab E{SLAB, DM};
              pg8::gemm_phase<pg8::EpiSlab, pg8::SchedPiece>(lds, g, S, E); }
        }
        SEAM(pb + 11);
    }
    if (EN(14) && IN(NPH - 1)) {
        LANEVARS
        for (int m = gw; m < SEQ; m += NGW) norm_final_row(XW + (size_t)m * DM, args.g_final, args.out + (size_t)m * DM, lane);
    }
#undef IN
#undef SEAM
#undef GRID_BAR
}

extern "C" void kernel_launch(void* const* d_in, const int* in_sizes, int n_in, void* d_out, int out_size, void* d_ws, size_t ws_size, hipStream_t stream) {
    static int grid = 0;
    if (grid == 0) {
        if (n_in != 18 || out_size != SEQ * DM || ws_size < WS_END) { fprintf(stderr, "kernel_launch: unexpected shapes: n_in %d out %d ws %zu (need %zu)\n", n_in, out_size, ws_size, (size_t)WS_END); grid = -1; return; }
        int dev = 0, cus = 0, per_cu = 0;
        if (hipGetDevice(&dev) != hipSuccess || hipDeviceGetAttribute(&cus, hipDeviceAttributeMultiprocessorCount, dev) != hipSuccess) { grid = -1; return; }
        if (hipFuncSetAttribute((const void*)fwd_kernel, hipFuncAttributeMaxDynamicSharedMemorySize, LDS_BYTES) != hipSuccess) { fprintf(stderr, "kernel_launch: hipFuncSetAttribute failed\n"); grid = -1; return; }
        if (hipOccupancyMaxActiveBlocksPerMultiprocessor(&per_cu, (const void*)fwd_kernel, NWAVES * 64, LDS_BYTES) != hipSuccess || per_cu < 1) { fprintf(stderr, "kernel_launch: occupancy query says %d\n", per_cu); }
        (void)hipGetLastError();
        grid = cus;
    }
    if (grid < 0) return;
    (void)hipMemsetAsync((char*)d_ws + WS_CTL, 0, CTL_ZERO_BYTES, stream);
    Args a{};
    a.x = (const float*)d_in[0]; a.c = (const float*)d_in[1]; a.ctx = (const float*)d_in[2]; a.c_ctx = (const float*)d_in[3];
    a.ada_a = (const float*)d_in[4]; a.ada_b = (const float*)d_in[5]; a.ada_bias = (const float*)d_in[6]; a.g_mix = (const float*)d_in[7];
    a.w_in = (const float*)d_in[8]; a.sink = (const float*)d_in[9]; a.w_f = (const float*)d_in[10]; a.g_attn = (const float*)d_in[11];
    a.g_four = (const float*)d_in[12]; a.w_out = (const float*)d_in[13]; a.g_mlp = (const float*)d_in[14]; a.w1 = (const float*)d_in[15];
    a.w2 = (const float*)d_in[16]; a.g_final = (const float*)d_in[17];
    a.out = (float*)d_out; a.ws = (unsigned char*)d_ws;
#if MK_PER_PHASE
    for (int p = 0; p < NPH; ++p) { a.ph_lo = p; a.ph_hi = p + 1; hipLaunchKernelGGL(fwd_kernel, dim3(grid), dim3(NWAVES * 64), LDS_BYTES, stream, a); }
#else
    a.ph_lo = 0; a.ph_hi = NPH;
    hipLaunchKernelGGL(fwd_kernel, dim3(grid), dim3(NWAVES * 64), LDS_BYTES, stream, a);
#endif
    const hipError_t le = hipPeekAtLastError();
    if (le != hipSuccess) fprintf(stderr, "kernel_launch: launch failed: %s\n", hipGetErrorName(le));
}
```

```cpp
#include <hip/hip_runtime.h>
#include <cstdio>
#include <cstdint>

#ifndef MK_PER_PHASE
#define MK_PER_PHASE 0
#endif

#define LAS __attribute__((address_space(3)))
typedef unsigned short bf16_t;
typedef short bf16x8 __attribute__((ext_vector_type(8)));
typedef short s16x4 __attribute__((ext_vector_type(4)));
typedef float f32x2 __attribute__((ext_vector_type(2)));
typedef float f32x4 __attribute__((ext_vector_type(4)));
typedef float f32x16 __attribute__((ext_vector_type(16)));
typedef unsigned u32x2 __attribute__((ext_vector_type(2)));
typedef unsigned u32x4 __attribute__((ext_vector_type(4)));

constexpr int DM = 4096, SEQ = 16384, CTX = 256, MT = SEQ + CTX, DEPTH = 4;
constexpr int NHEAD = 16, NKVH = 4, HD = 128, QW = 2048, FW = 2048, INW = 5120, DFF = 16384, ARANK = 512, NMOD = 6;
constexpr int K_LO = 2048, V_LO = 2560, F_LO = 3072;
constexpr float EPS = 1e-6f;

constexpr size_t MiB = 1u << 20;
constexpr size_t WS_CTL = 0, CTL_ZERO_BYTES = 1 * MiB;
constexpr size_t WS_MOD = 1 * MiB;
constexpr size_t WS_TPART = 2 * MiB;
constexpr size_t WS_ROPE = 2 * MiB + 256 * 1024;
constexpr size_t WS_TW = 2 * MiB + 512 * 1024;
constexpr size_t WS_FM1 = 3 * MiB, WS_FM2 = 3 * MiB + 128 * 1024, WS_FC = 3 * MiB + 256 * 1024, WS_CS = 3 * MiB + 512 * 1024;
constexpr size_t WS_WFRAW = 5 * MiB;
constexpr size_t WS_WFT = 13 * MiB;
constexpr size_t WS_GAM = 29 * MiB;
constexpr size_t WS_BIASIN = 29 * MiB + 256 * 1024;
constexpr size_t WS_BIAS1 = 29 * MiB + 512 * 1024;
constexpr size_t WS_SS = 30 * MiB;
constexpr size_t WS_SSAF = 30 * MiB + 512 * 1024;
constexpr size_t WS_WIN = 32 * MiB;
constexpr size_t WS_WOUT = 192 * MiB;
constexpr size_t WS_W1 = 320 * MiB;
constexpr size_t WS_W2 = 832 * MiB;
constexpr size_t WS_XW = 1344 * MiB;
constexpr size_t WS_HX = 1604 * MiB;
constexpr size_t WS_PX = 1734 * MiB;
constexpr size_t WS_MIX = 1897 * MiB;
constexpr size_t WS_ZT2 = 2027 * MiB;
constexpr size_t WS_Y2 = 2155 * MiB;
constexpr size_t WS_ZTC = 2283 * MiB;
constexpr size_t WS_H = 2285 * MiB;
constexpr size_t WS_SLAB = 2805 * MiB;
constexpr size_t WS_XB = 2873 * MiB;
constexpr size_t WS_END = 3129 * MiB;
static_assert(WS_XW + (size_t)MT * DM * 4 <= WS_HX && WS_HX + (size_t)MT * DM * 2 <= WS_PX && WS_PX + (size_t)MT * INW * 2 <= WS_MIX && WS_MIX + (size_t)MT * DM * 2 <= WS_ZT2 && WS_H + (size_t)MT * DFF * 2 <= WS_SLAB, "ws map");

constexpr int CW_BAR = 4096;

constexpr int RING_BYTES = 131072, LDSCTL_OFF = RING_BYTES, MISC_OFF = LDSCTL_OFF + 320, LDS_BYTES = 147456;
constexpr int NWAVES = 8;

__device__ __forceinline__ unsigned cvt_pk_bf16(float lo, float hi) { unsigned r; asm volatile("v_cvt_pk_bf16_f32 %0, %1, %2" : "=v"(r) : "v"(lo), "v"(hi)); return r; }
__device__ __forceinline__ unsigned f2bf(float f) { unsigned u = __builtin_bit_cast(unsigned, f); return (u + 0x7fffu + ((u >> 16) & 1u)) >> 16; }
__device__ __forceinline__ unsigned pk2(float lo, float hi) { return f2bf(lo) | (f2bf(hi) << 16); }
__device__ __forceinline__ float bf2f(unsigned short b) { return __builtin_bit_cast(float, ((unsigned)b) << 16); }
__device__ __forceinline__ float wave_sum(float v) {
#pragma unroll
    for (int o = 1; o < 64; o <<= 1) v += __shfl_xor(v, o);
    return v;
}
__device__ __forceinline__ float cos_rev(float x) { return __builtin_amdgcn_cosf(x); }
__device__ __forceinline__ float sin_rev(float x) { return __builtin_amdgcn_sinf(x); }

namespace pg8 {
constexpr int BM = 256, BK = 64, HALF = 128, HTB = HALF * BK * 2, STAGE_BYTES = 8 * HTB, NXCD = 8, WGM = 8;
__host__ __device__ __forceinline__ int lds_byte(int r, int c) { const int st = (r >> 4) * 2 + (c >> 5), rr = r & 15, cc = c & 31, ob = rr * 64 + cc * 2; return st * 1024 + (ob ^ (((ob >> 9) & 1) << 5)); }
__host__ __device__ __forceinline__ void stage_rc(int b, int& R, int& C) { const int st = b / 1024, sb = b % 1024, swz = sb ^ (((sb >> 9) & 1) << 5); R = (st >> 1) * 16 + swz / 64; C = (st & 1) * 32 + (swz % 64) / 2; }
__host__ __device__ __forceinline__ int perm32(int rho) { const int n = rho >> 4, i = rho & 15; return 8 * (i >> 2) + 4 * n + (i & 3); }

struct Unit { int pm, pn, g; };
struct Gemm { int K; unsigned rsA, rsB; size_t hsA, hsB; };

template <class Epi, class Sched>
__device__ __forceinline__ void gemm_phase(LAS unsigned char* lds, const Gemm g, const Sched& S, const Epi& E) {
    int tid = threadIdx.x; asm volatile("" : "+v"(tid));
    const int wid = __builtin_amdgcn_readfirstlane(tid >> 6), lane = tid & 63, wr = wid >> 2, wc = wid & 3, fr = lane & 15, fq = lane >> 4;
    const int K = g.K, nt = K / BK;
    unsigned voffA[2], voffB[2];
#pragma unroll
    for (int i = 0; i < 2; ++i) { int R, C; stage_rc(tid * 16 + i * 8192, R, C); const int Rb = Epi::PERM ? ((R & ~31) + perm32(R & 31)) : R;
        voffA[i] = (unsigned)R * g.rsA + (unsigned)C * 2u; voffB[i] = (unsigned)Rb * g.rsB + (unsigned)C * 2u; }
    const size_t kstep = (size_t)(BK * 2);
    const size_t hA = g.hsA, hB = g.hsB;
    const unsigned ldsw = (unsigned)wid * 1024u;
    const int aoff = lds_byte(wr * 64 + fr, fq * 8), boff = lds_byte(wc * 32 + fr, fq * 8);
#define PG8_SA(b, h) (((b) * 2 + (h)) * HTB)
#define PG8_SB(b, h) ((4 + (b) * 2 + (h)) * HTB)
#define PG8_STAGE(bufoff, gbase, voff) do { _Pragma("unroll") for (int _i = 0; _i < 2; ++_i) \
        __builtin_amdgcn_global_load_lds((const unsigned*)((const char*)(gbase) + (voff)[_i]), (LAS unsigned*)(lds + (bufoff) + ldsw + _i * 8192), 16, 0, 0); } while (0)
#define PG8_LDA(dst, b, h) do { _Pragma("unroll") for (int m = 0; m < 4; ++m) _Pragma("unroll") for (int k = 0; k < 2; ++k) dst[m][k] = *(const LAS bf16x8*)(lds + PG8_SA(b, h) + aoff + m * 2048 + k * 1024); } while (0)
#define PG8_LDB(dst, b, h) do { _Pragma("unroll") for (int n = 0; n < 2; ++n) _Pragma("unroll") for (int k = 0; k < 2; ++k) dst[n][k] = *(const LAS bf16x8*)(lds + PG8_SB(b, h) + boff + n * 2048 + k * 1024); } while (0)
#define PG8_MMA(ai, bj, At, Bt) do { __builtin_amdgcn_s_setprio(1); _Pragma("unroll") for (int m = 0; m < 4; ++m) _Pragma("unroll") for (int n = 0; n < 2; ++n) _Pragma("unroll") for (int k = 0; k < 2; ++k) \
        acc[ai][bj][m][n] = __builtin_amdgcn_mfma_f32_16x16x32_bf16(Bt[n][k], At[m][k], acc[ai][bj][m][n], 0, 0, 0); __builtin_amdgcn_s_setprio(0); } while (0)
#define PG8_WAIT_V(n) asm volatile("s_waitcnt vmcnt(" #n ")" ::: "memory")
#define PG8_WAIT_L(n) asm volatile("s_waitcnt lgkmcnt(" #n ")" ::: "memory")
#define PG8_BAR __builtin_amdgcn_s_barrier()
#define PG8_SCHED __builtin_amdgcn_sched_barrier(0)
    Unit cur, nxt; int ui = 0;
    if (!S.next(0, cur)) return;
    f32x4 acc[2][2][4][2];
#pragma unroll
    for (int a = 0; a < 2; ++a)
#pragma unroll
        for (int b = 0; b < 2; ++b)
#pragma unroll
            for (int m = 0; m < 4; ++m)
#pragma unroll
                for (int n = 0; n < 2; ++n) acc[a][b][m][n] = (f32x4){0.f, 0.f, 0.f, 0.f};
    bf16x8 At[4][2], B0[2][2], B1[2][2];
    LAS float* rtab = (LAS float*)(lds + STAGE_BYTES + 2048);
    if constexpr (Epi::MIDK) E.pre(cur, wr, fr, rtab);
    const char* cA = S.abase(cur); const char* cB = S.bbase(cur);
    PG8_STAGE(PG8_SB(0, 0), cB, voffB); PG8_STAGE(PG8_SB(0, 1), cB + hB, voffB); PG8_STAGE(PG8_SA(0, 0), cA, voffA); PG8_STAGE(PG8_SA(0, 1), cA + hA, voffA);
    if (wr == 1) PG8_BAR;
    PG8_WAIT_V(2); PG8_BAR;
    PG8_STAGE(PG8_SB(1, 0), cB + kstep, voffB); PG8_STAGE(PG8_SA(1, 0), cA + kstep, voffA); PG8_STAGE(PG8_SB(1, 1), cB + hB + kstep, voffB);
    PG8_WAIT_V(6); PG8_BAR;
    for (;;) {
        const bool has_next = S.next(ui + 1, nxt);
        const char* nA = has_next ? S.abase(nxt) : cA; const char* nB = has_next ? S.bbase(nxt) : cB;
#pragma nounroll
        for (int t = 0; t < nt; t += 2) {
            const bool last = (t == nt - 2);
            const char* a1 = cA + (size_t)(t + 1) * kstep;
            const char* a2 = last ? nA : cA + (size_t)(t + 2) * kstep; const char* b2 = last ? nB : cB + (size_t)(t + 2) * kstep;
            const char* a3 = a2 + kstep; const char* b3 = b2 + kstep;
            if constexpr (Epi::MIDK) { if (t == (nt >> 1)) {
#pragma unroll
                for (int a = 0; a < 2; ++a)
#pragma unroll
                    for (int m = 0; m < 4; ++m)
#pragma unroll
                        for (int b = 0; b < 2; ++b)
#pragma unroll
                            for (int n = 0; n < 2; ++n) acc[a][b][m][n] *= rtab[a * HALF + wr * 64 + m * 16 + fr]; } }
            PG8_LDB(B0, 0, 0); PG8_LDB(B1, 0, 1); PG8_SCHED; PG8_LDA(At, 0, 0); PG8_STAGE(PG8_SA(1, 1), a1 + hA, voffA);
            PG8_WAIT_V(8); PG8_WAIT_L(0); PG8_BAR; PG8_MMA(0, 0, At, B0); PG8_MMA(0, 1, At, B1); PG8_BAR; PG8_SCHED;
            PG8_LDA(At, 0, 1); PG8_STAGE(PG8_SB(0, 0), b2, voffB); PG8_STAGE(PG8_SB(0, 1), b2 + hB, voffB); PG8_STAGE(PG8_SA(0, 0), a2, voffA);
            PG8_WAIT_V(8); PG8_WAIT_L(0); PG8_BAR; PG8_MMA(1, 0, At, B0); PG8_MMA(1, 1, At, B1); PG8_BAR; PG8_SCHED;
            PG8_LDB(B0, 1, 0); PG8_LDB(B1, 1, 1); PG8_SCHED; PG8_LDA(At, 1, 0); PG8_STAGE(PG8_SA(0, 1), a2 + hA, voffA);
            PG8_WAIT_V(8); PG8_WAIT_L(0); PG8_BAR; PG8_MMA(0, 0, At, B0); PG8_MMA(0, 1, At, B1); PG8_BAR; PG8_SCHED;
            PG8_LDA(At, 1, 1); PG8_STAGE(PG8_SB(1, 0), b3, voffB); PG8_STAGE(PG8_SB(1, 1), b3 + hB, voffB); PG8_STAGE(PG8_SA(1, 0), a3, voffA);
            PG8_WAIT_V(8); PG8_WAIT_L(0); PG8_BAR; PG8_MMA(1, 0, At, B0); PG8_MMA(1, 1, At, B1); PG8_BAR; PG8_SCHED;
        }
        if (wr == 0) PG8_BAR;
        { int efr = fr, efq = fq; asm volatile("" : "+v"(efr), "+v"(efq));
          E(acc, cur, wr, wc, efr, efq); }
        if (!has_next) break;
#pragma unroll
        for (int a = 0; a < 2; ++a)
#pragma unroll
            for (int b = 0; b < 2; ++b)
#pragma unroll
                for (int m = 0; m < 4; ++m)
#pragma unroll
                    for (int n = 0; n < 2; ++n) acc[a][b][m][n] = (f32x4){0.f, 0.f, 0.f, 0.f};
        cur = nxt; cA = nA; cB = nB; ++ui;
        if constexpr (Epi::MIDK) E.pre(cur, wr, fr, rtab);
        if (wr == 1) PG8_BAR;
    }
    PG8_WAIT_V(0);
    PG8_BAR;
#undef PG8_SA
#undef PG8_SB
#undef PG8_STAGE
#undef PG8_LDA
#undef PG8_LDB
#undef PG8_MMA
#undef PG8_WAIT_V
#undef PG8_WAIT_L
#undef PG8_BAR
#undef PG8_SCHED
}

struct SchedStd {
    int nM, nN, nwg, G, c; const char* A; const char* B; size_t tsA, tsB;
    __device__ __forceinline__ void init(int nM_, int nN_, int G_, int c_, const void* A_, size_t tsA_, const void* B_, size_t tsB_) { nM = nM_; nN = nN_; nwg = nM * nN; G = G_; c = c_; A = (const char*)A_; B = (const char*)B_; tsA = tsA_; tsB = tsB_; }
    __device__ __forceinline__ bool next(int i, Unit& u) const {
        const long L = (long)i * G + c; if (L >= nwg) return false;
        int wgid = (int)L; { const int q = nwg / NXCD, r = nwg % NXCD, xcd = wgid % NXCD, off = wgid / NXCD; wgid = (xcd < r ? xcd * (q + 1) : r * (q + 1) + (xcd - r) * q) + off; }
        const int nig = WGM * nN, gid = wgid / nig, fm = gid * WGM, gsz = (nM - fm) < WGM ? (nM - fm) : WGM;
        u.pm = fm + ((wgid % nig) % gsz); u.pn = (wgid % nig) / gsz; u.g = 0; return true;
    }
    __device__ __forceinline__ const char* abase(const Unit& u) const { return A + (size_t)u.pm * tsA; }
    __device__ __forceinline__ const char* bbase(const Unit& u) const { return B + (size_t)u.pn * tsB; }
};
struct SchedGa {
    int G, c; const char* WfT; const char* PXf;
    __device__ __forceinline__ bool next(int i, Unit& u) const { const int L = i * G + c; if (L >= 1024) return false; u.pn = L >> 4; u.g = (L >> 2) & 3; u.pm = L & 3; return true; }
    __device__ __forceinline__ const char* abase(const Unit& u) const { return WfT + (size_t)u.g * (512 * 1024 * 2) + ((size_t)(u.pm & 1) * 256 * 1024 + (size_t)(u.pm >> 1) * 512) * 2; }
    __device__ __forceinline__ const char* bbase(const Unit& u) const { return PXf + ((size_t)(2 * u.pn) * INW + 512 * u.g) * 2; }
};
struct SchedGaCtx {
    int G, c; const char* WfT; const char* PXf;
    __device__ __forceinline__ bool next(int i, Unit& u) const { const int L = i * G + c; if (L >= 16) return false; u.pn = 0; u.g = L >> 2; u.pm = L & 3; return true; }
    __device__ __forceinline__ const char* abase(const Unit& u) const { return WfT + (size_t)u.g * (512 * 1024 * 2) + ((size_t)(u.pm & 1) * 256 * 1024 + (size_t)(u.pm >> 1) * 512) * 2; }
    __device__ __forceinline__ const char* bbase(const Unit& u) const { return PXf + ((size_t)SEQ * INW + 512 * u.g) * 2; }
};
struct SchedN {
    int G, c, ntile; const char* A; const char* B; size_t tsB;
    __device__ __forceinline__ bool next(int i, Unit& u) const { const int L = i * G + c; if (L >= ntile) return false; u.pn = L; u.pm = 0; u.g = 0; return true; }
    __device__ __forceinline__ const char* abase(const Unit&) const { return A; }
    __device__ __forceinline__ const char* bbase(const Unit& u) const { return B + (size_t)u.pn * tsB; }
};
struct SchedWf {
    int G, c; const char* WfRaw; const char* CS;
    __device__ __forceinline__ bool next(int i, Unit& u) const { const int L = i * G + c; if (L >= 128) return false; u.g = L >> 3; u.pm = (L >> 2) & 1; u.pn = L & 3; return true; }
    __device__ __forceinline__ const char* abase(const Unit& u) const { return WfRaw + (size_t)u.g * (512 * 512 * 2) + (size_t)u.pm * 256 * 1024; }
    __device__ __forceinline__ const char* bbase(const Unit& u) const { return CS + (size_t)u.pn * 256 * 1024; }
};

#define ACC_T const f32x4 (&acc)[2][2][4][2]
__device__ __forceinline__ u32x4 pack8(const f32x4 a, const f32x4 b) { u32x4 w; w.x = cvt_pk_bf16(a[0], a[1]); w.y = cvt_pk_bf16(a[2], a[3]); w.z = cvt_pk_bf16(b[0], b[1]); w.w = cvt_pk_bf16(b[2], b[3]); return w; }
__device__ __forceinline__ u32x2 pack4(const f32x4 a) { u32x2 w; w.x = cvt_pk_bf16(a[0], a[1]); w.y = cvt_pk_bf16(a[2], a[3]); return w; }

struct EpiInproj {
    static constexpr bool PERM = true, MIDK = false;
    bf16_t* PX; const float* COS; const float* SIN; const float* SSr; const float* bias;
    __device__ __forceinline__ void operator()(ACC_T, const Unit& u, int wr, int wc, int fr, int fq) const {
        const int row0 = u.pm * BM + wr * 64 + fr;
        f32x4 bv[2][2];
#pragma unroll
        for (int bj = 0; bj < 2; ++bj)
#pragma unroll
            for (int n = 0; n < 2; ++n) bv[bj][n] = *(const f32x4*)(bias + u.pn * BM + bj * HALF + wc * 32 + 8 * fq + 4 * n);
        if (u.pn < 10) {
            const int a = wc >> 1, b = wc & 1, jj = 16 * b + 4 * fq, dcol = 64 * a + jj;
            const bool rot = u.pm < 64;
#pragma unroll
            for (int ai = 0; ai < 2; ++ai)
#pragma unroll
                for (int m = 0; m < 4; ++m) {
                    const int row = row0 + ai * HALF + m * 16; const int pos = a ? (row & 63) : ((row >> 6) & 255);
                    const float rstd = 1.0f / sqrtf(SSr[row] * (1.0f / DM) + EPS);
                    f32x4 cs = (f32x4){1.f, 1.f, 1.f, 1.f}, sn = (f32x4){0.f, 0.f, 0.f, 0.f};
                    if (rot) { cs = *(const f32x4*)(COS + pos * 32 + jj); sn = *(const f32x4*)(SIN + pos * 32 + jj); }
                    bf16_t* rowp = PX + (size_t)row * INW + u.pn * BM + dcol;
#pragma unroll
                    for (int bj = 0; bj < 2; ++bj) { const f32x4 x1 = acc[ai][bj][m][0] * rstd + bv[bj][0], x2 = acc[ai][bj][m][1] * rstd + bv[bj][1];
                        const f32x4 o1 = x1 * cs - x2 * sn, o2 = x2 * cs + x1 * sn;
                        *(u32x2*)(rowp + bj * HALF) = pack4(o1); *(u32x2*)(rowp + bj * HALF + 32) = pack4(o2); }
                }
        } else {
            const int col0 = u.pn * BM + wc * 32 + 8 * fq;
#pragma unroll
            for (int ai = 0; ai < 2; ++ai)
#pragma unroll
                for (int m = 0; m < 4; ++m) { const int row = row0 + ai * HALF + m * 16; bf16_t* rowp = PX + (size_t)row * INW + col0;
                    const float rstd = 1.0f / sqrtf(SSr[row] * (1.0f / DM) + EPS);
#pragma unroll
                    for (int bj = 0; bj < 2; ++bj) *(u32x4*)(rowp + bj * HALF) = pack8(acc[ai][bj][m][0] * rstd + bv[bj][0], acc[ai][bj][m][1] * rstd + bv[bj][1]); }
        }
    }
};
template <bool MIXN> struct EpiResid {
    static constexpr bool PERM = true, MIDK = MIXN;
    const float* base; float* XW; const float* gate; const float* gam; bf16_t* HXo; float* SSo;
    const float* SSa; const float* SSf;
    __device__ __forceinline__ void pre(const Unit& u, int wr, int fr, LAS float* rtab) const {
        const int rl0 = wr * 64 + fr;
#pragma unroll
        for (int ai = 0; ai < 2; ++ai)
#pragma unroll
            for (int m = 0; m < 4; ++m) { const int rl = rl0 + ai * HALF + m * 16, row = u.pm * BM + rl;
                rtab[rl] = sqrtf((SSf[row] * (1.0f / FW) + EPS) / (SSa[row] * (1.0f / QW) + EPS)); }
    }
    __device__ __forceinline__ void operator()(ACC_T, const Unit& u, int wr, int wc, int fr, int fq) const {
        const int row0 = u.pm * BM + wr * 64 + fr, col0 = u.pn * BM + wc * 32 + 8 * fq;
        const bool nxt = (gam != nullptr);
        f32x4 gv[2][2];
#pragma unroll
        for (int bj = 0; bj < 2; ++bj)
#pragma unroll
            for (int n = 0; n < 2; ++n) gv[bj][n] = *(const f32x4*)(gate + col0 + bj * HALF + 4 * n);
#pragma unroll
        for (int ai = 0; ai < 2; ++ai)
#pragma unroll
        for (int mp = 0; mp < 2; ++mp) {
            f32x4 bs[2][2][2]; float rf[2];
#pragma unroll
            for (int mm = 0; mm < 2; ++mm) { const int row = row0 + ai * HALF + (2 * mp + mm) * 16; const size_t off = (size_t)row * DM + col0;
                rf[mm] = MIXN ? SSf[row] : 0.f;
#pragma unroll
                for (int bj = 0; bj < 2; ++bj)
#pragma unroll
                    for (int n = 0; n < 2; ++n) bs[mm][bj][n] = *(const f32x4*)(base + off + bj * HALF + 4 * n); }
            asm volatile("" ::: "memory");
#pragma unroll
            for (int mm = 0; mm < 2; ++mm) { const int m = 2 * mp + mm; const int row = row0 + ai * HALF + m * 16; const size_t off = (size_t)row * DM + col0; float s = 0.f;
                const float rs = MIXN ? 1.0f / sqrtf(rf[mm] * (1.0f / FW) + EPS) : 1.0f;
#pragma unroll
                for (int bj = 0; bj < 2; ++bj) { const f32x4 x0 = bs[mm][bj][0] + gv[bj][0] * (acc[ai][bj][m][0] * rs), x1 = bs[mm][bj][1] + gv[bj][1] * (acc[ai][bj][m][1] * rs);
                    *(f32x4*)(XW + off + bj * HALF) = x0; *(f32x4*)(XW + off + bj * HALF + 4) = x1;
                    if (nxt) { s += ((x0[0] * x0[0] + x0[1] * x0[1]) + (x0[2] * x0[2] + x0[3] * x0[3])) + ((x1[0] * x1[0] + x1[1] * x1[1]) + (x1[2] * x1[2] + x1[3] * x1[3]));
                               const f32x4 g0 = *(const f32x4*)(gam + col0 + bj * HALF), g1 = *(const f32x4*)(gam + col0 + bj * HALF + 4);
                               *(u32x4*)(HXo + off + bj * HALF) = pack8(x0 * g0, x1 * g1); } }
                if (nxt) { s += __shfl_xor(s, 16); s += __shfl_xor(s, 32); if (fq == 0) atomicAdd(SSo + row, s); } }
            asm volatile("" ::: "memory");
        }
    }
};
struct EpiRelu2 {
    static constexpr bool PERM = true, MIDK = false;
    bf16_t* H; const float* SSr; const float* bias;
    __device__ __forceinline__ void operator()(ACC_T, const Unit& u, int wr, int wc, int fr, int fq) const {
        const int row0 = u.pm * BM + wr * 64 + fr, col0 = u.pn * BM + wc * 32 + 8 * fq;
        f32x4 bv[2][2];
#pragma unroll
        for (int bj = 0; bj < 2; ++bj)
#pragma unroll
            for (int n = 0; n < 2; ++n) bv[bj][n] = *(const f32x4*)(bias + col0 + bj * HALF + 4 * n);
#pragma unroll
        for (int ai = 0; ai < 2; ++ai)
#pragma unroll
            for (int m = 0; m < 4; ++m) { const int row = row0 + ai * HALF + m * 16; bf16_t* rowp = H + (size_t)row * DFF + col0;
                const float rstd = 1.0f / sqrtf(SSr[row] * (1.0f / DM) + EPS);
#pragma unroll
                for (int bj = 0; bj < 2; ++bj) { f32x4 v0 = acc[ai][bj][m][0] * rstd + bv[bj][0], v1 = acc[ai][bj][m][1] * rstd + bv[bj][1];
#pragma unroll
                    for (int e = 0; e < 4; ++e) { const float a0 = fmaxf(v0[e], 0.f), a1 = fmaxf(v1[e], 0.f); v0[e] = a0 * a0; v1[e] = a1 * a1; }
                    *(u32x4*)(rowp + bj * HALF) = pack8(v0, v1); } }
    }
};
struct EpiWf {
    static constexpr bool PERM = true, MIDK = false;
    bf16_t* WfT;
    __device__ __forceinline__ void operator()(ACC_T, const Unit& u, int wr, int wc, int fr, int fq) const {
        const int row0 = u.pm * BM + wr * 64 + fr, col0 = u.pn * BM + wc * 32 + 8 * fq;
        bf16_t* base = WfT + (size_t)u.g * (512 * 1024);
#pragma unroll
        for (int ai = 0; ai < 2; ++ai)
#pragma unroll
            for (int m = 0; m < 4; ++m) { bf16_t* rowp = base + (size_t)(row0 + ai * HALF + m * 16) * 1024 + col0;
#pragma unroll
                for (int bj = 0; bj < 2; ++bj) *(u32x4*)(rowp + bj * HALF) = pack8(acc[ai][bj][m][0], acc[ai][bj][m][1]); }
    }
};
struct EpiGa {
    static constexpr bool PERM = true, MIDK = false;
    bf16_t* ZT2;
    __device__ __forceinline__ void operator()(ACC_T, const Unit& u, int wr, int wc, int fr, int fq) const {
        const int reim = u.pm >> 1, d0 = (u.pm & 1) * 256 + wr * 64 + fr, l1 = wc * 32 + 8 * fq;
#pragma unroll
        for (int ai = 0; ai < 2; ++ai)
#pragma unroll
            for (int m = 0; m < 4; ++m) { const int j = u.g * 512 + d0 + ai * HALF + m * 16;
#pragma unroll
                for (int bj = 0; bj < 2; ++bj) { const int l2 = 2 * u.pn + bj;
                    *(u32x4*)(ZT2 + ((size_t)(j * 128 + l2) * 256 + reim * 128 + l1)) = pack8(acc[ai][bj][m][0], acc[ai][bj][m][1]); } }
    }
};
struct EpiGaCtx {
    static constexpr bool PERM = true, MIDK = false;
    bf16_t* ZTc;
    __device__ __forceinline__ void operator()(ACC_T, const Unit& u, int wr, int wc, int fr, int fq) const {
        const int reim = u.pm >> 1, d0 = (u.pm & 1) * 256 + wr * 64 + fr, l0 = wc * 32 + 8 * fq;
#pragma unroll
        for (int ai = 0; ai < 2; ++ai)
#pragma unroll
            for (int m = 0; m < 4; ++m) { const int j = u.g * 512 + d0 + ai * HALF + m * 16;
#pragma unroll
                for (int bj = 0; bj < 2; ++bj)
                    *(u32x4*)(ZTc + ((size_t)j * 512 + reim * 256 + bj * HALF + l0)) = pack8(acc[ai][bj][m][0], acc[ai][bj][m][1]); }
    }
};
struct EpiGb {
    static constexpr bool PERM = true, MIDK = false;
    bf16_t* Y2; const f32x2* TW;
    __device__ __forceinline__ void operator()(ACC_T, const Unit& u, int wr, int wc, int fr, int fq) const {
        const int l2b = wc * 32 + 8 * fq;
#pragma unroll
        for (int m = 0; m < 4; ++m) { const int k1 = wr * 64 + m * 16 + fr;
            f32x2 t[8];
#pragma unroll
            for (int e = 0; e < 8; ++e) t[e] = TW[(unsigned)(k1 * (l2b + e))];
#pragma unroll
            for (int bj = 0; bj < 2; ++bj) { const int j = 2 * u.pn + bj;
                f32x4 r0, r1, i0, i1;
#pragma unroll
                for (int e = 0; e < 4; ++e) {
                    const float yr0 = acc[0][bj][m][0][e], yi0 = acc[1][bj][m][0][e], yr1 = acc[0][bj][m][1][e], yi1 = acc[1][bj][m][1][e];
                    r0[e] = yr0 * t[e].x + yi0 * t[e].y; i0[e] = yi0 * t[e].x - yr0 * t[e].y;
                    r1[e] = yr1 * t[4 + e].x + yi1 * t[4 + e].y; i1[e] = yi1 * t[4 + e].x - yr1 * t[4 + e].y; }
                bf16_t* p = Y2 + ((size_t)(k1 * 2048 + j) * 256 + l2b);
                *(u32x4*)p = pack8(r0, r1); *(u32x4*)(p + 128) = pack8(i0, i1); }
            asm volatile("" ::: "memory"); }
    }
};
struct EpiGc {
    static constexpr bool PERM = true, MIDK = false;
    bf16_t* MIX; float* SSf;
    __device__ __forceinline__ void operator()(ACC_T, const Unit& u, int wr, int wc, int fr, int fq) const {
        const int k1 = u.pn >> 3, j0 = (u.pn & 7) * 256 + wc * 32 + 8 * fq;
#pragma unroll
        for (int m = 0; m < 4; ++m) { const int k2 = wr * 64 + m * 16 + fr; const int pos = k1 + 128 * k2; float s = 0.f;
#pragma unroll
            for (int bj = 0; bj < 2; ++bj) { const f32x4 v0 = acc[0][bj][m][0], v1 = acc[0][bj][m][1];
                s += ((v0[0] * v0[0] + v0[1] * v0[1]) + (v0[2] * v0[2] + v0[3] * v0[3])) + ((v1[0] * v1[0] + v1[1] * v1[1]) + (v1[2] * v1[2] + v1[3] * v1[3]));
                *(u32x4*)(MIX + (size_t)pos * DM + QW + j0 + bj * HALF) = pack8(v0, v1); }
            s += __shfl_xor(s, 16); s += __shfl_xor(s, 32); if (fq == 0) atomicAdd(SSf + pos, s); }
    }
};
struct EpiGctx {
    static constexpr bool PERM = true, MIDK = false;
    bf16_t* MIX; float* SSf;
    __device__ __forceinline__ void operator()(ACC_T, const Unit& u, int wr, int wc, int fr, int fq) const {
        const int j0 = u.pn * 256 + wc * 32 + 8 * fq;
#pragma unroll
        for (int ai = 0; ai < 2; ++ai)
#pragma unroll
            for (int m = 0; m < 4; ++m) { const int k = ai * HALF + wr * 64 + m * 16 + fr; float s = 0.f;
#pragma unroll
                for (int bj = 0; bj < 2; ++bj) { const f32x4 v0 = acc[ai][bj][m][0], v1 = acc[ai][bj][m][1];
                    s += ((v0[0] * v0[0] + v0[1] * v0[1]) + (v0[2] * v0[2] + v0[3] * v0[3])) + ((v1[0] * v1[0] + v1[1] * v1[1]) + (v1[2] * v1[2] + v1[3] * v1[3]));
                    *(u32x4*)(MIX + (size_t)(SEQ + k) * DM + QW + j0 + bj * HALF) = pack8(v0, v1); }
                s += __shfl_xor(s, 16); s += __shfl_xor(s, 32); if (fq == 0) atomicAdd(SSf + SEQ + k, s); }
    }
};

struct SchedPiece {
    int G, c, npiece, nks, pn0; const char* A; const char* B; size_t tsB, kbytes;
    __device__ __forceinline__ bool next(int i, Unit& u) const { const int L = i * G + c; if (L >= npiece) return false; u.pn = pn0 + L / nks; u.g = L % nks; u.pm = 0; return true; }
    __device__ __forceinline__ const char* abase(const Unit& u) const { return A + (size_t)u.g * kbytes; }
    __device__ __forceinline__ const char* bbase(const Unit& u) const { return B + (size_t)u.pn * tsB + (size_t)u.g * kbytes; }
};
struct EpiSlab {
    static constexpr bool PERM = false, MIDK = false;
    float* SLAB; int ldn;
    __device__ __forceinline__ void operator()(ACC_T, const Unit& u, int wr, int wc, int fr, int fq) const {
        const int row0 = wr * 64 + fr, col0 = u.pn * BM + wc * 32 + 4 * fq;
        float* base = SLAB + (size_t)u.g * 256 * ldn;
#pragma unroll
        for (int ai = 0; ai < 2; ++ai)
#pragma unroll
            for (int m = 0; m < 4; ++m) { float* rowp = base + (size_t)(row0 + ai * HALF + m * 16) * ldn + col0;
#pragma unroll
                for (int bj = 0; bj < 2; ++bj)
#pragma unroll
                    for (int n = 0; n < 2; ++n) *(f32x4*)(rowp + bj * HALF + n * 16) = acc[ai][bj][m][n]; }
    }
};
#undef ACC_T
}

namespace att {
constexpr float SCALE = 0.08838834764831845f;
constexpr float THR = 8.f;
constexpr int SHM_K = 16384, SHM_V = 16384, OFF_V = 0, OFF_K = 2 * SHM_V, OFF_WS = 2 * SHM_V + 2 * SHM_K;
#define KSWZ(row, colB) ((row) * 256 + ((colB) ^ (((row) & 7) << 4)))
#define SBAR() __builtin_amdgcn_sched_barrier(0)
__device__ __forceinline__ int v_st(int k, int c) { const int kk = (k & ~0xC) | ((k & 4) << 1) | ((k & 8) >> 1); return ((kk >> 3) * 4 + (c >> 5)) * 512 + ((kk & 7) * 32 + (c & 31)) * 2; }
__device__ __forceinline__ int v_rd_base(int lane) { return ((lane & 3) << 3) | (((lane >> 2) & 3) << 6) | (((lane >> 4) & 1) << 5) | (((lane >> 5) & 1) << 8); }
constexpr int v_rd_off(int d0, int ks, int half) { return d0 * 512 + ks * 4096 + half * 2048; }
__device__ __forceinline__ int crow(int r, int hi) { return (r & 3) + 8 * (r >> 2) + 4 * hi; }
__device__ __forceinline__ unsigned cvtpk(float lo, float hi) { unsigned r; asm volatile("v_cvt_pk_bf16_f32 %0, %1, %2" : "=v"(r) : "v"(lo), "v"(hi)); return r; }
__device__ __forceinline__ void mask_tile(f32x16& p0, f32x16& p1, int dq, unsigned W) {
    const float NEG = -__builtin_inff();
#pragma unroll
    for (int r = 0; r < 16; ++r) {
        const int c = (r & 3) + 8 * (r >> 2);
        if ((unsigned)(dq - c) >= W) p0[r] = NEG;
        if ((unsigned)(dq - c - 32) >= W) p1[r] = NEG;
    }
}
__device__ __forceinline__ void partialSM(f32x16& p0, f32x16& p1, float& m_reg, float& mn, float& alpha) {
    float pmax = p0[0];
#pragma unroll
    for (int r = 1; r < 16; ++r) pmax = fmaxf(pmax, p0[r]);
#pragma unroll
    for (int r = 0; r < 16; ++r) pmax = fmaxf(pmax, p1[r]);
    { auto rr = __builtin_amdgcn_permlane32_swap(__float_as_uint(pmax), __float_as_uint(pmax), false, false);
      pmax = fmaxf(__uint_as_float(rr[0]), __uint_as_float(rr[1])); }
    constexpr float C2 = 1.4426950408889634f * SCALE;
    if (__all((pmax - m_reg) * SCALE <= THR)) { mn = m_reg; alpha = 1.f; }
    else { mn = fmaxf(m_reg, pmax); alpha = __builtin_amdgcn_exp2f((m_reg - mn) * C2); m_reg = mn; }
    const float mnL = -mn * C2;
#pragma unroll
    for (int r = 0; r < 16; ++r) p0[r] = fmaf(p0[r], C2, mnL);
#pragma unroll
    for (int r = 0; r < 16; ++r) p1[r] = fmaf(p1[r], C2, mnL);
#pragma unroll
    for (int r = 0; r < 16; ++r) p0[r] = __builtin_amdgcn_exp2f(p0[r]);
}
__device__ __forceinline__ void finishSM(f32x16& p0, f32x16& p1, float alpha, float& l_reg, bf16x8& pa0, bf16x8& pa1, bf16x8& pa2, bf16x8& pa3) {
#pragma unroll
    for (int r = 0; r < 16; ++r) p1[r] = __builtin_amdgcn_exp2f(p1[r]);
    float ps = 0;
#pragma unroll
    for (int r = 0; r < 16; ++r) ps += p0[r];
#pragma unroll
    for (int r = 0; r < 16; ++r) ps += p1[r];
    { auto rr = __builtin_amdgcn_permlane32_swap(__float_as_uint(ps), __float_as_uint(ps), false, false);
      ps = __uint_as_float(rr[0]) + __uint_as_float(rr[1]); }
    l_reg = l_reg * alpha + ps;
#define PK4(P, B_, OUT) do { unsigned a0 = cvtpk(P[B_+0], P[B_+1]), a1 = cvtpk(P[B_+2], P[B_+3]);                          \
        unsigned b0 = cvtpk(P[B_+4], P[B_+5]), b1 = cvtpk(P[B_+6], P[B_+7]);                                             \
        auto r0 = __builtin_amdgcn_permlane32_swap(a0, b0, false, false); auto r1 = __builtin_amdgcn_permlane32_swap(a1, b1, false, false); \
        u32x4 w = {r0[0], r1[0], r0[1], r1[1]}; OUT = __builtin_bit_cast(bf16x8, w); } while (0)
    PK4(p0, 0, pa0); PK4(p0, 8, pa1); PK4(p1, 0, pa2); PK4(p1, 8, pa3);
#undef PK4
}
template <int KB>
__device__ __forceinline__ void qkt(f32x16& p0, f32x16& p1, const LAS char* K_lds, int r32, int hi, const bf16x8* qr) {
    p0 = f32x16{}; p1 = f32x16{};
    const LAS char* kb[4];
#pragma unroll
    for (int dd = 0; dd < 4; ++dd) kb[dd] = K_lds + KB * SHM_K + KSWZ(r32, (dd * 16 + hi * 8) * 2);
#pragma unroll
    for (int d0 = 0; d0 < 8; ++d0) { const LAS char* a = kb[d0 & 3] + (d0 >> 2) * 128;
        bf16x8 b0 = *(const LAS bf16x8*)(a);
        bf16x8 b1 = *(const LAS bf16x8*)(a + 32 * 256);
        p0 = __builtin_amdgcn_mfma_f32_32x32x16_bf16(b0, qr[d0], p0, 0, 0, 0);
        p1 = __builtin_amdgcn_mfma_f32_32x32x16_bf16(b1, qr[d0], p1, 0, 0, 0); }
}
template <int VB>
__device__ __forceinline__ void pv_tile(f32x16* o, int vb0, bf16x8 pa0, bf16x8 pa1, bf16x8 pa2, bf16x8 pa3) {
#define TRRD(dst, off) asm volatile("ds_read_b64_tr_b16 %0, %1 offset:%2" : "=&v"(dst) : "v"(vb0), "i"(off) : "memory")
#define PV_D0(d0) do { s16x4 l0, l1, l2, l3, h0, h1, h2, h3; constexpr int b_ = VB * SHM_V + v_rd_off(d0, 0, 0); \
        TRRD(l0, b_); TRRD(h0, b_ + 2048); TRRD(l1, b_ + 4096); TRRD(h1, b_ + 6144); TRRD(l2, b_ + 8192); TRRD(h2, b_ + 10240); TRRD(l3, b_ + 12288); TRRD(h3, b_ + 14336); \
        asm volatile("s_waitcnt lgkmcnt(0)" ::: "memory"); SBAR();   \
        o[d0] = __builtin_amdgcn_mfma_f32_32x32x16_bf16(pa0, (bf16x8){l0[0], l0[1], l0[2], l0[3], h0[0], h0[1], h0[2], h0[3]}, o[d0], 0, 0, 0);   \
        o[d0] = __builtin_amdgcn_mfma_f32_32x32x16_bf16(pa1, (bf16x8){l1[0], l1[1], l1[2], l1[3], h1[0], h1[1], h1[2], h1[3]}, o[d0], 0, 0, 0);   \
        o[d0] = __builtin_amdgcn_mfma_f32_32x32x16_bf16(pa2, (bf16x8){l2[0], l2[1], l2[2], l2[3], h2[0], h2[1], h2[2], h2[3]}, o[d0], 0, 0, 0);   \
        o[d0] = __builtin_amdgcn_mfma_f32_32x32x16_bf16(pa3, (bf16x8){l3[0], l3[1], l3[2], l3[3], h3[0], h3[1], h3[2], h3[3]}, o[d0], 0, 0, 0); } while (0)
    PV_D0(0); PV_D0(1); PV_D0(2); PV_D0(3);
#undef PV_D0
#undef TRRD
}

__device__ __forceinline__ void attn_item(LAS char* lds, const bf16_t* PX, bf16_t* MIX, float* SSa, const float* sink, int qrow0, int kvh, int hp, int nt, int wstart) {
    int tid = threadIdx.x; asm volatile("" : "+v"(tid));
    const int wid = __builtin_amdgcn_readfirstlane(tid >> 6), lane = tid & 63, r32 = lane & 31, hi = lane >> 5;
    const int hq = 4 * kvh + 2 * hp + (wid >> 2);
    const int qw0 = qrow0 + 32 * (wid & 3), qrow = qw0 + r32;
    LAS char* V_lds = lds + OFF_V; LAS char* K_lds = lds + OFF_K;
    LAS float* ws = (LAS float*)(lds + OFF_WS) + wid * 64; LAS float* li_l = ws; LAS float* al_l = ws + 32;
    bf16x8 qr[8];
    { const bf16_t* qp = PX + (size_t)qrow * INW + hq * HD + hi * 8;
#pragma unroll
      for (int d0 = 0; d0 < 8; ++d0) qr[d0] = *(const bf16x8*)(qp + d0 * 16); }
    const int sr = tid >> 4, sc = (tid & 15) * 8, vst0 = v_st(sr, sc), vst1 = v_st(32 + sr, sc), kws = KSWZ(sr, sc * 2);
    const int vb0 = (int)(unsigned)(size_t)V_lds + v_rd_base(lane);
    const bf16_t* Kg = PX + K_LO + kvh * HD + sc; const bf16_t* Vg = PX + V_LO + kvh * HD + sc;
    float m_reg = sink[hq] * (1.0f / SCALE), l_reg = 1.f; f32x16 o[4] = {};
    bf16x8 st_k0, st_k1, st_v0, st_v1;
#define TROW(t_) ((t_) < 4 ? SEQ + 64 * (t_) : wstart + 64 * ((t_) - 4))
#define LOADT(t_) do { const size_t rb_ = (size_t)(TROW(t_) + sr); st_k0 = *(const bf16x8*)(Kg + rb_ * INW); st_k1 = *(const bf16x8*)(Kg + (rb_ + 32) * INW); \
                       st_v0 = *(const bf16x8*)(Vg + rb_ * INW); st_v1 = *(const bf16x8*)(Vg + (rb_ + 32) * INW); } while (0)
#define WRITET(b_) do { *(LAS bf16x8*)(K_lds + (b_) * SHM_K + kws) = st_k0; *(LAS bf16x8*)(K_lds + (b_) * SHM_K + kws + 32 * 256) = st_k1; \
                        *(LAS bf16x8*)(V_lds + (b_) * SHM_V + vst0) = st_v0; *(LAS bf16x8*)(V_lds + (b_) * SHM_V + vst1) = st_v1; } while (0)
#define RESC(a) do { if (__any((a) < 1.f)) { if (hi == 0) al_l[r32] = (a); asm volatile("s_waitcnt lgkmcnt(0)" ::: "memory"); \
        _Pragma("unroll") for (int d_ = 0; d_ < 4; ++d_) _Pragma("unroll") for (int r = 0; r < 16; ++r) o[d_][r] *= al_l[crow(r, hi)]; } } while (0)
#define STEP(B_, t_) do { const int tt_ = (t_); \
        if (tt_ + 1 < nt) LOADT(tt_ + 1); \
        const int kb_ = TROW(tt_); \
        const bool act_ = tt_ < 4 || (kb_ <= qw0 + 31 + 128 && kb_ + 63 >= qw0 - 128);              \
        if (act_) { f32x16 p0, p1; float mn, alpha; bf16x8 pa0, pa1, pa2, pa3; \
            SBAR(); qkt<B_>(p0, p1, K_lds, r32, hi, qr); \
            if (tt_ >= 4 && (kb_ + 63 - qw0 > 128 || qw0 + 31 - kb_ > 128)) mask_tile(p0, p1, qrow + 128 - kb_ - 4 * hi, 257u); \
            partialSM(p0, p1, m_reg, mn, alpha); RESC(alpha); \
            finishSM(p0, p1, alpha, l_reg, pa0, pa1, pa2, pa3); SBAR(); \
            pv_tile<B_>(o, vb0, pa0, pa1, pa2, pa3); } \
        if (tt_ + 1 < nt) WRITET((B_) ^ 1); \
        __syncthreads(); } while (0)
    LOADT(0); WRITET(0); __syncthreads();
    for (int t = 0; t < nt; t += 2) { STEP(0, t); STEP(1, t + 1); }
    if (hi == 0) li_l[r32] = l_reg;
    asm volatile("s_waitcnt lgkmcnt(0)" ::: "memory");
    float rli[16];
#pragma unroll
    for (int r = 0; r < 16; ++r) rli[r] = 1.0f / li_l[crow(r, hi)];
    bf16_t* Ow = MIX + (size_t)qw0 * DM + hq * HD;
#pragma unroll
    for (int r = 0; r < 16; ++r) { const int orow = crow(r, hi); float s = 0.f;
#pragma unroll
        for (int d0 = 0; d0 < 4; ++d0) { const float v = o[d0][r] * rli[r]; const float vn = __shfl_xor(v, 1); s += v * v;
            if ((r32 & 1) == 0) *(unsigned*)(Ow + (size_t)orow * DM + d0 * 32 + r32) = cvtpk(v, vn); }
        s += __shfl_xor(s, 1); s += __shfl_xor(s, 2); s += __shfl_xor(s, 4); s += __shfl_xor(s, 8); s += __shfl_xor(s, 16);
        if (r32 == r) atomicAdd(SSa + qw0 + orow, s); }
    __syncthreads();
#undef TROW
#undef LOADT
#undef WRITET
#undef RESC
#undef STEP
}
}

#define XB_TMO      128
#define XB_XCNT(j)  (256  + 64 * (j))
#define XB_XSUB(j)  (1280 + 64 * (j))
#define XB_XGEN(j)  (2304 + 64 * (j))
#define XB_TOP      3328
#define XB_TOPGEN   3392
#define XCD_BAR_WORDS 3456
#define XB_SPIN_CAP (1u << 22)
__device__ __forceinline__ unsigned xb_ld(unsigned* p)              { return __hip_atomic_load(p, __ATOMIC_RELAXED, __HIP_MEMORY_SCOPE_AGENT); }
__device__ __forceinline__ unsigned xb_add(unsigned* p, unsigned v) { return __hip_atomic_fetch_add(p, v, __ATOMIC_RELAXED, __HIP_MEMORY_SCOPE_AGENT); }
__device__ __forceinline__ unsigned xb_xcc_id() { return (unsigned)__builtin_amdgcn_s_getreg((3 << 11) | 20) & 0xFu; }
#define XB_SPIN(cond, bar) do { unsigned _sp = 0; while (cond) { __builtin_amdgcn_s_sleep(1); \
    if ((++_sp & 255u) == 0u) { if (xb_ld(&(bar)[XB_TMO])) break; if (_sp > XB_SPIN_CAP) { atomicAdd(&(bar)[XB_TMO], 1u); break; } } } } while (0)
struct XcdBarrier { unsigned* bar; unsigned x; volatile LAS unsigned* st; };
__device__ __forceinline__ XcdBarrier xcd_barrier_post(unsigned* bar, volatile LAS unsigned* st) {
    XcdBarrier b; b.bar = bar; b.x = xb_xcc_id(); b.st = st;
    if (threadIdx.x == 0) (void)xb_add(&bar[XB_XCNT(b.x)], 1u);
    return b;
}
__device__ __forceinline__ void xcd_barrier_complete(unsigned* bar, unsigned x, unsigned& nloc, unsigned& nx) {
    const unsigned G = gridDim.x * gridDim.y * gridDim.z;
    unsigned sum, cnt, mine, sp = 0u;
    for (;;) {
        sum = 0u; cnt = 0u; mine = 0u;
#pragma unroll
        for (unsigned j = 0; j < 16; ++j) { const unsigned c = xb_ld(&bar[XB_XCNT(j)]); sum += c; cnt += (c > 0u) ? 1u : 0u; mine = (j == x) ? c : mine; }
        if (sum == G) break;
        __builtin_amdgcn_s_sleep(1);
        if ((++sp & 255u) == 0u) { if (xb_ld(&bar[XB_TMO])) break; if (sp > XB_SPIN_CAP) { atomicAdd(&bar[XB_TMO], 1u); break; } }
    }
    nloc = mine > 0u ? mine : 1u; nx = cnt > 0u ? cnt : 1u;
}
__device__ __forceinline__ void xcd_barrier(const XcdBarrier& b) {
    asm volatile("s_waitcnt vmcnt(0)" ::: "memory");
    __syncthreads();
    if (threadIdx.x == 0) {
        unsigned* bar = b.bar;
        __builtin_amdgcn_s_waitcnt(0);
        unsigned nloc = b.st[0], nx = b.st[1];
        if (nloc == 0u) { xcd_barrier_complete(bar, b.x, nloc, nx); b.st[0] = nloc; b.st[1] = nx; }
        const unsigned old = xb_add(&bar[XB_XSUB(b.x)], 1u);
        const unsigned gen = old / nloc;
        if (old + 1u == (gen + 1u) * nloc) {
            __builtin_amdgcn_fence(__ATOMIC_RELEASE, "agent");
            asm volatile("s_waitcnt vmcnt(0)" ::: "memory");
            const unsigned og = xb_add(&bar[XB_TOP], 1u);
            const unsigned tg = og / nx;
            if (og + 1u == (tg + 1u) * nx) xb_add(&bar[XB_TOPGEN], 1u);
            else XB_SPIN(xb_ld(&bar[XB_TOPGEN]) == tg, bar);
            __builtin_amdgcn_fence(__ATOMIC_ACQUIRE, "agent");
            xb_add(&bar[XB_XGEN(b.x)], 1u);
            asm volatile("s_waitcnt vmcnt(0)" ::: "memory");
        } else {
            XB_SPIN(xb_ld(&bar[XB_XGEN(b.x)]) == gen, bar);
            __builtin_amdgcn_fence(__ATOMIC_ACQUIRE, "agent");
            asm volatile("s_waitcnt vmcnt(0)" ::: "memory");
        }
    }
    __syncthreads();
}

__device__ __forceinline__ int vcol_qk(int nt) {
    const int d = nt & 127, a = d >> 6, nn = (d >> 5) & 1, b = (d >> 4) & 1, fq = (d >> 2) & 3, e = d & 3;
    return (nt & ~127) + 32 * (2 * a + b) + 8 * fq + 4 * nn + e;
}
template <bool PERMQK, bool BIAS>
__device__ __forceinline__ void transpose_item(const float* W, int K, int N, bf16_t* WT, LAS float* scr, int item, int lane, const float* sh = nullptr, float* bias = nullptr, const float* kscale = nullptr) {
    const int nblk = N / 32, kb = item / nblk, nb = item % nblk, k0 = 64 * kb, n0 = 32 * nb;
#pragma unroll 8
    for (int i = 0; i < 32; ++i) { const int kk = 2 * i + (lane >> 5); float w = W[(size_t)(k0 + kk) * N + n0 + (lane & 31)]; if (kscale) w *= kscale[k0 + kk]; scr[kk * 33 + (lane & 31)] = w; }
    asm volatile("s_waitcnt lgkmcnt(0)" ::: "memory");
    if (BIAS) {
        const int n = lane & 31, hh = lane >> 5; float sacc = 0.f;
#pragma unroll 8
        for (int i = 0; i < 32; ++i) sacc += scr[(32 * hh + i) * 33 + n] * sh[k0 + 32 * hh + i];
        sacc += __shfl_xor(sacc, 32);
        if (lane < 32) { int nt = n0 + n; if (PERMQK && nt < K_LO + 512) nt = vcol_qk(nt); atomicAdd(bias + nt, sacc); }
    }
    const int c = lane & 7;
#pragma unroll
    for (int j = 0; j < 4; ++j) { const int n = (lane >> 3) + 8 * j; const LAS float* s = scr + (8 * c) * 33 + n;
        u32x4 o; o.x = pk2(s[0 * 33], s[1 * 33]); o.y = pk2(s[2 * 33], s[3 * 33]); o.z = pk2(s[4 * 33], s[5 * 33]); o.w = pk2(s[6 * 33], s[7 * 33]);
        int nt = n0 + n;
        if (PERMQK && nt < K_LO + 512) nt = vcol_qk(nt);
        *(u32x4*)(WT + (size_t)nt * K + k0 + 8 * c) = o; }
    asm volatile("s_waitcnt lgkmcnt(0)" ::: "memory");
}

__device__ __forceinline__ void norm_mod_row(const float* xrow, const float* g, const float* sc, const float* sh, bf16_t* orow, int lane) {
    const f32x4* xr = (const f32x4*)xrow + lane;
    f32x4 v[16]; float s = 0.f;
#pragma unroll
    for (int j = 0; j < 16; ++j) { v[j] = xr[64 * j]; s += (v[j].x * v[j].x + v[j].y * v[j].y) + (v[j].z * v[j].z + v[j].w * v[j].w); }
    const float rstd = 1.0f / sqrtf(wave_sum(s) * (1.0f / DM) + EPS);
    u32x2* o8 = (u32x2*)orow + lane;
#pragma unroll
    for (int j = 0; j < 16; ++j) { const f32x4 gg = ((const f32x4*)g)[lane + 64 * j], ss = ((const f32x4*)sc)[lane + 64 * j], hh = ((const f32x4*)sh)[lane + 64 * j];
        const f32x4 y = (v[j] * rstd) * gg * (ss + 1.0f) + hh; o8[64 * j] = pg8::pack4(y); }
}

template <int NKS>
__device__ __forceinline__ void ctx_fold_norm_row(LAS float* red, const float* xrow, float* xout, const float* slab, size_t kstride, const float* gate,
                                                  const float* g, const float* sc, const float* sh, bf16_t* orow, int lane, int wave, float fa = 1.f, float fb = 1.f) {
    f32x4 v[2]; float s = 0.f;
#pragma unroll
    for (int q = 0; q < 2; ++q) { const int idx = lane + 64 * (2 * wave + q);
        f32x4 a = (f32x4){0.f, 0.f, 0.f, 0.f};
#pragma unroll
        for (int ks = 0; ks < NKS; ++ks) a += ((const f32x4*)(slab + (size_t)ks * kstride))[idx] * (ks < NKS / 2 ? fa : fb);
        v[q] = ((const f32x4*)xrow)[idx] + ((const f32x4*)gate)[idx] * a;
        ((f32x4*)xout)[idx] = v[q];
        s += (v[q].x * v[q].x + v[q].y * v[q].y) + (v[q].z * v[q].z + v[q].w * v[q].w); }
    s = wave_sum(s);
    if (lane == 0) red[wave] = s;
    __syncthreads();
    float tot = 0.f;
#pragma unroll
    for (int w = 0; w < 8; ++w) tot += red[w];
    const float rstd = 1.0f / sqrtf(tot * (1.0f / DM) + EPS);
#pragma unroll
    for (int q = 0; q < 2; ++q) { const int idx = lane + 64 * (2 * wave + q);
        const f32x4 gg = ((const f32x4*)g)[idx], ss = ((const f32x4*)sc)[idx], hh = ((const f32x4*)sh)[idx];
        const f32x4 y = (v[q] * rstd) * gg * (ss + 1.0f) + hh; ((u32x2*)orow)[idx] = pg8::pack4(y); }
    __syncthreads();
}
__device__ __forceinline__ void scale_row(const float* xrow, const float* gam, bf16_t* orow, float* ss, int lane) {
    const f32x4* xr = (const f32x4*)xrow + lane; u32x2* o8 = (u32x2*)orow + lane; float s = 0.f;
#pragma unroll
    for (int j = 0; j < 16; ++j) { const f32x4 v = xr[64 * j]; s += (v.x * v.x + v.y * v.y) + (v.z * v.z + v.w * v.w);
        o8[64 * j] = pg8::pack4(v * ((const f32x4*)gam)[lane + 64 * j]); }
    s = wave_sum(s);
    if (lane == 0) *ss = s;
}
__device__ __forceinline__ void norm_final_row(const float* xrow, const float* g, float* orow, int lane) {
    const f32x4* xr = (const f32x4*)xrow + lane;
    f32x4 v[16]; float s = 0.f;
#pragma unroll
    for (int j = 0; j < 16; ++j) { v[j] = xr[64 * j]; s += (v[j].x * v[j].x + v[j].y * v[j].y) + (v[j].z * v[j].z + v[j].w * v[j].w); }
    const float rstd = 1.0f / sqrtf(wave_sum(s) * (1.0f / DM) + EPS);
    f32x4* o = (f32x4*)orow + lane;
#pragma unroll
    for (int j = 0; j < 16; ++j) { const f32x4 gg = ((const f32x4*)g)[lane + 64 * j]; o[64 * j] = (v[j] * rstd) * gg; }
}
__device__ __forceinline__ void mixnorm_row(bf16_t* row, const float* ga, const float* gf, int lane) {
    u32x4* p = (u32x4*)row + lane;
    u32x4 w[8]; float sa = 0.f, sf = 0.f;
#pragma unroll
    for (int i = 0; i < 8; ++i) { w[i] = p[64 * i];
        float s = 0.f;
#pragma unroll
        for (int e = 0; e < 4; ++e) { const float lo = __builtin_bit_cast(float, w[i][e] << 16), hi = __builtin_bit_cast(float, w[i][e] & 0xffff0000u); s += lo * lo + hi * hi; }
        if (i < 4) sa += s; else sf += s; }
    const float ra = 1.0f / sqrtf(wave_sum(sa) * (1.0f / QW) + EPS), rf = 1.0f / sqrtf(wave_sum(sf) * (1.0f / FW) + EPS);
#pragma unroll
    for (int i = 0; i < 8; ++i) { const float rs = i < 4 ? ra : rf; const float* g = (i < 4 ? ga + 512 * i : gf + 512 * (i - 4)) + 8 * lane;
        const f32x4 g0 = *(const f32x4*)g, g1 = *(const f32x4*)(g + 4);
        u32x4 o;
#pragma unroll
        for (int e = 0; e < 4; ++e) { const float lo = __builtin_bit_cast(float, w[i][e] << 16), hi = __builtin_bit_cast(float, w[i][e] & 0xffff0000u);
            const float glo = e < 2 ? g0[2 * e] : g1[2 * e - 4], ghi = e < 2 ? g0[2 * e + 1] : g1[2 * e - 3];
            o[e] = cvt_pk_bf16(lo * rs * glo, hi * rs * ghi); }
        p[64 * i] = o; }
}

struct Args {
    const float* x; const float* c; const float* ctx; const float* c_ctx; const float* ada_a; const float* ada_b; const float* ada_bias; const float* g_mix;
    const float* w_in; const float* sink; const float* w_f; const float* g_attn; const float* g_four; const float* w_out; const float* g_mlp; const float* w1; const float* w2; const float* g_final;
    float* out; unsigned char* ws; int ph_lo, ph_hi;
};
constexpr int NPH_PRO = 3, NPH_LAYER = 11, NPH = NPH_PRO + DEPTH * NPH_LAYER + 1;

__global__ void __launch_bounds__(NWAVES * 64, 2) fwd_kernel(Args args) {
    extern __shared__ __attribute__((aligned(16))) unsigned char lds_raw[];
    LAS unsigned char* lds = (LAS unsigned char*)lds_raw;
    const int G = gridDim.x, bx = blockIdx.x, NGW = G * NWAVES;
#define LANEVARS int tid = threadIdx.x; asm volatile("" : "+v"(tid)); const int lane = tid & 63, wave = __builtin_amdgcn_readfirstlane(tid >> 6), gw = bx * NWAVES + wave; (void)lane; (void)gw;
    unsigned char* ws = args.ws;
    unsigned* ctl = (unsigned*)(ws + WS_CTL);
    float* MOD = (float*)(ws + WS_MOD); float* TPART = (float*)(ws + WS_TPART);
    float* COS = (float*)(ws + WS_ROPE); float* SIN = COS + 256 * 32;
    f32x2* TW = (f32x2*)(ws + WS_TW);
    bf16_t* FM1 = (bf16_t*)(ws + WS_FM1); bf16_t* FM2 = (bf16_t*)(ws + WS_FM2); bf16_t* FC = (bf16_t*)(ws + WS_FC); bf16_t* CS = (bf16_t*)(ws + WS_CS);
    bf16_t* WFRAW = (bf16_t*)(ws + WS_WFRAW); bf16_t* WFT = (bf16_t*)(ws + WS_WFT);
    bf16_t* WIN = (bf16_t*)(ws + WS_WIN); bf16_t* WOUT = (bf16_t*)(ws + WS_WOUT); bf16_t* W1T = (bf16_t*)(ws + WS_W1); bf16_t* W2T = (bf16_t*)(ws + WS_W2);
    float* GAM = (float*)(ws + WS_GAM); float* BIASIN = (float*)(ws + WS_BIASIN); float* BIAS1 = (float*)(ws + WS_BIAS1); float* SSQ = (float*)(ws + WS_SS); float* SSAF = (float*)(ws + WS_SSAF);
    float* XW = (float*)(ws + WS_XW); bf16_t* HX = (bf16_t*)(ws + WS_HX); bf16_t* PX = (bf16_t*)(ws + WS_PX); bf16_t* MIX = (bf16_t*)(ws + WS_MIX);
    bf16_t* ZT2 = (bf16_t*)(ws + WS_ZT2); bf16_t* Y2 = (bf16_t*)(ws + WS_Y2); bf16_t* ZTC = (bf16_t*)(ws + WS_ZTC); bf16_t* HB = (bf16_t*)(ws + WS_H);

    for (int u = threadIdx.x; u < (LDS_BYTES - LDSCTL_OFF) / 4; u += NWAVES * 64) ((LAS unsigned*)(lds + LDSCTL_OFF))[u] = 0u;
    __syncthreads();
#if MK_PER_PHASE
#define GRID_BAR() do { } while (0)
#else
    XcdBarrier bar = xcd_barrier_post(ctl + CW_BAR, (volatile LAS unsigned*)(lds + MISC_OFF) + 8);
#define GRID_BAR() xcd_barrier(bar)
#endif
    const int lo = args.ph_lo, hi = args.ph_hi;
#ifndef SITEMASK
#define SITEMASK 0xFFFF
#endif
#define EN(s) (((SITEMASK) >> (s)) & 1)
#ifndef REPMASK
#define REPMASK 0
#endif
#ifndef REPLMIN
#define REPLMIN 0
#endif
#ifndef REPCOUNT
#define REPCOUNT 2
#endif
#define NREP0(s) ((((REPMASK) >> (s)) & 1) ? REPCOUNT : 1)
#ifndef REPLMAX
#define REPLMAX 99
#endif
#define NREP(s) (((((REPMASK) >> (s)) & 1) && l >= REPLMIN && l <= REPLMAX) ? REPCOUNT : 1)
#define IN(k) (lo <= (k) && (k) < hi)
#define SEAM(k) do { if (IN(k) && IN((k) + 1)) GRID_BAR(); } while (0)

    for (int rep = 0; rep < NREP0(0); ++rep) if (EN(0) && IN(0)) {
        LANEVARS
        for (int it = bx; it < DEPTH * 16 * 4; it += G) {
            const int l = it >> 6, rc = (it >> 2) & 15, dp = it & 3, rr = tid & 31, dg = tid >> 5;
            float s0 = 0.f, s1 = 0.f;
            const float* ap = args.ada_a + (size_t)l * DM * ARANK + rc * 32 + rr;
            for (int i = 0; i < 64; ++i) { const int d = dp * 1024 + dg + 16 * i; const float av = ap[(size_t)d * ARANK];
                const float c0 = args.c[d], c1 = args.c_ctx[d];
                s0 += (c0 / (1.0f + __expf(-c0))) * av; s1 += (c1 / (1.0f + __expf(-c1))) * av; }
            LAS float* red = (LAS float*)lds;
            red[(dg * 32 + rr) * 2 + 0] = s0; red[(dg * 32 + rr) * 2 + 1] = s1;
            __syncthreads();
            if (tid < 64) { const int r2 = tid & 31, v = tid >> 5; float s = 0.f;
                for (int q = 0; q < 16; ++q) s += red[(q * 32 + r2) * 2 + v];
                TPART[((l * 4 + dp) * 2 + v) * ARANK + rc * 32 + r2] = s; }
            __syncthreads();
        }
        const int gt = bx * (NWAVES * 64) + tid, NT = G * NWAVES * 64;
        for (int i = gt; i < DEPTH * 2 * SEQ; i += NT) SSQ[i] = 0.f;
        for (int i = gt; i < DEPTH * 2 * MT; i += NT) SSAF[i] = 0.f;
        for (int i = gt; i < DEPTH * INW; i += NT) BIASIN[i] = 0.f;
        for (int i = gt; i < DEPTH * DFF; i += NT) BIAS1[i] = 0.f;
        for (int i = gt; i < 256 * 32; i += NT) { const int pos = i >> 5, j = i & 31;
            const float inv = __builtin_amdgcn_exp2f(-(float)j * (13.287712379549449f / 32.0f));
            const float rev = (float)pos * inv * 0.15915494309189535f;
            COS[i] = cos_rev(rev); SIN[i] = sin_rev(rev); }
        for (int i = gt; i < 16384; i += NT) { const float rev = (float)i * (1.0f / 16384.0f); TW[i] = (f32x2){cos_rev(rev), sin_rev(rev)}; }
        for (int i = gt; i < 256 * 256; i += NT) { const int m = i >> 8, k = i & 255, ro = m >> 7, kk = m & 127, ri = k >> 7, ll = k & 127;
            const float rev = (float)((kk * ll) & 127) * (1.0f / 128.0f); const float cv = cos_rev(rev) * 0.08838834764831845f, sv = sin_rev(rev) * 0.08838834764831845f;
            FM1[i] = (bf16_t)f2bf(ro == 0 ? (ri == 0 ? cv : sv) : (ri == 0 ? -sv : cv));
            FM2[i] = (bf16_t)f2bf(ro == 0 ? (ri == 0 ? cv : sv) : 0.f); }
        for (int i = gt; i < 256 * 512; i += NT) { const int k = i >> 9, q = i & 511, ri = q >> 8, ll = q & 255;
            const float rev = (float)((k * ll) & 255) * (1.0f / 256.0f);
            FC[i] = (bf16_t)f2bf((ri == 0 ? cos_rev(rev) : sin_rev(rev)) * 0.0625f); }
        for (int i = gt; i < 1024 * 512; i += NT) { const int n = i >> 9, m = i & 511, ri = n >> 9, cch = n & 511;
            const float rev = (float)((cch * m) & 511) * (1.0f / 512.0f);
            CS[i] = (bf16_t)f2bf((ri == 0 ? cos_rev(rev) : -sin_rev(rev)) * 0.04419417382415922f); }
    }
    SEAM(0);
    if (EN(1) && IN(1)) {
        LANEVARS
        for (int it = bx; it < DEPTH * 96; it += G) {
            const int l = it / 96, jc = it - l * 96;
            LAS float* tl = (LAS float*)lds;
            LAS float* red = tl + 1024;
            for (int q = tid; q < 1024; q += NWAVES * 64) { const int v = q >> 9, r = q & 511; float s = 0.f;
                for (int dp = 0; dp < 4; ++dp) s += TPART[((l * 4 + dp) * 2 + v) * ARANK + r];
                tl[q] = s; }
            __syncthreads();
            const int th = tid >> 8, jj = tid & 255, j = jc * 256 + jj;
            const float* bp = args.ada_b + (size_t)l * ARANK * (NMOD * DM) + j;
            float s0 = 0.f, s1 = 0.f;
#pragma unroll 8
            for (int r = th * 256; r < th * 256 + 256; ++r) { const float bv = bp[(size_t)r * (NMOD * DM)]; s0 += tl[r] * bv; s1 += tl[512 + r] * bv; }
            red[(th * 256 + jj) * 2 + 0] = s0; red[(th * 256 + jj) * 2 + 1] = s1;
            __syncthreads();
            if (tid < 256) { const float bias = args.ada_bias[(size_t)l * (NMOD * DM) + j];
                const float m0 = bias + red[(0 * 256 + jj) * 2 + 0] + red[(1 * 256 + jj) * 2 + 0];
                MOD[(size_t)(l * 2 + 0) * (NMOD * DM) + j] = m0;
                if (j >= 1 * DM && j < 2 * DM) GAM[(size_t)(l * 2 + 0) * DM + (j - 1 * DM)] = args.g_mix[(size_t)l * DM + (j - 1 * DM)] * (1.0f + m0);
                if (j >= 4 * DM && j < 5 * DM) GAM[(size_t)(l * 2 + 1) * DM + (j - 4 * DM)] = args.g_mlp[(size_t)l * DM + (j - 4 * DM)] * (1.0f + m0);
                MOD[(size_t)(l * 2 + 1) * (NMOD * DM) + j] = bias + red[(0 * 256 + jj) * 2 + 1] + red[(1 * 256 + jj) * 2 + 1]; }
            __syncthreads();
        }
    }
    SEAM(1);
    for (int rep = 0; rep < NREP0(15); ++rep) if (EN(15) && IN(2)) {
        LANEVARS
        LAS float* scr = (LAS float*)(lds + wave * 16384);
        constexpr int I_IN = (DM / 64) * (INW / 32), I_OUT = (DM / 64) * (DM / 32), I_1 = (DM / 64) * (DFF / 32), I_2 = (DFF / 64) * (DM / 32), I_F = (512 / 64) * (512 / 32);
        constexpr int PER_L = I_IN + I_OUT + I_1 + I_2 + 4 * I_F, NITEMS = DEPTH * PER_L;
        for (int it = gw; it < NITEMS; it += NGW) {
            const int l = it / PER_L; int r = it - l * PER_L;
            const float* modl = MOD + (size_t)(l * 2 + 0) * (NMOD * DM);
            if (r < I_IN) { transpose_item<true, true>(args.w_in + (size_t)l * DM * INW, DM, INW, WIN + (size_t)l * INW * DM, scr, r, lane, modl + 0 * DM, BIASIN + (size_t)l * INW); continue; } r -= I_IN;
            if (r < I_OUT) { const int kb_ = r / (DM / 32);
                const float* ks = kb_ < QW / 64 ? args.g_attn + (size_t)l * QW : args.g_four + (size_t)l * FW - QW;
                transpose_item<false, false>(args.w_out + (size_t)l * DM * DM, DM, DM, WOUT + (size_t)l * DM * DM, scr, r, lane, nullptr, nullptr, ks); continue; } r -= I_OUT;
            if (r < I_1) { transpose_item<false, true>(args.w1 + (size_t)l * DM * DFF, DM, DFF, W1T + (size_t)l * DFF * DM, scr, r, lane, modl + 3 * DM, BIAS1 + (size_t)l * DFF); continue; } r -= I_1;
            if (r < I_2) { transpose_item<false, false>(args.w2 + (size_t)l * DFF * DM, DFF, DM, W2T + (size_t)l * DM * DFF, scr, r, lane); continue; } r -= I_2;
            const int gq = r / I_F; r -= gq * I_F;
            transpose_item<false, false>(args.w_f + (size_t)(l * 4 + gq) * 512 * 512, 512, 512, WFRAW + (size_t)(l * 4 + gq) * 512 * 512, scr, r, lane);
        }
    }
    SEAM(2);

    float* SLAB = (float*)(ws + WS_SLAB); float* XB = (float*)(ws + WS_XB);
    float* XWC = XW + (size_t)SEQ * DM;
    for (int l = 0; l < DEPTH; ++l) {
        const int pb = NPH_PRO + l * NPH_LAYER;
        const bool cact = (l != DEPTH - 1);
        const float* modl = MOD + (size_t)(l * 2 + 0) * (NMOD * DM);
        const float* modc = MOD + (size_t)(l * 2 + 1) * (NMOD * DM);
        const float* xlat = l == 0 ? args.x : XW;
        for (int rep = 0; rep < NREP(2); ++rep) if (EN(2) && IN(pb + 0)) {
            LANEVARS
            const float* g = args.g_mix + (size_t)l * DM;
            if (l == 0) {
                for (int m = gw; m < SEQ; m += NGW) scale_row(args.x + (size_t)m * DM, GAM, HX + (size_t)m * DM, SSQ + m, lane);
                for (int r = gw; r < CTX; r += NGW) norm_mod_row(args.ctx + (size_t)r * DM, g, modc + 1 * DM, modc + 0 * DM, HX + (size_t)(SEQ + r) * DM, lane);
                __syncthreads();
                { pg8::Gemm gg{512, 1024u, 1024u, (size_t)128 * 1024, (size_t)128 * 1024};
                  pg8::SchedWf S{G, bx, (const char*)WFRAW, (const char*)CS}; pg8::EpiWf E{WFT};
                  pg8::gemm_phase<pg8::EpiWf, pg8::SchedWf>(lds, gg, S, E); }
            } else { for (int r = bx; r < CTX; r += G)
                       ctx_fold_norm_row<16>((LAS float*)lds, XWC + (size_t)r * DM, XWC + (size_t)r * DM, SLAB + (size_t)r * DM, (size_t)256 * DM, modc - 2 * (NMOD * DM) + 5 * DM,
                                             g, modc + 1 * DM, modc + 0 * DM, HX + (size_t)(SEQ + r) * DM, lane, wave); }
        }
        SEAM(pb + 0);
        for (int rep = 0; rep < NREP(3); ++rep) if (EN(3) && IN(pb + 1)) {
            { pg8::Gemm g{DM, (unsigned)(DM * 2), (unsigned)(DM * 2), (size_t)128 * DM * 2, (size_t)128 * DM * 2};
              pg8::SchedStd S; S.init(SEQ / 256, INW / 256, G, bx, HX, (size_t)256 * DM * 2, WIN + (size_t)l * INW * DM, (size_t)256 * DM * 2);
              pg8::EpiInproj E{PX, COS, SIN, SSQ + (size_t)(l * 2 + 0) * SEQ, BIASIN + (size_t)l * INW};
              pg8::gemm_phase<pg8::EpiInproj, pg8::SchedStd>(lds, g, S, E); }
            { const int nks = cact ? 8 : 16, kp = DM / nks, ntile = cact ? 20 : 4, pn0 = cact ? 0 : 8;
              pg8::Gemm g{kp, (unsigned)(DM * 2), (unsigned)(DM * 2), (size_t)128 * DM * 2, (size_t)128 * DM * 2};
              pg8::SchedPiece S{G, bx, ntile * nks, nks, pn0, (const char*)(HX + (size_t)SEQ * DM), (const char*)(WIN + (size_t)l * INW * DM), (size_t)256 * DM * 2, (size_t)kp * 2};
              pg8::EpiSlab E{SLAB, INW};
              pg8::gemm_phase<pg8::EpiSlab, pg8::SchedPiece>(lds, g, S, E); }
        }
        SEAM(pb + 1);
        for (int rep = 0; rep < NREP(4); ++rep) if (EN(4) && IN(pb + 2)) {
            LANEVARS
            const int nks = cact ? 8 : 16, c4lo = cact ? 0 : K_LO / 4, c4n = cact ? INW / 4 : 1024 / 4;
            for (int i = bx * (NWAVES * 64) + tid; i < 256 * c4n; i += G * NWAVES * 64) {
                const int r = i / c4n, cv = (c4lo + i % c4n) * 4;
                f32x4 a = (f32x4){0.f, 0.f, 0.f, 0.f};
                for (int ks = 0; ks < nks; ++ks) a += *(const f32x4*)(SLAB + ((size_t)ks * 256 + r) * INW + cv);
                int ct = cv;
                if (cv < K_LO + 512) { const int v = cv & 127, wc = v >> 5, fq = (v >> 3) & 3, n = (v >> 2) & 1; ct = (cv & ~127) + 64 * (wc >> 1) + 32 * n + 16 * (wc & 1) + 4 * fq; }
                *(u32x2*)(PX + (size_t)(SEQ + r) * INW + ct) = pg8::pack4(a);
            }
        }
        SEAM(pb + 2);
        for (int rep = 0; rep < NREP(5); ++rep) if (EN(5) && IN(pb + 3)) {
            const float* sk = args.sink + l * NHEAD;
            const int nitems = cact ? 1040 : 1024;
            for (int it = bx; it < nitems; it += G) {
                int qrow0, ntile, w0; const int kvh = (it >> 1) & 3, hp = it & 1;
                if (it < 1024) { const int n = it >> 3; w0 = n == 0 ? 0 : 128 * (n - 1); const int w1 = n == 127 ? SEQ : 128 * (n + 2); qrow0 = 128 * n; ntile = 4 + (w1 - w0) / 64; }
                else { qrow0 = SEQ + 128 * ((it - 1024) >> 3); ntile = 4; w0 = 0; }
                att::attn_item((LAS char*)lds, PX, MIX, SSAF + (size_t)(l * 2 + 0) * MT, sk, qrow0, kvh, hp, ntile, w0);
            }
            { pg8::Gemm g{512, 2048u, (unsigned)(128 * INW * 2), (size_t)128 * 2048, (size_t)INW * 2};
              pg8::SchedGa S{G, bx, (const char*)(WFT + (size_t)l * 4 * 512 * 1024), (const char*)(PX + F_LO)}; pg8::EpiGa E{ZT2};
              pg8::gemm_phase<pg8::EpiGa, pg8::SchedGa>(lds, g, S, E); }
            if (cact) {
              pg8::Gemm g{512, 2048u, (unsigned)(INW * 2), (size_t)128 * 2048, (size_t)128 * INW * 2};
              pg8::SchedGaCtx S{G, bx, (const char*)(WFT + (size_t)l * 4 * 512 * 1024), (const char*)(PX + F_LO)}; pg8::EpiGaCtx E{ZTC};
              pg8::gemm_phase<pg8::EpiGaCtx, pg8::SchedGaCtx>(lds, g, S, E); }
        }
        SEAM(pb + 3);
        for (int rep = 0; rep < NREP(6); ++rep) if (EN(6) && IN(pb + 4)) {
            { pg8::Gemm g{256, 512u, 512u, (size_t)128 * 512, (size_t)128 * 512};
              pg8::SchedN S{G, bx, 1024, (const char*)FM1, (const char*)ZT2, (size_t)256 * 512}; pg8::EpiGb E{Y2, TW};
              pg8::gemm_phase<pg8::EpiGb, pg8::SchedN>(lds, g, S, E); }
            if (cact) {
              pg8::Gemm g{512, 1024u, 1024u, (size_t)128 * 1024, (size_t)128 * 1024};
              pg8::SchedN S{G, bx, 8, (const char*)FC, (const char*)ZTC, (size_t)256 * 1024}; pg8::EpiGctx E{MIX, SSAF + (size_t)(l * 2 + 1) * MT};
              pg8::gemm_phase<pg8::EpiGctx, pg8::SchedN>(lds, g, S, E); }
        }
        SEAM(pb + 4);
        for (int rep = 0; rep < NREP(7); ++rep) if (EN(7) && IN(pb + 5)) {
            pg8::Gemm g{256, 512u, 512u, (size_t)128 * 512, (size_t)128 * 512};
            pg8::SchedN S{G, bx, 1024, (const char*)FM2, (const char*)Y2, (size_t)256 * 512}; pg8::EpiGc E{MIX, SSAF + (size_t)(l * 2 + 1) * MT};
            pg8::gemm_phase<pg8::EpiGc, pg8::SchedN>(lds, g, S, E);
        }
        SEAM(pb + 5);
        for (int rep = 0; rep < NREP(9); ++rep) if (EN(9) && IN(pb + 6)) {
            { pg8::Gemm g{DM, (unsigned)(DM * 2), (unsigned)(DM * 2), (size_t)128 * DM * 2, (size_t)128 * DM * 2};
              pg8::SchedStd S; S.init(SEQ / 256, DM / 256, G, bx, MIX, (size_t)256 * DM * 2, WOUT + (size_t)l * DM * DM, (size_t)256 * DM * 2);
              pg8::EpiResid<true> E{xlat, XB, modl + 2 * DM, GAM + (size_t)(l * 2 + 1) * DM, HX, SSQ + (size_t)(l * 2 + 1) * SEQ, SSAF + (size_t)(l * 2 + 0) * MT, SSAF + (size_t)(l * 2 + 1) * MT};
              pg8::gemm_phase<pg8::EpiResid<true>, pg8::SchedStd>(lds, g, S, E); }
            if (cact) {
              pg8::Gemm g{512, (unsigned)(DM * 2), (unsigned)(DM * 2), (size_t)128 * DM * 2, (size_t)128 * DM * 2};
              pg8::SchedPiece S{G, bx, 16 * 8, 8, 0, (const char*)(MIX + (size_t)SEQ * DM), (const char*)(WOUT + (size_t)l * DM * DM), (size_t)256 * DM * 2, (size_t)512 * 2};
              pg8::EpiSlab E{SLAB, DM};
              pg8::gemm_phase<pg8::EpiSlab, pg8::SchedPiece>(lds, g, S, E); }
        }
        SEAM(pb + 6);
        for (int rep = 0; rep < NREP(10); ++rep) if (EN(10) && IN(pb + 7)) {
            LANEVARS
            const float* g = args.g_mlp + (size_t)l * DM;
            if (cact) { for (int r = bx; r < CTX; r += G) {
                            const float ra = 1.0f / sqrtf(SSAF[(size_t)(l * 2 + 0) * MT + SEQ + r] * (1.0f / QW) + EPS), rf = 1.0f / sqrtf(SSAF[(size_t)(l * 2 + 1) * MT + SEQ + r] * (1.0f / FW) + EPS);
                            ctx_fold_norm_row<8>((LAS float*)lds, (l == 0 ? args.ctx : XWC) + (size_t)r * DM, XWC + (size_t)r * DM, SLAB + (size_t)r * DM, (size_t)256 * DM, modc + 2 * DM,
                                                 g, modc + 4 * DM, modc + 3 * DM, HX + (size_t)(SEQ + r) * DM, lane, wave, ra, rf); } }
        }
        SEAM(pb + 7);
        for (int rep = 0; rep < NREP(11); ++rep) if (EN(11) && IN(pb + 8)) {
            { pg8::Gemm g{DM, (unsigned)(DM * 2), (unsigned)(DM * 2), (size_t)128 * DM * 2, (size_t)128 * DM * 2};
              pg8::SchedStd S; S.init(SEQ / 256, DFF / 256, G, bx, HX, (size_t)256 * DM * 2, W1T + (size_t)l * DFF * DM, (size_t)256 * DM * 2);
              pg8::EpiRelu2 E{HB, SSQ + (size_t)(l * 2 + 1) * SEQ, BIAS1 + (size_t)l * DFF};
              pg8::gemm_phase<pg8::EpiRelu2, pg8::SchedStd>(lds, g, S, E); }
            if (cact) {
              pg8::Gemm g{1024, (unsigned)(DM * 2), (unsigned)(DM * 2), (size_t)128 * DM * 2, (size_t)128 * DM * 2};
              pg8::SchedPiece S{G, bx, 64 * 4, 4, 0, (const char*)(HX + (size_t)SEQ * DM), (const char*)(W1T + (size_t)l * DFF * DM), (size_t)256 * DM * 2, (size_t)1024 * 2};
              pg8::EpiSlab E{SLAB, DFF};
              pg8::gemm_phase<pg8::EpiSlab, pg8::SchedPiece>(lds, g, S, E); }
        }
        SEAM(pb + 8);
        if (EN(12) && IN(pb + 9) && cact) {
            LANEVARS
            for (int i = bx * (NWAVES * 64) + tid; i < 256 * (DFF / 4); i += G * NWAVES * 64) {
                const int r = i / (DFF / 4), c4 = (i % (DFF / 4)) * 4;
                f32x4 a = (f32x4){0.f, 0.f, 0.f, 0.f};
#pragma unroll
                for (int ks = 0; ks < 4; ++ks) a += *(const f32x4*)(SLAB + ((size_t)ks * 256 + r) * DFF + c4);
#pragma unroll
                for (int e = 0; e < 4; ++e) { const float t = fmaxf(a[e], 0.f); a[e] = t * t; }
                *(u32x2*)(HB + (size_t)(SEQ + r) * DFF + c4) = pg8::pack4(a);
            }
        }
        SEAM(pb + 9);
        for (int rep = 0; rep < NREP(13); ++rep) if (EN(13) && IN(pb + 10)) {
            { pg8::Gemm g{DFF, (unsigned)(DFF * 2), (unsigned)(DFF * 2), (size_t)128 * DFF * 2, (size_t)128 * DFF * 2};
              pg8::SchedStd S; S.init(SEQ / 256, DM / 256, G, bx, HB, (size_t)256 * DFF * 2, W2T + (size_t)l * DM * DFF, (size_t)256 * DFF * 2);
              pg8::EpiResid<false> E{XB, XW, modl + 5 * DM, l < DEPTH - 1 ? GAM + (size_t)((l + 1) * 2 + 0) * DM : nullptr, HX, SSQ + (size_t)((l + 1 < DEPTH ? l + 1 : l) * 2 + 0) * SEQ, nullptr, nullptr};
              pg8::gemm_phase<pg8::EpiResid<false>, pg8::SchedStd>(lds, g, S, E); }
            if (cact) {
              pg8::Gemm g{1024, (unsigned)(DFF * 2), (unsigned)(DFF * 2), (size_t)128 * DFF * 2, (size_t)128 * DFF * 2};
              pg8::SchedPiece S{G, bx, 16 * 16, 16, 0, (const char*)(HB + (size_t)SEQ * DFF), (const char*)(W2T + (size_t)l * DM * DFF), (size_t)256 * DFF * 2, (size_t)1024 * 2};
              pg8::EpiSlab E{SLAB, DM};
              pg8::gemm_phase<pg8::EpiSlab, pg8::SchedPiece>(lds, g, S, E); }
        }
        SEAM(pb + 10);
    }
    if (EN(14) && IN(NPH - 1)) {
        LANEVARS
        for (int m = gw; m < SEQ; m += NGW) norm_final_row(XW + (size_t)m * DM, args.g_final, args.out + (size_t)m * DM, lane);
    }
#undef IN
#undef SEAM
#undef GRID_BAR
}

extern "C" void kernel_launch(void* const* d_in, const int* in_sizes, int n_in, void* d_out, int out_size, void* d_ws, size_t ws_size, hipStream_t stream) {
    static int grid = 0;
    if (grid == 0) {
        if (n_in != 18 || out_size != SEQ * DM || ws_size < WS_END) { fprintf(stderr, "kernel_launch: unexpected shapes: n_in %d out %d ws %zu (need %zu)\n", n_in, out_size, ws_size, (size_t)WS_END); grid = -1; return; }
        int dev = 0, cus = 0, per_cu = 0;
        if (hipGetDevice(&dev) != hipSuccess || hipDeviceGetAttribute(&cus, hipDeviceAttributeMultiprocessorCount, dev) != hipSuccess) { grid = -1; return; }
        if (hipFuncSetAttribute((const void*)fwd_kernel, hipFuncAttributeMaxDynamicSharedMemorySize, LDS_BYTES) != hipSuccess) { fprintf(stderr, "kernel_launch: hipFuncSetAttribute failed\n"); grid = -1; return; }
        if (hipOccupancyMaxActiveBlocksPerMultiprocessor(&per_cu, (const void*)fwd_kernel, NWAVES * 64, LDS_BYTES) != hipSuccess || per_cu < 1) { fprintf(stderr, "kernel_launch: occupancy query says %d\n", per_cu); }
        (void)hipGetLastError();
        grid = cus;
    }
    if (grid < 0) return;
    (void)hipMemsetAsync((char*)d_ws + WS_CTL, 0, CTL_ZERO_BYTES, stream);
    Args a{};
    a.x = (const float*)d_in[0]; a.c = (const float*)d_in[1]; a.ctx = (const float*)d_in[2]; a.c_ctx = (const float*)d_in[3];
    a.ada_a = (const float*)d_in[4]; a.ada_b = (const float*)d_in[5]; a.ada_bias = (const float*)d_in[6]; a.g_mix = (const float*)d_in[7];
    a.w_in = (const float*)d_in[8]; a.sink = (const float*)d_in[9]; a.w_f = (const float*)d_in[10]; a.g_attn = (const float*)d_in[11];
    a.g_four = (const float*)d_in[12]; a.w_out = (const float*)d_in[13]; a.g_mlp = (const float*)d_in[14]; a.w1 = (const float*)d_in[15];
    a.w2 = (const float*)d_in[16]; a.g_final = (const float*)d_in[17];
    a.out = (float*)d_out; a.ws = (unsigned char*)d_ws;
#if MK_PER_PHASE
    for (int p = 0; p < NPH; ++p) { a.ph_lo = p; a.ph_hi = p + 1; hipLaunchKernelGGL(fwd_kernel, dim3(grid), dim3(NWAVES * 64), LDS_BYTES, stream, a); }
#else
    a.ph_lo = 0; a.ph_hi = NPH;
    hipLaunchKernelGGL(fwd_kernel, dim3(grid), dim3(NWAVES * 64), LDS_BYTES, stream, a);
#endif
    const hipError_t le = hipPeekAtLastError();
    if (le != hipSuccess) fprintf(stderr, "kernel_launch: launch failed: %s\n", hipGetErrorName(le));
}
```

```cpp
#include <hip/hip_runtime.h>
#include <cstdio>
#include <cstdint>

#ifndef MK_PER_PHASE
#define MK_PER_PHASE 0
#endif

#define LAS __attribute__((address_space(3)))
typedef unsigned short bf16_t;
typedef short bf16x8 __attribute__((ext_vector_type(8)));
typedef short s16x4 __attribute__((ext_vector_type(4)));
typedef float f32x2 __attribute__((ext_vector_type(2)));
typedef float f32x4 __attribute__((ext_vector_type(4)));
typedef float f32x16 __attribute__((ext_vector_type(16)));
typedef unsigned u32x2 __attribute__((ext_vector_type(2)));
typedef unsigned u32x4 __attribute__((ext_vector_type(4)));

constexpr int DM = 4096, SEQ = 16384, CTX = 256, MT = SEQ + CTX, DEPTH = 4;
constexpr int NHEAD = 16, NKVH = 4, HD = 128, QW = 2048, FW = 2048, INW = 5120, DFF = 16384, ARANK = 512, NMOD = 6;
constexpr int K_LO = 2048, V_LO = 2560, F_LO = 3072;
constexpr float EPS = 1e-6f;

constexpr size_t MiB = 1u << 20;
constexpr size_t WS_CTL = 0, CTL_ZERO_BYTES = 1 * MiB;
constexpr size_t WS_MOD = 1 * MiB;
constexpr size_t WS_TPART = 2 * MiB;
constexpr size_t WS_ROPE = 2 * MiB + 256 * 1024;
constexpr size_t WS_TW = 2 * MiB + 512 * 1024;
constexpr size_t WS_FM1 = 3 * MiB, WS_FM2 = 3 * MiB + 128 * 1024, WS_FC = 3 * MiB + 256 * 1024, WS_CS = 3 * MiB + 512 * 1024;
constexpr size_t WS_WFRAW = 5 * MiB;
constexpr size_t WS_WFT = 13 * MiB;
constexpr size_t WS_GAM = 29 * MiB;
constexpr size_t WS_BIASIN = 29 * MiB + 256 * 1024;
constexpr size_t WS_BIAS1 = 29 * MiB + 512 * 1024;
constexpr size_t WS_SS = 30 * MiB;
constexpr size_t WS_SSAF = 30 * MiB + 512 * 1024;
constexpr size_t WS_WIN = 32 * MiB;
constexpr size_t WS_WOUT = 192 * MiB;
constexpr size_t WS_W1 = 320 * MiB;
constexpr size_t WS_W2 = 832 * MiB;
constexpr size_t WS_XW = 1344 * MiB;
constexpr size_t WS_HX = 1604 * MiB;
constexpr size_t WS_PX = 1734 * MiB;
constexpr size_t WS_MIX = 1897 * MiB;
constexpr size_t WS_ZT2 = 2027 * MiB;
constexpr size_t WS_Y2 = 2155 * MiB;
constexpr size_t WS_ZTC = 2283 * MiB;
constexpr size_t WS_H = 2285 * MiB;
constexpr size_t WS_SLAB = 2805 * MiB;
constexpr size_t WS_XB = 2873 * MiB;
constexpr size_t WS_END = 3129 * MiB;
static_assert(WS_XW + (size_t)MT * DM * 4 <= WS_HX && WS_HX + (size_t)MT * DM * 2 <= WS_PX && WS_PX + (size_t)MT * INW * 2 <= WS_MIX && WS_MIX + (size_t)MT * DM * 2 <= WS_ZT2 && WS_H + (size_t)MT * DFF * 2 <= WS_SLAB, "ws map");

constexpr int CW_BAR = 4096;

constexpr int RING_BYTES = 131072, LDSCTL_OFF = RING_BYTES, MISC_OFF = LDSCTL_OFF + 320, LDS_BYTES = 147456;
constexpr int NWAVES = 8;

__device__ __forceinline__ unsigned cvt_pk_bf16(float lo, float hi) { unsigned r; asm volatile("v_cvt_pk_bf16_f32 %0, %1, %2" : "=v"(r) : "v"(lo), "v"(hi)); return r; }
__device__ __forceinline__ unsigned f2bf(float f) { unsigned u = __builtin_bit_cast(unsigned, f); return (u + 0x7fffu + ((u >> 16) & 1u)) >> 16; }
__device__ __forceinline__ unsigned pk2(float lo, float hi) { return f2bf(lo) | (f2bf(hi) << 16); }
__device__ __forceinline__ float bf2f(unsigned short b) { return __builtin_bit_cast(float, ((unsigned)b) << 16); }
__device__ __forceinline__ float wave_sum(float v) {
#pragma unroll
    for (int o = 1; o < 64; o <<= 1) v += __shfl_xor(v, o);
    return v;
}
__device__ __forceinline__ float cos_rev(float x) { return __builtin_amdgcn_cosf(x); }
__device__ __forceinline__ float sin_rev(float x) { return __builtin_amdgcn_sinf(x); }

namespace pg8 {
constexpr int BM = 256, BK = 64, HALF = 128, HTB = HALF * BK * 2, STAGE_BYTES = 8 * HTB, NXCD = 8, WGM = 8;
__host__ __device__ __forceinline__ int lds_byte(int r, int c) { const int st = (r >> 4) * 2 + (c >> 5), rr = r & 15, cc = c & 31, ob = rr * 64 + cc * 2; return st * 1024 + (ob ^ (((ob >> 9) & 1) << 5)); }
__host__ __device__ __forceinline__ void stage_rc(int b, int& R, int& C) { const int st = b / 1024, sb = b % 1024, swz = sb ^ (((sb >> 9) & 1) << 5); R = (st >> 1) * 16 + swz / 64; C = (st & 1) * 32 + (swz % 64) / 2; }
__host__ __device__ __forceinline__ int perm32(int rho) { const int n = rho >> 4, i = rho & 15; return 8 * (i >> 2) + 4 * n + (i & 3); }

struct Unit { int pm, pn, g; };
struct Gemm { int K; unsigned rsA, rsB; size_t hsA, hsB; size_t ksA = 128, ksB = 128; };

template <class Epi, class Sched>
__device__ __forceinline__ void gemm_phase(LAS unsigned char* lds, const Gemm g, const Sched& S, const Epi& E) {
    int tid = threadIdx.x; asm volatile("" : "+v"(tid));
    const int wid = __builtin_amdgcn_readfirstlane(tid >> 6), lane = tid & 63, wr = wid >> 2, wc = wid & 3, fr = lane & 15, fq = lane >> 4;
    const int K = g.K, nt = K / BK;
    unsigned voffA[2], voffB[2];
#pragma unroll
    for (int i = 0; i < 2; ++i) { int R, C; stage_rc(tid * 16 + i * 8192, R, C); const int Rb = Epi::PERM ? ((R & ~31) + perm32(R & 31)) : R;
        voffA[i] = (unsigned)R * g.rsA + (unsigned)C * 2u; voffB[i] = (unsigned)Rb * g.rsB + (unsigned)C * 2u; }
    const size_t kA = g.ksA, kB = g.ksB;
    const size_t hA = g.hsA, hB = g.hsB;
    const unsigned ldsw = (unsigned)wid * 1024u;
    const int aoff = lds_byte(wr * 64 + fr, fq * 8), boff = lds_byte(wc * 32 + fr, fq * 8);
#define PG8_SA(b, h) (((b) * 2 + (h)) * HTB)
#define PG8_SB(b, h) ((4 + (b) * 2 + (h)) * HTB)
#define PG8_STAGE(bufoff, gbase, voff) do { _Pragma("unroll") for (int _i = 0; _i < 2; ++_i) \
        __builtin_amdgcn_global_load_lds((const unsigned*)((const char*)(gbase) + (voff)[_i]), (LAS unsigned*)(lds + (bufoff) + ldsw + _i * 8192), 16, 0, 0); } while (0)
#define PG8_LDA(dst, b, h) do { _Pragma("unroll") for (int m = 0; m < 4; ++m) _Pragma("unroll") for (int k = 0; k < 2; ++k) dst[m][k] = *(const LAS bf16x8*)(lds + PG8_SA(b, h) + aoff + m * 2048 + k * 1024); } while (0)
#define PG8_LDB(dst, b, h) do { _Pragma("unroll") for (int n = 0; n < 2; ++n) _Pragma("unroll") for (int k = 0; k < 2; ++k) dst[n][k] = *(const LAS bf16x8*)(lds + PG8_SB(b, h) + boff + n * 2048 + k * 1024); } while (0)
#define PG8_MMA(ai, bj, At, Bt) do { __builtin_amdgcn_s_setprio(1); _Pragma("unroll") for (int m = 0; m < 4; ++m) _Pragma("unroll") for (int n = 0; n < 2; ++n) _Pragma("unroll") for (int k = 0; k < 2; ++k) \
        acc[ai][bj][m][n] = __builtin_amdgcn_mfma_f32_16x16x32_bf16(Bt[n][k], At[m][k], acc[ai][bj][m][n], 0, 0, 0); __builtin_amdgcn_s_setprio(0); } while (0)
#define PG8_WAIT_V(n) asm volatile("s_waitcnt vmcnt(" #n ")" ::: "memory")
#define PG8_WAIT_L(n) asm volatile("s_waitcnt lgkmcnt(" #n ")" ::: "memory")
#define PG8_BAR __builtin_amdgcn_s_barrier()
#define PG8_SCHED __builtin_amdgcn_sched_barrier(0)
    Unit cur, nxt; int ui = 0;
    if (!S.next(0, cur)) return;
    f32x4 acc[2][2][4][2];
#pragma unroll
    for (int a = 0; a < 2; ++a)
#pragma unroll
        for (int b = 0; b < 2; ++b)
#pragma unroll
            for (int m = 0; m < 4; ++m)
#pragma unroll
                for (int n = 0; n < 2; ++n) acc[a][b][m][n] = (f32x4){0.f, 0.f, 0.f, 0.f};
    bf16x8 At[4][2], B0[2][2], B1[2][2];
    LAS float* rtab = (LAS float*)(lds + STAGE_BYTES + 2048);
    if constexpr (Epi::MIDK) E.pre(cur, wr, fr, rtab);
    const char* cA = S.abase(cur); const char* cB = S.bbase(cur);
    PG8_STAGE(PG8_SB(0, 0), cB, voffB); PG8_STAGE(PG8_SB(0, 1), cB + hB, voffB); PG8_STAGE(PG8_SA(0, 0), cA, voffA); PG8_STAGE(PG8_SA(0, 1), cA + hA, voffA);
    if (wr == 1) PG8_BAR;
    PG8_WAIT_V(2); PG8_BAR;
    PG8_STAGE(PG8_SB(1, 0), cB + kB, voffB); PG8_STAGE(PG8_SA(1, 0), cA + kA, voffA); PG8_STAGE(PG8_SB(1, 1), cB + hB + kB, voffB);
    PG8_WAIT_V(6); PG8_BAR;
    for (;;) {
        const bool has_next = S.next(ui + 1, nxt);
        const char* nA = has_next ? S.abase(nxt) : cA; const char* nB = has_next ? S.bbase(nxt) : cB;
#pragma nounroll
        for (int t = 0; t < nt; t += 2) {
            const bool last = (t == nt - 2);
            const char* a1 = cA + (size_t)(t + 1) * kA;
            const char* a2 = last ? nA : cA + (size_t)(t + 2) * kA; const char* b2 = last ? nB : cB + (size_t)(t + 2) * kB;
            const char* a3 = a2 + kA; const char* b3 = b2 + kB;
            if constexpr (Epi::MIDK) { if (t == (nt >> 1)) {
#pragma unroll
                for (int a = 0; a < 2; ++a)
#pragma unroll
                    for (int m = 0; m < 4; ++m)
#pragma unroll
                        for (int b = 0; b < 2; ++b)
#pragma unroll
                            for (int n = 0; n < 2; ++n) acc[a][b][m][n] *= rtab[a * HALF + wr * 64 + m * 16 + fr]; } }
            PG8_LDB(B0, 0, 0); PG8_LDB(B1, 0, 1); PG8_SCHED; PG8_LDA(At, 0, 0); PG8_STAGE(PG8_SA(1, 1), a1 + hA, voffA);
            PG8_WAIT_V(8); PG8_WAIT_L(0); PG8_BAR; PG8_MMA(0, 0, At, B0); PG8_MMA(0, 1, At, B1); PG8_BAR; PG8_SCHED;
            PG8_LDA(At, 0, 1); PG8_STAGE(PG8_SB(0, 0), b2, voffB); PG8_STAGE(PG8_SB(0, 1), b2 + hB, voffB); PG8_STAGE(PG8_SA(0, 0), a2, voffA);
            PG8_WAIT_V(8); PG8_WAIT_L(0); PG8_BAR; PG8_MMA(1, 0, At, B0); PG8_MMA(1, 1, At, B1); PG8_BAR; PG8_SCHED;
            PG8_LDB(B0, 1, 0); PG8_LDB(B1, 1, 1); PG8_SCHED; PG8_LDA(At, 1, 0); PG8_STAGE(PG8_SA(0, 1), a2 + hA, voffA);
            PG8_WAIT_V(8); PG8_WAIT_L(0); PG8_BAR; PG8_MMA(0, 0, At, B0); PG8_MMA(0, 1, At, B1); PG8_BAR; PG8_SCHED;
            PG8_LDA(At, 1, 1); PG8_STAGE(PG8_SB(1, 0), b3, voffB); PG8_STAGE(PG8_SB(1, 1), b3 + hB, voffB); PG8_STAGE(PG8_SA(1, 0), a3, voffA);
            PG8_WAIT_V(8); PG8_WAIT_L(0); PG8_BAR; PG8_MMA(1, 0, At, B0); PG8_MMA(1, 1, At, B1); PG8_BAR; PG8_SCHED;
        }
        if (wr == 0) PG8_BAR;
        { int efr = fr, efq = fq; asm volatile("" : "+v"(efr), "+v"(efq));
          E(acc, cur, wr, wc, efr, efq); }
        if (!has_next) break;
#pragma unroll
        for (int a = 0; a < 2; ++a)
#pragma unroll
            for (int b = 0; b < 2; ++b)
#pragma unroll
                for (int m = 0; m < 4; ++m)
#pragma unroll
                    for (int n = 0; n < 2; ++n) acc[a][b][m][n] = (f32x4){0.f, 0.f, 0.f, 0.f};
        cur = nxt; cA = nA; cB = nB; ++ui;
        if constexpr (Epi::MIDK) E.pre(cur, wr, fr, rtab);
        if (wr == 1) PG8_BAR;
    }
    PG8_WAIT_V(0);
    PG8_BAR;
#undef PG8_SA
#undef PG8_SB
#undef PG8_STAGE
#undef PG8_LDA
#undef PG8_LDB
#undef PG8_MMA
#undef PG8_WAIT_V
#undef PG8_WAIT_L
#undef PG8_BAR
#undef PG8_SCHED
}

struct SchedStd {
    int nM, nN, nwg, G, c, wgm; const char* A; const char* B; size_t tsA, tsB;
    __device__ __forceinline__ void init(int nM_, int nN_, int G_, int c_, const void* A_, size_t tsA_, const void* B_, size_t tsB_, int wgm_ = WGM) { wgm = wgm_; nM = nM_; nN = nN_; nwg = nM * nN; G = G_; c = c_; A = (const char*)A_; B = (const char*)B_; tsA = tsA_; tsB = tsB_; }
    __device__ __forceinline__ bool next(int i, Unit& u) const {
        const long L = (long)i * G + c; if (L >= nwg) return false;
        int wgid = (int)L; { const int q = nwg / NXCD, r = nwg % NXCD, xcd = wgid % NXCD, off = wgid / NXCD; wgid = (xcd < r ? xcd * (q + 1) : r * (q + 1) + (xcd - r) * q) + off; }
        const int nig = wgm * nN, gid = wgid / nig, fm = gid * wgm, gsz = (nM - fm) < wgm ? (nM - fm) : wgm;
        u.pm = fm + ((wgid % nig) % gsz); u.pn = (wgid % nig) / gsz; u.g = 0; return true;
    }
    __device__ __forceinline__ const char* abase(const Unit& u) const { return A + (size_t)u.pm * tsA; }
    __device__ __forceinline__ const char* bbase(const Unit& u) const { return B + (size_t)u.pn * tsB; }
};
struct SchedGa {
    int G, c; const char* WfT; const char* PXf;
    __device__ __forceinline__ bool next(int i, Unit& u) const { const int L = i * G + c; if (L >= 1024) return false; u.pn = L >> 4; u.g = (L >> 2) & 3; u.pm = L & 3; return true; }
    __device__ __forceinline__ const char* abase(const Unit& u) const { return WfT + (size_t)u.g * (512 * 1024 * 2) + ((size_t)(u.pm & 1) * 256 * 1024 + (size_t)(u.pm >> 1) * 512) * 2; }
    __device__ __forceinline__ const char* bbase(const Unit& u) const { return PXf + ((size_t)(2 * u.pn) * INW + 512 * u.g) * 2; }
};
struct SchedGaCtx {
    int G, c; const char* WfT; const char* PXf;
    __device__ __forceinline__ bool next(int i, Unit& u) const { const int L = i * G + c; if (L >= 16) return false; u.pn = 0; u.g = L >> 2; u.pm = L & 3; return true; }
    __device__ __forceinline__ const char* abase(const Unit& u) const { return WfT + (size_t)u.g * (512 * 1024 * 2) + ((size_t)(u.pm & 1) * 256 * 1024 + (size_t)(u.pm >> 1) * 512) * 2; }
    __device__ __forceinline__ const char* bbase(const Unit& u) const { return PXf + ((size_t)SEQ * INW + 512 * u.g) * 2; }
};
struct SchedN {
    int G, c, ntile; const char* A; const char* B; size_t tsB;
    __device__ __forceinline__ bool next(int i, Unit& u) const { const int L = i * G + c; if (L >= ntile) return false; u.pn = L; u.pm = 0; u.g = 0; return true; }
    __device__ __forceinline__ const char* abase(const Unit&) const { return A; }
    __device__ __forceinline__ const char* bbase(const Unit& u) const { return B + (size_t)u.pn * tsB; }
};
struct SchedWf {
    int G, c; const char* WfRaw; const char* CS;
    __device__ __forceinline__ bool next(int i, Unit& u) const { const int L = i * G + c; if (L >= 128) return false; u.g = L >> 3; u.pm = (L >> 2) & 1; u.pn = L & 3; return true; }
    __device__ __forceinline__ const char* abase(const Unit& u) const { return WfRaw + (size_t)u.g * (512 * 512 * 2) + (size_t)u.pm * 256 * 1024; }
    __device__ __forceinline__ const char* bbase(const Unit& u) const { return CS + (size_t)u.pn * 256 * 1024; }
};

#define ACC_T const f32x4 (&acc)[2][2][4][2]
__device__ __forceinline__ u32x4 pack8(const f32x4 a, const f32x4 b) { u32x4 w; w.x = cvt_pk_bf16(a[0], a[1]); w.y = cvt_pk_bf16(a[2], a[3]); w.z = cvt_pk_bf16(b[0], b[1]); w.w = cvt_pk_bf16(b[2], b[3]); return w; }
__device__ __forceinline__ u32x2 pack4(const f32x4 a) { u32x2 w; w.x = cvt_pk_bf16(a[0], a[1]); w.y = cvt_pk_bf16(a[2], a[3]); return w; }

struct EpiInproj {
    static constexpr bool PERM = true, MIDK = false;
    bf16_t* PX; const float* COS; const float* SIN; const float* SSr; const float* bias;
    __device__ __forceinline__ void operator()(ACC_T, const Unit& u, int wr, int wc, int fr, int fq) const {
        const int row0 = u.pm * BM + wr * 64 + fr;
        f32x4 bv[2][2];
#pragma unroll
        for (int bj = 0; bj < 2; ++bj)
#pragma unroll
            for (int n = 0; n < 2; ++n) bv[bj][n] = *(const f32x4*)(bias + u.pn * BM + bj * HALF + wc * 32 + 8 * fq + 4 * n);
        if (u.pn < 10) {
            const int a = wc >> 1, b = wc & 1, jj = 16 * b + 4 * fq, dcol = 64 * a + jj;
            const bool rot = u.pm < 64;
#pragma unroll
            for (int ai = 0; ai < 2; ++ai)
#pragma unroll
                for (int m = 0; m < 4; ++m) {
                    const int row = row0 + ai * HALF + m * 16; const int pos = a ? (row & 63) : ((row >> 6) & 255);
                    const float rstd = 1.0f / sqrtf(SSr[row] * (1.0f / DM) + EPS);
                    f32x4 cs = (f32x4){1.f, 1.f, 1.f, 1.f}, sn = (f32x4){0.f, 0.f, 0.f, 0.f};
                    if (rot) { cs = *(const f32x4*)(COS + pos * 32 + jj); sn = *(const f32x4*)(SIN + pos * 32 + jj); }
                    bf16_t* rowp = PX + (size_t)row * INW + u.pn * BM + dcol;
#pragma unroll
                    for (int bj = 0; bj < 2; ++bj) { const f32x4 x1 = acc[ai][bj][m][0] * rstd + bv[bj][0], x2 = acc[ai][bj][m][1] * rstd + bv[bj][1];
                        const f32x4 o1 = x1 * cs - x2 * sn, o2 = x2 * cs + x1 * sn;
                        *(u32x2*)(rowp + bj * HALF) = pack4(o1); *(u32x2*)(rowp + bj * HALF + 32) = pack4(o2); }
                }
        } else {
            const int col0 = u.pn * BM + wc * 32 + 8 * fq;
#pragma unroll
            for (int ai = 0; ai < 2; ++ai)
#pragma unroll
                for (int m = 0; m < 4; ++m) { const int row = row0 + ai * HALF + m * 16; bf16_t* rowp = PX + (size_t)row * INW + col0;
                    const float rstd = 1.0f / sqrtf(SSr[row] * (1.0f / DM) + EPS);
#pragma unroll
                    for (int bj = 0; bj < 2; ++bj) *(u32x4*)(rowp + bj * HALF) = pack8(acc[ai][bj][m][0] * rstd + bv[bj][0], acc[ai][bj][m][1] * rstd + bv[bj][1]); }
        }
    }
};
template <bool MIXN> struct EpiResid {
    static constexpr bool PERM = true, MIDK = MIXN;
    const float* base; float* XW; const float* gate; const float* gam; bf16_t* HXo; float* SSo;
    const float* SSa; const float* SSf;
    __device__ __forceinline__ void pre(const Unit& u, int wr, int fr, LAS float* rtab) const {
        const int rl0 = wr * 64 + fr;
#pragma unroll
        for (int ai = 0; ai < 2; ++ai)
#pragma unroll
            for (int m = 0; m < 4; ++m) { const int rl = rl0 + ai * HALF + m * 16, row = u.pm * BM + rl;
                rtab[rl] = sqrtf((SSf[row] * (1.0f / FW) + EPS) / (SSa[row] * (1.0f / QW) + EPS)); }
    }
    __device__ __forceinline__ void operator()(ACC_T, const Unit& u, int wr, int wc, int fr, int fq) const {
        const int row0 = u.pm * BM + wr * 64 + fr, col0 = u.pn * BM + wc * 32 + 8 * fq;
        const bool nxt = (gam != nullptr);
        f32x4 gv[2][2];
#pragma unroll
        for (int bj = 0; bj < 2; ++bj)
#pragma unroll
            for (int n = 0; n < 2; ++n) gv[bj][n] = *(const f32x4*)(gate + col0 + bj * HALF + 4 * n);
#pragma unroll
        for (int ai = 0; ai < 2; ++ai)
#pragma unroll
        for (int mp = 0; mp < 2; ++mp) {
            f32x4 bs[2][2][2]; float rf[2];
#pragma unroll
            for (int mm = 0; mm < 2; ++mm) { const int row = row0 + ai * HALF + (2 * mp + mm) * 16; const size_t off = (size_t)row * DM + col0;
                rf[mm] = MIXN ? SSf[row] : 0.f;
#pragma unroll
                for (int bj = 0; bj < 2; ++bj)
#pragma unroll
                    for (int n = 0; n < 2; ++n) bs[mm][bj][n] = *(const f32x4*)(base + off + bj * HALF + 4 * n); }
            asm volatile("" ::: "memory");
#pragma unroll
            for (int mm = 0; mm < 2; ++mm) { const int m = 2 * mp + mm; const int row = row0 + ai * HALF + m * 16; const size_t off = (size_t)row * DM + col0; float s = 0.f;
                const float rs = MIXN ? 1.0f / sqrtf(rf[mm] * (1.0f / FW) + EPS) : 1.0f;
#pragma unroll
                for (int bj = 0; bj < 2; ++bj) { const f32x4 x0 = bs[mm][bj][0] + gv[bj][0] * (acc[ai][bj][m][0] * rs), x1 = bs[mm][bj][1] + gv[bj][1] * (acc[ai][bj][m][1] * rs);
                    *(f32x4*)(XW + off + bj * HALF) = x0; *(f32x4*)(XW + off + bj * HALF + 4) = x1;
                    if (nxt) { s += ((x0[0] * x0[0] + x0[1] * x0[1]) + (x0[2] * x0[2] + x0[3] * x0[3])) + ((x1[0] * x1[0] + x1[1] * x1[1]) + (x1[2] * x1[2] + x1[3] * x1[3]));
                               const f32x4 g0 = *(const f32x4*)(gam + col0 + bj * HALF), g1 = *(const f32x4*)(gam + col0 + bj * HALF + 4);
                               *(u32x4*)(HXo + off + bj * HALF) = pack8(x0 * g0, x1 * g1); } }
                if (nxt) { s += __shfl_xor(s, 16); s += __shfl_xor(s, 32); if (fq == 0) atomicAdd(SSo + row, s); } }
            asm volatile("" ::: "memory");
        }
    }
};
struct EpiRelu2 {
    static constexpr bool PERM = true, MIDK = false;
    bf16_t* H; const float* SSr; const float* bias;
    __device__ __forceinline__ void operator()(ACC_T, const Unit& u, int wr, int wc, int fr, int fq) const {
        const int row0 = u.pm * BM + wr * 64 + fr, col0 = u.pn * BM + wc * 32 + 8 * fq;
        f32x4 bv[2][2];
#pragma unroll
        for (int bj = 0; bj < 2; ++bj)
#pragma unroll
            for (int n = 0; n < 2; ++n) bv[bj][n] = *(const f32x4*)(bias + col0 + bj * HALF + 4 * n);
#pragma unroll
        for (int ai = 0; ai < 2; ++ai)
#pragma unroll
            for (int m = 0; m < 4; ++m) { const int row = row0 + ai * HALF + m * 16;
                bf16_t* rowp = H + ((size_t)(u.pm * 256 + 4 * u.pn + (wc >> 1)) * 256 + (row & 255)) * 64 + 32 * (wc & 1) + 8 * fq;
                const float rstd = 1.0f / sqrtf(SSr[row] * (1.0f / DM) + EPS);
#pragma unroll
                for (int bj = 0; bj < 2; ++bj) { f32x4 v0 = acc[ai][bj][m][0] * rstd + bv[bj][0], v1 = acc[ai][bj][m][1] * rstd + bv[bj][1];
#pragma unroll
                    for (int e = 0; e < 4; ++e) { const float a0 = fmaxf(v0[e], 0.f), a1 = fmaxf(v1[e], 0.f); v0[e] = a0 * a0; v1[e] = a1 * a1; }
                    *(u32x4*)(rowp + (size_t)bj * 2 * 256 * 64) = pack8(v0, v1); } }
    }
};
struct EpiWf {
    static constexpr bool PERM = true, MIDK = false;
    bf16_t* WfT;
    __device__ __forceinline__ void operator()(ACC_T, const Unit& u, int wr, int wc, int fr, int fq) const {
        const int row0 = u.pm * BM + wr * 64 + fr, col0 = u.pn * BM + wc * 32 + 8 * fq;
        bf16_t* base = WfT + (size_t)u.g * (512 * 1024);
#pragma unroll
        for (int ai = 0; ai < 2; ++ai)
#pragma unroll
            for (int m = 0; m < 4; ++m) { bf16_t* rowp = base + (size_t)(row0 + ai * HALF + m * 16) * 1024 + col0;
#pragma unroll
                for (int bj = 0; bj < 2; ++bj) *(u32x4*)(rowp + bj * HALF) = pack8(acc[ai][bj][m][0], acc[ai][bj][m][1]); }
    }
};
struct EpiGa {
    static constexpr bool PERM = true, MIDK = false;
    bf16_t* ZT2;
    __device__ __forceinline__ void operator()(ACC_T, const Unit& u, int wr, int wc, int fr, int fq) const {
        const int reim = u.pm >> 1, d0 = (u.pm & 1) * 256 + wr * 64 + fr, l1 = wc * 32 + 8 * fq;
#pragma unroll
        for (int ai = 0; ai < 2; ++ai)
#pragma unroll
            for (int m = 0; m < 4; ++m) { const int j = u.g * 512 + d0 + ai * HALF + m * 16;
#pragma unroll
                for (int bj = 0; bj < 2; ++bj) { const int l2 = 2 * u.pn + bj;
                    *(u32x4*)(ZT2 + ((size_t)(j * 128 + l2) * 256 + reim * 128 + l1)) = pack8(acc[ai][bj][m][0], acc[ai][bj][m][1]); } }
    }
};
struct EpiGaCtx {
    static constexpr bool PERM = true, MIDK = false;
    bf16_t* ZTc;
    __device__ __forceinline__ void operator()(ACC_T, const Unit& u, int wr, int wc, int fr, int fq) const {
        const int reim = u.pm >> 1, d0 = (u.pm & 1) * 256 + wr * 64 + fr, l0 = wc * 32 + 8 * fq;
#pragma unroll
        for (int ai = 0; ai < 2; ++ai)
#pragma unroll
            for (int m = 0; m < 4; ++m) { const int j = u.g * 512 + d0 + ai * HALF + m * 16;
#pragma unroll
                for (int bj = 0; bj < 2; ++bj)
                    *(u32x4*)(ZTc + ((size_t)j * 512 + reim * 256 + bj * HALF + l0)) = pack8(acc[ai][bj][m][0], acc[ai][bj][m][1]); }
    }
};
struct EpiGb {
    static constexpr bool PERM = true, MIDK = false;
    bf16_t* Y2; const f32x2* TW;
    __device__ __forceinline__ void operator()(ACC_T, const Unit& u, int wr, int wc, int fr, int fq) const {
        const int l2b = wc * 32 + 8 * fq;
#pragma unroll
        for (int m = 0; m < 4; ++m) { const int k1 = wr * 64 + m * 16 + fr;
            f32x2 t[8];
#pragma unroll
            for (int e = 0; e < 8; ++e) t[e] = TW[(unsigned)(k1 * (l2b + e))];
#pragma unroll
            for (int bj = 0; bj < 2; ++bj) { const int j = 2 * u.pn + bj;
                f32x4 r0, r1, i0, i1;
#pragma unroll
                for (int e = 0; e < 4; ++e) {
                    const float yr0 = acc[0][bj][m][0][e], yi0 = acc[1][bj][m][0][e], yr1 = acc[0][bj][m][1][e], yi1 = acc[1][bj][m][1][e];
                    r0[e] = yr0 * t[e].x + yi0 * t[e].y; i0[e] = yi0 * t[e].x - yr0 * t[e].y;
                    r1[e] = yr1 * t[4 + e].x + yi1 * t[4 + e].y; i1[e] = yi1 * t[4 + e].x - yr1 * t[4 + e].y; }
                bf16_t* p = Y2 + ((size_t)(k1 * 2048 + j) * 256 + l2b);
                *(u32x4*)p = pack8(r0, r1); *(u32x4*)(p + 128) = pack8(i0, i1); }
            asm volatile("" ::: "memory"); }
    }
};
struct EpiGc {
    static constexpr bool PERM = true, MIDK = false;
    bf16_t* MIX; float* SSf;
    __device__ __forceinline__ void operator()(ACC_T, const Unit& u, int wr, int wc, int fr, int fq) const {
        const int k1 = u.pn >> 3, j0 = (u.pn & 7) * 256 + wc * 32 + 8 * fq;
#pragma unroll
        for (int m = 0; m < 4; ++m) { const int k2 = wr * 64 + m * 16 + fr; const int pos = k1 + 128 * k2; float s = 0.f;
#pragma unroll
            for (int bj = 0; bj < 2; ++bj) { const f32x4 v0 = acc[0][bj][m][0], v1 = acc[0][bj][m][1];
                s += ((v0[0] * v0[0] + v0[1] * v0[1]) + (v0[2] * v0[2] + v0[3] * v0[3])) + ((v1[0] * v1[0] + v1[1] * v1[1]) + (v1[2] * v1[2] + v1[3] * v1[3]));
                *(u32x4*)(MIX + (size_t)pos * DM + QW + j0 + bj * HALF) = pack8(v0, v1); }
            s += __shfl_xor(s, 16); s += __shfl_xor(s, 32); if (fq == 0) atomicAdd(SSf + pos, s); }
    }
};
struct EpiGctx {
    static constexpr bool PERM = true, MIDK = false;
    bf16_t* MIX; float* SSf;
    __device__ __forceinline__ void operator()(ACC_T, const Unit& u, int wr, int wc, int fr, int fq) const {
        const int j0 = u.pn * 256 + wc * 32 + 8 * fq;
#pragma unroll
        for (int ai = 0; ai < 2; ++ai)
#pragma unroll
            for (int m = 0; m < 4; ++m) { const int k = ai * HALF + wr * 64 + m * 16 + fr; float s = 0.f;
#pragma unroll
                for (int bj = 0; bj < 2; ++bj) { const f32x4 v0 = acc[ai][bj][m][0], v1 = acc[ai][bj][m][1];
                    s += ((v0[0] * v0[0] + v0[1] * v0[1]) + (v0[2] * v0[2] + v0[3] * v0[3])) + ((v1[0] * v1[0] + v1[1] * v1[1]) + (v1[2] * v1[2] + v1[3] * v1[3]));
                    *(u32x4*)(MIX + (size_t)(SEQ + k) * DM + QW + j0 + bj * HALF) = pack8(v0, v1); }
                s += __shfl_xor(s, 16); s += __shfl_xor(s, 32); if (fq == 0) atomicAdd(SSf + SEQ + k, s); }
    }
};

struct SchedPiece {
    int G, c, npiece, nks, pn0; const char* A; const char* B; size_t tsB, kbytes; size_t kbytesA = 0;
    __device__ __forceinline__ bool next(int i, Unit& u) const { const int L = i * G + c; if (L >= npiece) return false; u.pn = pn0 + L / nks; u.g = L % nks; u.pm = 0; return true; }
    __device__ __forceinline__ const char* abase(const Unit& u) const { return A + (size_t)u.g * (kbytesA ? kbytesA : kbytes); }
    __device__ __forceinline__ const char* bbase(const Unit& u) const { return B + (size_t)u.pn * tsB + (size_t)u.g * kbytes; }
};
struct EpiSlab {
    static constexpr bool PERM = false, MIDK = false;
    float* SLAB; int ldn;
    __device__ __forceinline__ void operator()(ACC_T, const Unit& u, int wr, int wc, int fr, int fq) const {
        const int row0 = wr * 64 + fr, col0 = u.pn * BM + wc * 32 + 4 * fq;
        float* base = SLAB + (size_t)u.g * 256 * ldn;
#pragma unroll
        for (int ai = 0; ai < 2; ++ai)
#pragma unroll
            for (int m = 0; m < 4; ++m) { float* rowp = base + (size_t)(row0 + ai * HALF + m * 16) * ldn + col0;
#pragma unroll
                for (int bj = 0; bj < 2; ++bj)
#pragma unroll
                    for (int n = 0; n < 2; ++n) *(f32x4*)(rowp + bj * HALF + n * 16) = acc[ai][bj][m][n]; }
    }
};
#undef ACC_T
}

namespace att {
constexpr float SCALE = 0.08838834764831845f;
constexpr float THR = 8.f;
constexpr int SHM_K = 16384, SHM_V = 16384, OFF_V = 0, OFF_K = 2 * SHM_V, OFF_WS = 2 * SHM_V + 2 * SHM_K;
#define KSWZ(row, colB) ((row) * 256 + ((colB) ^ (((row) & 7) << 4)))
#define SBAR() __builtin_amdgcn_sched_barrier(0)
__device__ __forceinline__ int v_st(int k, int c) { const int kk = (k & ~0xC) | ((k & 4) << 1) | ((k & 8) >> 1); return ((kk >> 3) * 4 + (c >> 5)) * 512 + ((kk & 7) * 32 + (c & 31)) * 2; }
__device__ __forceinline__ int v_rd_base(int lane) { return ((lane & 3) << 3) | (((lane >> 2) & 3) << 6) | (((lane >> 4) & 1) << 5) | (((lane >> 5) & 1) << 8); }
constexpr int v_rd_off(int d0, int ks, int half) { return d0 * 512 + ks * 4096 + half * 2048; }
__device__ __forceinline__ int crow(int r, int hi) { return (r & 3) + 8 * (r >> 2) + 4 * hi; }
__device__ __forceinline__ unsigned cvtpk(float lo, float hi) { unsigned r; asm volatile("v_cvt_pk_bf16_f32 %0, %1, %2" : "=v"(r) : "v"(lo), "v"(hi)); return r; }
__device__ __forceinline__ void mask_tile(f32x16& p0, f32x16& p1, int dq, unsigned W) {
    const float NEG = -__builtin_inff();
#pragma unroll
    for (int r = 0; r < 16; ++r) {
        const int c = (r & 3) + 8 * (r >> 2);
        if ((unsigned)(dq - c) >= W) p0[r] = NEG;
        if ((unsigned)(dq - c - 32) >= W) p1[r] = NEG;
    }
}
__device__ __forceinline__ void partialSM(f32x16& p0, f32x16& p1, float& m_reg, float& mn, float& alpha) {
    float pmax = p0[0];
#pragma unroll
    for (int r = 1; r < 16; ++r) pmax = fmaxf(pmax, p0[r]);
#pragma unroll
    for (int r = 0; r < 16; ++r) pmax = fmaxf(pmax, p1[r]);
    { auto rr = __builtin_amdgcn_permlane32_swap(__float_as_uint(pmax), __float_as_uint(pmax), false, false);
      pmax = fmaxf(__uint_as_float(rr[0]), __uint_as_float(rr[1])); }
    constexpr float C2 = 1.4426950408889634f * SCALE;
    if (__all((pmax - m_reg) * SCALE <= THR)) { mn = m_reg; alpha = 1.f; }
    else { mn = fmaxf(m_reg, pmax); alpha = __builtin_amdgcn_exp2f((m_reg - mn) * C2); m_reg = mn; }
    const float mnL = -mn * C2;
#pragma unroll
    for (int r = 0; r < 16; ++r) p0[r] = fmaf(p0[r], C2, mnL);
#pragma unroll
    for (int r = 0; r < 16; ++r) p1[r] = fmaf(p1[r], C2, mnL);
#pragma unroll
    for (int r = 0; r < 16; ++r) p0[r] = __builtin_amdgcn_exp2f(p0[r]);
}
__device__ __forceinline__ void finishSM(f32x16& p0, f32x16& p1, float alpha, float& l_reg, bf16x8& pa0, bf16x8& pa1, bf16x8& pa2, bf16x8& pa3) {
#pragma unroll
    for (int r = 0; r < 16; ++r) p1[r] = __builtin_amdgcn_exp2f(p1[r]);
    float ps = 0;
#pragma unroll
    for (int r = 0; r < 16; ++r) ps += p0[r];
#pragma unroll
    for (int r = 0; r < 16; ++r) ps += p1[r];
    { auto rr = __builtin_amdgcn_permlane32_swap(__float_as_uint(ps), __float_as_uint(ps), false, false);
      ps = __uint_as_float(rr[0]) + __uint_as_float(rr[1]); }
    l_reg = l_reg * alpha + ps;
#define PK4(P, B_, OUT) do { unsigned a0 = cvtpk(P[B_+0], P[B_+1]), a1 = cvtpk(P[B_+2], P[B_+3]);                          \
        unsigned b0 = cvtpk(P[B_+4], P[B_+5]), b1 = cvtpk(P[B_+6], P[B_+7]);                                             \
        auto r0 = __builtin_amdgcn_permlane32_swap(a0, b0, false, false); auto r1 = __builtin_amdgcn_permlane32_swap(a1, b1, false, false); \
        u32x4 w = {r0[0], r1[0], r0[1], r1[1]}; OUT = __builtin_bit_cast(bf16x8, w); } while (0)
    PK4(p0, 0, pa0); PK4(p0, 8, pa1); PK4(p1, 0, pa2); PK4(p1, 8, pa3);
#undef PK4
}
template <int KB>
__device__ __forceinline__ void qkt(f32x16& p0, f32x16& p1, const LAS char* K_lds, int r32, int hi, const bf16x8* qr) {
    p0 = f32x16{}; p1 = f32x16{};
    const LAS char* kb[4];
#pragma unroll
    for (int dd = 0; dd < 4; ++dd) kb[dd] = K_lds + KB * SHM_K + KSWZ(r32, (dd * 16 + hi * 8) * 2);
#pragma unroll
    for (int d0 = 0; d0 < 8; ++d0) { const LAS char* a = kb[d0 & 3] + (d0 >> 2) * 128;
        bf16x8 b0 = *(const LAS bf16x8*)(a);
        bf16x8 b1 = *(const LAS bf16x8*)(a + 32 * 256);
        p0 = __builtin_amdgcn_mfma_f32_32x32x16_bf16(b0, qr[d0], p0, 0, 0, 0);
        p1 = __builtin_amdgcn_mfma_f32_32x32x16_bf16(b1, qr[d0], p1, 0, 0, 0); }
}
template <int VB>
__device__ __forceinline__ void pv_tile(f32x16* o, int vb0, bf16x8 pa0, bf16x8 pa1, bf16x8 pa2, bf16x8 pa3) {
#define TRRD(dst, off) asm volatile("ds_read_b64_tr_b16 %0, %1 offset:%2" : "=&v"(dst) : "v"(vb0), "i"(off) : "memory")
#define PV_D0(d0) do { s16x4 l0, l1, l2, l3, h0, h1, h2, h3; constexpr int b_ = VB * SHM_V + v_rd_off(d0, 0, 0); \
        TRRD(l0, b_); TRRD(h0, b_ + 2048); TRRD(l1, b_ + 4096); TRRD(h1, b_ + 6144); TRRD(l2, b_ + 8192); TRRD(h2, b_ + 10240); TRRD(l3, b_ + 12288); TRRD(h3, b_ + 14336); \
        asm volatile("s_waitcnt lgkmcnt(0)" ::: "memory"); SBAR();   \
        o[d0] = __builtin_amdgcn_mfma_f32_32x32x16_bf16(pa0, (bf16x8){l0[0], l0[1], l0[2], l0[3], h0[0], h0[1], h0[2], h0[3]}, o[d0], 0, 0, 0);   \
        o[d0] = __builtin_amdgcn_mfma_f32_32x32x16_bf16(pa1, (bf16x8){l1[0], l1[1], l1[2], l1[3], h1[0], h1[1], h1[2], h1[3]}, o[d0], 0, 0, 0);   \
        o[d0] = __builtin_amdgcn_mfma_f32_32x32x16_bf16(pa2, (bf16x8){l2[0], l2[1], l2[2], l2[3], h2[0], h2[1], h2[2], h2[3]}, o[d0], 0, 0, 0);   \
        o[d0] = __builtin_amdgcn_mfma_f32_32x32x16_bf16(pa3, (bf16x8){l3[0], l3[1], l3[2], l3[3], h3[0], h3[1], h3[2], h3[3]}, o[d0], 0, 0, 0); } while (0)
    PV_D0(0); PV_D0(1); PV_D0(2); PV_D0(3);
#undef PV_D0
#undef TRRD
}

__device__ __forceinline__ void attn_item(LAS char* lds, const bf16_t* PX, bf16_t* MIX, float* SSa, const float* sink, int qrow0, int kvh, int hp, int nt, int wstart) {
    int tid = threadIdx.x; asm volatile("" : "+v"(tid));
    const int wid = __builtin_amdgcn_readfirstlane(tid >> 6), lane = tid & 63, r32 = lane & 31, hi = lane >> 5;
    const int hq = 4 * kvh + 2 * hp + (wid >> 2);
    const int qw0 = qrow0 + 32 * (wid & 3), qrow = qw0 + r32;
    LAS char* V_lds = lds + OFF_V; LAS char* K_lds = lds + OFF_K;
    LAS float* ws = (LAS float*)(lds + OFF_WS) + wid * 64; LAS float* li_l = ws; LAS float* al_l = ws + 32;
    bf16x8 qr[8];
    { const bf16_t* qp = PX + (size_t)qrow * INW + hq * HD + hi * 8;
#pragma unroll
      for (int d0 = 0; d0 < 8; ++d0) qr[d0] = *(const bf16x8*)(qp + d0 * 16); }
    const int sr = tid >> 4, sc = (tid & 15) * 8, vst0 = v_st(sr, sc), vst1 = v_st(32 + sr, sc), kws = KSWZ(sr, sc * 2);
    const int vb0 = (int)(unsigned)(size_t)V_lds + v_rd_base(lane);
    const bf16_t* Kg = PX + K_LO + kvh * HD + sc; const bf16_t* Vg = PX + V_LO + kvh * HD + sc;
    float m_reg = sink[hq] * (1.0f / SCALE), l_reg = 1.f; f32x16 o[4] = {};
    bf16x8 st_k0, st_k1, st_v0, st_v1;
#define TROW(t_) ((t_) < 4 ? SEQ + 64 * (t_) : wstart + 64 * ((t_) - 4))
#define LOADT(t_) do { const size_t rb_ = (size_t)(TROW(t_) + sr); st_k0 = *(const bf16x8*)(Kg + rb_ * INW); st_k1 = *(const bf16x8*)(Kg + (rb_ + 32) * INW); \
                       st_v0 = *(const bf16x8*)(Vg + rb_ * INW); st_v1 = *(const bf16x8*)(Vg + (rb_ + 32) * INW); } while (0)
#define WRITET(b_) do { *(LAS bf16x8*)(K_lds + (b_) * SHM_K + kws) = st_k0; *(LAS bf16x8*)(K_lds + (b_) * SHM_K + kws + 32 * 256) = st_k1; \
                        *(LAS bf16x8*)(V_lds + (b_) * SHM_V + vst0) = st_v0; *(LAS bf16x8*)(V_lds + (b_) * SHM_V + vst1) = st_v1; } while (0)
#define RESC(a) do { if (__any((a) < 1.f)) { if (hi == 0) al_l[r32] = (a); asm volatile("s_waitcnt lgkmcnt(0)" ::: "memory"); \
        _Pragma("unroll") for (int d_ = 0; d_ < 4; ++d_) _Pragma("unroll") for (int r = 0; r < 16; ++r) o[d_][r] *= al_l[crow(r, hi)]; } } while (0)
#define STEP(B_, t_) do { const int tt_ = (t_); \
        if (tt_ + 1 < nt) LOADT(tt_ + 1); \
        const int kb_ = TROW(tt_); \
        const bool act_ = tt_ < 4 || (kb_ <= qw0 + 31 + 128 && kb_ + 63 >= qw0 - 128);              \
        if (act_) { f32x16 p0, p1; float mn, alpha; bf16x8 pa0, pa1, pa2, pa3; \
            SBAR(); qkt<B_>(p0, p1, K_lds, r32, hi, qr); \
            if (tt_ >= 4 && (kb_ + 63 - qw0 > 128 || qw0 + 31 - kb_ > 128)) mask_tile(p0, p1, qrow + 128 - kb_ - 4 * hi, 257u); \
            partialSM(p0, p1, m_reg, mn, alpha); RESC(alpha); \
            finishSM(p0, p1, alpha, l_reg, pa0, pa1, pa2, pa3); SBAR(); \
            pv_tile<B_>(o, vb0, pa0, pa1, pa2, pa3); } \
        if (tt_ + 1 < nt) WRITET((B_) ^ 1); \
        __syncthreads(); } while (0)
    LOADT(0); WRITET(0); __syncthreads();
    for (int t = 0; t < nt; t += 2) { STEP(0, t); STEP(1, t + 1); }
    if (hi == 0) li_l[r32] = l_reg;
    asm volatile("s_waitcnt lgkmcnt(0)" ::: "memory");
    float rli[16];
#pragma unroll
    for (int r = 0; r < 16; ++r) rli[r] = 1.0f / li_l[crow(r, hi)];
    bf16_t* Ow = MIX + (size_t)qw0 * DM + hq * HD;
#pragma unroll
    for (int r = 0; r < 16; ++r) { const int orow = crow(r, hi); float s = 0.f;
#pragma unroll
        for (int d0 = 0; d0 < 4; ++d0) { const float v = o[d0][r] * rli[r]; const float vn = __shfl_xor(v, 1); s += v * v;
            if ((r32 & 1) == 0) *(unsigned*)(Ow + (size_t)orow * DM + d0 * 32 + r32) = cvtpk(v, vn); }
        s += __shfl_xor(s, 1); s += __shfl_xor(s, 2); s += __shfl_xor(s, 4); s += __shfl_xor(s, 8); s += __shfl_xor(s, 16);
        if (r32 == r) atomicAdd(SSa + qw0 + orow, s); }
    __syncthreads();
#undef TROW
#undef LOADT
#undef WRITET
#undef RESC
#undef STEP
}
}

#define XB_TMO      128
#define XB_XCNT(j)  (256  + 64 * (j))
#define XB_XSUB(j)  (1280 + 64 * (j))
#define XB_XGEN(j)  (2304 + 64 * (j))
#define XB_TOP      3328
#define XB_TOPGEN   3392
#define XCD_BAR_WORDS 3456
#define XB_SPIN_CAP (1u << 22)
__device__ __forceinline__ unsigned xb_ld(unsigned* p)              { return __hip_atomic_load(p, __ATOMIC_RELAXED, __HIP_MEMORY_SCOPE_AGENT); }
__device__ __forceinline__ unsigned xb_add(unsigned* p, unsigned v) { return __hip_atomic_fetch_add(p, v, __ATOMIC_RELAXED, __HIP_MEMORY_SCOPE_AGENT); }
__device__ __forceinline__ unsigned xb_xcc_id() { return (unsigned)__builtin_amdgcn_s_getreg((3 << 11) | 20) & 0xFu; }
#define XB_SPIN(cond, bar) do { unsigned _sp = 0; while (cond) { __builtin_amdgcn_s_sleep(1); \
    if ((++_sp & 255u) == 0u) { if (xb_ld(&(bar)[XB_TMO])) break; if (_sp > XB_SPIN_CAP) { atomicAdd(&(bar)[XB_TMO], 1u); break; } } } } while (0)
struct XcdBarrier { unsigned* bar; unsigned x; volatile LAS unsigned* st; };
__device__ __forceinline__ XcdBarrier xcd_barrier_post(unsigned* bar, volatile LAS unsigned* st) {
    XcdBarrier b; b.bar = bar; b.x = xb_xcc_id(); b.st = st;
    if (threadIdx.x == 0) (void)xb_add(&bar[XB_XCNT(b.x)], 1u);
    return b;
}
__device__ __forceinline__ void xcd_barrier_complete(unsigned* bar, unsigned x, unsigned& nloc, unsigned& nx) {
    const unsigned G = gridDim.x * gridDim.y * gridDim.z;
    unsigned sum, cnt, mine, sp = 0u;
    for (;;) {
        sum = 0u; cnt = 0u; mine = 0u;
#pragma unroll
        for (unsigned j = 0; j < 16; ++j) { const unsigned c = xb_ld(&bar[XB_XCNT(j)]); sum += c; cnt += (c > 0u) ? 1u : 0u; mine = (j == x) ? c : mine; }
        if (sum == G) break;
        __builtin_amdgcn_s_sleep(1);
        if ((++sp & 255u) == 0u) { if (xb_ld(&bar[XB_TMO])) break; if (sp > XB_SPIN_CAP) { atomicAdd(&bar[XB_TMO], 1u); break; } }
    }
    nloc = mine > 0u ? mine : 1u; nx = cnt > 0u ? cnt : 1u;
}
__device__ __forceinline__ void xcd_barrier(const XcdBarrier& b) {
    asm volatile("s_waitcnt vmcnt(0)" ::: "memory");
    __syncthreads();
    if (threadIdx.x == 0) {
        unsigned* bar = b.bar;
        __builtin_amdgcn_s_waitcnt(0);
        unsigned nloc = b.st[0], nx = b.st[1];
        if (nloc == 0u) { xcd_barrier_complete(bar, b.x, nloc, nx); b.st[0] = nloc; b.st[1] = nx; }
        const unsigned old = xb_add(&bar[XB_XSUB(b.x)], 1u);
        const unsigned gen = old / nloc;
        if (old + 1u == (gen + 1u) * nloc) {
            __builtin_amdgcn_fence(__ATOMIC_RELEASE, "agent");
            asm volatile("s_waitcnt vmcnt(0)" ::: "memory");
            const unsigned og = xb_add(&bar[XB_TOP], 1u);
            const unsigned tg = og / nx;
            if (og + 1u == (tg + 1u) * nx) xb_add(&bar[XB_TOPGEN], 1u);
            else XB_SPIN(xb_ld(&bar[XB_TOPGEN]) == tg, bar);
            __builtin_amdgcn_fence(__ATOMIC_ACQUIRE, "agent");
            xb_add(&bar[XB_XGEN(b.x)], 1u);
            asm volatile("s_waitcnt vmcnt(0)" ::: "memory");
        } else {
            XB_SPIN(xb_ld(&bar[XB_XGEN(b.x)]) == gen, bar);
            __builtin_amdgcn_fence(__ATOMIC_ACQUIRE, "agent");
            asm volatile("s_waitcnt vmcnt(0)" ::: "memory");
        }
    }
    __syncthreads();
}

__device__ __forceinline__ int vcol_qk(int nt) {
    const int d = nt & 127, a = d >> 6, nn = (d >> 5) & 1, b = (d >> 4) & 1, fq = (d >> 2) & 3, e = d & 3;
    return (nt & ~127) + 32 * (2 * a + b) + 8 * fq + 4 * nn + e;
}
template <bool PERMQK, bool BIAS, bool TILED = true>
__device__ __forceinline__ void transpose_item(const float* W, int K, int N, bf16_t* WT, LAS float* scr, int item, int lane, const float* sh = nullptr, float* bias = nullptr, const float* kscale = nullptr) {
    const int nblk = N / 32, kb = item / nblk, nb = item % nblk, k0 = 64 * kb, n0 = 32 * nb;
#pragma unroll 8
    for (int i = 0; i < 32; ++i) { const int kk = 2 * i + (lane >> 5); float w = W[(size_t)(k0 + kk) * N + n0 + (lane & 31)]; if (kscale) w *= kscale[k0 + kk]; scr[kk * 33 + (lane & 31)] = w; }
    asm volatile("s_waitcnt lgkmcnt(0)" ::: "memory");
    if (BIAS) {
        const int n = lane & 31, hh = lane >> 5; float sacc = 0.f;
#pragma unroll 8
        for (int i = 0; i < 32; ++i) sacc += scr[(32 * hh + i) * 33 + n] * sh[k0 + 32 * hh + i];
        sacc += __shfl_xor(sacc, 32);
        if (lane < 32) { int nt = n0 + n; if (PERMQK && nt < K_LO + 512) nt = vcol_qk(nt); atomicAdd(bias + nt, sacc); }
    }
    const int c = lane & 7;
#pragma unroll
    for (int j = 0; j < 4; ++j) { const int n = (lane >> 3) + 8 * j; const LAS float* s = scr + (8 * c) * 33 + n;
        u32x4 o; o.x = pk2(s[0 * 33], s[1 * 33]); o.y = pk2(s[2 * 33], s[3 * 33]); o.z = pk2(s[4 * 33], s[5 * 33]); o.w = pk2(s[6 * 33], s[7 * 33]);
        int nt = n0 + n;
        if (PERMQK && nt < K_LO + 512) nt = vcol_qk(nt);
        if (TILED) *(u32x4*)(WT + (((size_t)(nt >> 8) * (K / 64) + kb) * 256 + (nt & 255)) * 64 + 8 * c) = o;
        else *(u32x4*)(WT + (size_t)nt * K + k0 + 8 * c) = o; }
    asm volatile("s_waitcnt lgkmcnt(0)" ::: "memory");
}

__device__ __forceinline__ void norm_mod_row(const float* xrow, const float* g, const float* sc, const float* sh, bf16_t* orow, int lane) {
    const f32x4* xr = (const f32x4*)xrow + lane;
    f32x4 v[16]; float s = 0.f;
#pragma unroll
    for (int j = 0; j < 16; ++j) { v[j] = xr[64 * j]; s += (v[j].x * v[j].x + v[j].y * v[j].y) + (v[j].z * v[j].z + v[j].w * v[j].w); }
    const float rstd = 1.0f / sqrtf(wave_sum(s) * (1.0f / DM) + EPS);
    u32x2* o8 = (u32x2*)orow + lane;
#pragma unroll
    for (int j = 0; j < 16; ++j) { const f32x4 gg = ((const f32x4*)g)[lane + 64 * j], ss = ((const f32x4*)sc)[lane + 64 * j], hh = ((const f32x4*)sh)[lane + 64 * j];
        const f32x4 y = (v[j] * rstd) * gg * (ss + 1.0f) + hh; o8[64 * j] = pg8::pack4(y); }
}

template <int NKS>
__device__ __forceinline__ void ctx_fold_norm_row(LAS float* red, const float* xrow, float* xout, const float* slab, size_t kstride, const float* gate,
                                                  const float* g, const float* sc, const float* sh, bf16_t* orow, int lane, int wave, float fa = 1.f, float fb = 1.f) {
    f32x4 v[2]; float s = 0.f;
#pragma unroll
    for (int q = 0; q < 2; ++q) { const int idx = lane + 64 * (2 * wave + q);
        f32x4 a = (f32x4){0.f, 0.f, 0.f, 0.f};
#pragma unroll
        for (int ks = 0; ks < NKS; ++ks) a += ((const f32x4*)(slab + (size_t)ks * kstride))[idx] * (ks < NKS / 2 ? fa : fb);
        v[q] = ((const f32x4*)xrow)[idx] + ((const f32x4*)gate)[idx] * a;
        ((f32x4*)xout)[idx] = v[q];
        s += (v[q].x * v[q].x + v[q].y * v[q].y) + (v[q].z * v[q].z + v[q].w * v[q].w); }
    s = wave_sum(s);
    if (lane == 0) red[wave] = s;
    __syncthreads();
    float tot = 0.f;
#pragma unroll
    for (int w = 0; w < 8; ++w) tot += red[w];
    const float rstd = 1.0f / sqrtf(tot * (1.0f / DM) + EPS);
#pragma unroll
    for (int q = 0; q < 2; ++q) { const int idx = lane + 64 * (2 * wave + q);
        const f32x4 gg = ((const f32x4*)g)[idx], ss = ((const f32x4*)sc)[idx], hh = ((const f32x4*)sh)[idx];
        const f32x4 y = (v[q] * rstd) * gg * (ss + 1.0f) + hh; ((u32x2*)orow)[idx] = pg8::pack4(y); }
    __syncthreads();
}
__device__ __forceinline__ void scale_row(const float* xrow, const float* gam, bf16_t* orow, float* ss, int lane) {
    const f32x4* xr = (const f32x4*)xrow + lane; u32x2* o8 = (u32x2*)orow + lane; float s = 0.f;
#pragma unroll
    for (int j = 0; j < 16; ++j) { const f32x4 v = xr[64 * j]; s += (v.x * v.x + v.y * v.y) + (v.z * v.z + v.w * v.w);
        o8[64 * j] = pg8::pack4(v * ((const f32x4*)gam)[lane + 64 * j]); }
    s = wave_sum(s);
    if (lane == 0) *ss = s;
}
__device__ __forceinline__ void norm_final_row(const float* xrow, const float* g, float* orow, int lane) {
    const f32x4* xr = (const f32x4*)xrow + lane;
    f32x4 v[16]; float s = 0.f;
#pragma unroll
    for (int j = 0; j < 16; ++j) { v[j] = xr[64 * j]; s += (v[j].x * v[j].x + v[j].y * v[j].y) + (v[j].z * v[j].z + v[j].w * v[j].w); }
    const float rstd = 1.0f / sqrtf(wave_sum(s) * (1.0f / DM) + EPS);
    f32x4* o = (f32x4*)orow + lane;
#pragma unroll
    for (int j = 0; j < 16; ++j) { const f32x4 gg = ((const f32x4*)g)[lane + 64 * j]; o[64 * j] = (v[j] * rstd) * gg; }
}
__device__ __forceinline__ void mixnorm_row(bf16_t* row, const float* ga, const float* gf, int lane) {
    u32x4* p = (u32x4*)row + lane;
    u32x4 w[8]; float sa = 0.f, sf = 0.f;
#pragma unroll
    for (int i = 0; i < 8; ++i) { w[i] = p[64 * i];
        float s = 0.f;
#pragma unroll
        for (int e = 0; e < 4; ++e) { const float lo = __builtin_bit_cast(float, w[i][e] << 16), hi = __builtin_bit_cast(float, w[i][e] & 0xffff0000u); s += lo * lo + hi * hi; }
        if (i < 4) sa += s; else sf += s; }
    const float ra = 1.0f / sqrtf(wave_sum(sa) * (1.0f / QW) + EPS), rf = 1.0f / sqrtf(wave_sum(sf) * (1.0f / FW) + EPS);
#pragma unroll
    for (int i = 0; i < 8; ++i) { const float rs = i < 4 ? ra : rf; const float* g = (i < 4 ? ga + 512 * i : gf + 512 * (i - 4)) + 8 * lane;
        const f32x4 g0 = *(const f32x4*)g, g1 = *(const f32x4*)(g + 4);
        u32x4 o;
#pragma unroll
        for (int e = 0; e < 4; ++e) { const float lo = __builtin_bit_cast(float, w[i][e] << 16), hi = __builtin_bit_cast(float, w[i][e] & 0xffff0000u);
            const float glo = e < 2 ? g0[2 * e] : g1[2 * e - 4], ghi = e < 2 ? g0[2 * e + 1] : g1[2 * e - 3];
            o[e] = cvt_pk_bf16(lo * rs * glo, hi * rs * ghi); }
        p[64 * i] = o; }
}

struct Args {
    const float* x; const float* c; const float* ctx; const float* c_ctx; const float* ada_a; const float* ada_b; const float* ada_bias; const float* g_mix;
    const float* w_in; const float* sink; const float* w_f; const float* g_attn; const float* g_four; const float* w_out; const float* g_mlp; const float* w1; const float* w2; const float* g_final;
    float* out; unsigned char* ws; int ph_lo, ph_hi;
};
constexpr int NPH_PRO = 3, NPH_LAYER = 11, NPH = NPH_PRO + DEPTH * NPH_LAYER + 1;

__global__ void __launch_bounds__(NWAVES * 64, 2) fwd_kernel(Args args) {
    extern __shared__ __attribute__((aligned(16))) unsigned char lds_raw[];
    LAS unsigned char* lds = (LAS unsigned char*)lds_raw;
    const int G = gridDim.x, bx = blockIdx.x, NGW = G * NWAVES;
#define LANEVARS int tid = threadIdx.x; asm volatile("" : "+v"(tid)); const int lane = tid & 63, wave = __builtin_amdgcn_readfirstlane(tid >> 6), gw = bx * NWAVES + wave; (void)lane; (void)gw;
    unsigned char* ws = args.ws;
    unsigned* ctl = (unsigned*)(ws + WS_CTL);
    float* MOD = (float*)(ws + WS_MOD); float* TPART = (float*)(ws + WS_TPART);
    float* COS = (float*)(ws + WS_ROPE); float* SIN = COS + 256 * 32;
    f32x2* TW = (f32x2*)(ws + WS_TW);
    bf16_t* FM1 = (bf16_t*)(ws + WS_FM1); bf16_t* FM2 = (bf16_t*)(ws + WS_FM2); bf16_t* FC = (bf16_t*)(ws + WS_FC); bf16_t* CS = (bf16_t*)(ws + WS_CS);
    bf16_t* WFRAW = (bf16_t*)(ws + WS_WFRAW); bf16_t* WFT = (bf16_t*)(ws + WS_WFT);
    bf16_t* WIN = (bf16_t*)(ws + WS_WIN); bf16_t* WOUT = (bf16_t*)(ws + WS_WOUT); bf16_t* W1T = (bf16_t*)(ws + WS_W1); bf16_t* W2T = (bf16_t*)(ws + WS_W2);
    float* GAM = (float*)(ws + WS_GAM); float* BIASIN = (float*)(ws + WS_BIASIN); float* BIAS1 = (float*)(ws + WS_BIAS1); float* SSQ = (float*)(ws + WS_SS); float* SSAF = (float*)(ws + WS_SSAF);
    float* XW = (float*)(ws + WS_XW); bf16_t* HX = (bf16_t*)(ws + WS_HX); bf16_t* PX = (bf16_t*)(ws + WS_PX); bf16_t* MIX = (bf16_t*)(ws + WS_MIX);
    bf16_t* ZT2 = (bf16_t*)(ws + WS_ZT2); bf16_t* Y2 = (bf16_t*)(ws + WS_Y2); bf16_t* ZTC = (bf16_t*)(ws + WS_ZTC); bf16_t* HB = (bf16_t*)(ws + WS_H);

    for (int u = threadIdx.x; u < (LDS_BYTES - LDSCTL_OFF) / 4; u += NWAVES * 64) ((LAS unsigned*)(lds + LDSCTL_OFF))[u] = 0u;
    __syncthreads();
#if MK_PER_PHASE
#define GRID_BAR() do { } while (0)
#else
    XcdBarrier bar = xcd_barrier_post(ctl + CW_BAR, (volatile LAS unsigned*)(lds + MISC_OFF) + 8);
#define GRID_BAR() xcd_barrier(bar)
#endif
    const int lo = args.ph_lo, hi = args.ph_hi;
#ifndef SITEMASK
#define SITEMASK 0xFFFF
#endif
#define EN(s) (((SITEMASK) >> (s)) & 1)
#ifndef REPMASK
#define REPMASK 0
#endif
#ifndef REPLMIN
#define REPLMIN 0
#endif
#ifndef REPCOUNT
#define REPCOUNT 2
#endif
#define NREP0(s) ((((REPMASK) >> (s)) & 1) ? REPCOUNT : 1)
#ifndef REPLMAX
#define REPLMAX 99
#endif
#define NREP(s) (((((REPMASK) >> (s)) & 1) && l >= REPLMIN && l <= REPLMAX) ? REPCOUNT : 1)
#define IN(k) (lo <= (k) && (k) < hi)
#define SEAM(k) do { if (IN(k) && IN((k) + 1)) GRID_BAR(); } while (0)

    for (int rep = 0; rep < NREP0(0); ++rep) if (EN(0) && IN(0)) {
        LANEVARS
        for (int it = bx; it < DEPTH * 16 * 4; it += G) {
            const int l = it >> 6, rc = (it >> 2) & 15, dp = it & 3, rr = tid & 31, dg = tid >> 5;
            float s0 = 0.f, s1 = 0.f;
            const float* ap = args.ada_a + (size_t)l * DM * ARANK + rc * 32 + rr;
            for (int i = 0; i < 64; ++i) { const int d = dp * 1024 + dg + 16 * i; const float av = ap[(size_t)d * ARANK];
                const float c0 = args.c[d], c1 = args.c_ctx[d];
                s0 += (c0 / (1.0f + __expf(-c0))) * av; s1 += (c1 / (1.0f + __expf(-c1))) * av; }
            LAS float* red = (LAS float*)lds;
            red[(dg * 32 + rr) * 2 + 0] = s0; red[(dg * 32 + rr) * 2 + 1] = s1;
            __syncthreads();
            if (tid < 64) { const int r2 = tid & 31, v = tid >> 5; float s = 0.f;
                for (int q = 0; q < 16; ++q) s += red[(q * 32 + r2) * 2 + v];
                TPART[((l * 4 + dp) * 2 + v) * ARANK + rc * 32 + r2] = s; }
            __syncthreads();
        }
        const int gt = bx * (NWAVES * 64) + tid, NT = G * NWAVES * 64;
        for (int i = gt; i < DEPTH * 2 * SEQ; i += NT) SSQ[i] = 0.f;
        for (int i = gt; i < DEPTH * 2 * MT; i += NT) SSAF[i] = 0.f;
        for (int i = gt; i < DEPTH * INW; i += NT) BIASIN[i] = 0.f;
        for (int i = gt; i < DEPTH * DFF; i += NT) BIAS1[i] = 0.f;
        for (int i = gt; i < 256 * 32; i += NT) { const int pos = i >> 5, j = i & 31;
            const float inv = __builtin_amdgcn_exp2f(-(float)j * (13.287712379549449f / 32.0f));
            const float rev = (float)pos * inv * 0.15915494309189535f;
            COS[i] = cos_rev(rev); SIN[i] = sin_rev(rev); }
        for (int i = gt; i < 16384; i += NT) { const float rev = (float)i * (1.0f / 16384.0f); TW[i] = (f32x2){cos_rev(rev), sin_rev(rev)}; }
        for (int i = gt; i < 256 * 256; i += NT) { const int m = i >> 8, k = i & 255, ro = m >> 7, kk = m & 127, ri = k >> 7, ll = k & 127;
            const float rev = (float)((kk * ll) & 127) * (1.0f / 128.0f); const float cv = cos_rev(rev) * 0.08838834764831845f, sv = sin_rev(rev) * 0.08838834764831845f;
            FM1[i] = (bf16_t)f2bf(ro == 0 ? (ri == 0 ? cv : sv) : (ri == 0 ? -sv : cv));
            FM2[i] = (bf16_t)f2bf(ro == 0 ? (ri == 0 ? cv : sv) : 0.f); }
        for (int i = gt; i < 256 * 512; i += NT) { const int k = i >> 9, q = i & 511, ri = q >> 8, ll = q & 255;
            const float rev = (float)((k * ll) & 255) * (1.0f / 256.0f);
            FC[i] = (bf16_t)f2bf((ri == 0 ? cos_rev(rev) : sin_rev(rev)) * 0.0625f); }
        for (int i = gt; i < 1024 * 512; i += NT) { const int n = i >> 9, m = i & 511, ri = n >> 9, cch = n & 511;
            const float rev = (float)((cch * m) & 511) * (1.0f / 512.0f);
            CS[i] = (bf16_t)f2bf((ri == 0 ? cos_rev(rev) : -sin_rev(rev)) * 0.04419417382415922f); }
    }
    SEAM(0);
    if (EN(1) && IN(1)) {
        LANEVARS
        for (int it = bx; it < DEPTH * 96; it += G) {
            const int l = it / 96, jc = it - l * 96;
            LAS float* tl = (LAS float*)lds;
            LAS float* red = tl + 1024;
            for (int q = tid; q < 1024; q += NWAVES * 64) { const int v = q >> 9, r = q & 511; float s = 0.f;
                for (int dp = 0; dp < 4; ++dp) s += TPART[((l * 4 + dp) * 2 + v) * ARANK + r];
                tl[q] = s; }
            __syncthreads();
            const int th = tid >> 8, jj = tid & 255, j = jc * 256 + jj;
            const float* bp = args.ada_b + (size_t)l * ARANK * (NMOD * DM) + j;
            float s0 = 0.f, s1 = 0.f;
#pragma unroll 8
            for (int r = th * 256; r < th * 256 + 256; ++r) { const float bv = bp[(size_t)r * (NMOD * DM)]; s0 += tl[r] * bv; s1 += tl[512 + r] * bv; }
            red[(th * 256 + jj) * 2 + 0] = s0; red[(th * 256 + jj) * 2 + 1] = s1;
            __syncthreads();
            if (tid < 256) { const float bias = args.ada_bias[(size_t)l * (NMOD * DM) + j];
                const float m0 = bias + red[(0 * 256 + jj) * 2 + 0] + red[(1 * 256 + jj) * 2 + 0];
                MOD[(size_t)(l * 2 + 0) * (NMOD * DM) + j] = m0;
                if (j >= 1 * DM && j < 2 * DM) GAM[(size_t)(l * 2 + 0) * DM + (j - 1 * DM)] = args.g_mix[(size_t)l * DM + (j - 1 * DM)] * (1.0f + m0);
                if (j >= 4 * DM && j < 5 * DM) GAM[(size_t)(l * 2 + 1) * DM + (j - 4 * DM)] = args.g_mlp[(size_t)l * DM + (j - 4 * DM)] * (1.0f + m0);
                MOD[(size_t)(l * 2 + 1) * (NMOD * DM) + j] = bias + red[(0 * 256 + jj) * 2 + 1] + red[(1 * 256 + jj) * 2 + 1]; }
            __syncthreads();
        }
    }
    SEAM(1);
    for (int rep = 0; rep < NREP0(15); ++rep) if (EN(15) && IN(2)) {
        LANEVARS
        LAS float* scr = (LAS float*)(lds + wave * 16384);
        constexpr int I_IN = (DM / 64) * (INW / 32), I_OUT = (DM / 64) * (DM / 32), I_1 = (DM / 64) * (DFF / 32), I_2 = (DFF / 64) * (DM / 32), I_F = (512 / 64) * (512 / 32);
        constexpr int PER_L = I_IN + I_OUT + I_1 + I_2 + 4 * I_F, NITEMS = DEPTH * PER_L;
        for (int it = gw; it < NITEMS; it += NGW) {
            const int l = it / PER_L; int r = it - l * PER_L;
            const float* modl = MOD + (size_t)(l * 2 + 0) * (NMOD * DM);
            if (r < I_IN) { transpose_item<true, true>(args.w_in + (size_t)l * DM * INW, DM, INW, WIN + (size_t)l * INW * DM, scr, r, lane, modl + 0 * DM, BIASIN + (size_t)l * INW); continue; } r -= I_IN;
            if (r < I_OUT) { const int kb_ = r / (DM / 32);
                const float* ks = kb_ < QW / 64 ? args.g_attn + (size_t)l * QW : args.g_four + (size_t)l * FW - QW;
                transpose_item<false, false>(args.w_out + (size_t)l * DM * DM, DM, DM, WOUT + (size_t)l * DM * DM, scr, r, lane, nullptr, nullptr, ks); continue; } r -= I_OUT;
            if (r < I_1) { transpose_item<false, true>(args.w1 + (size_t)l * DM * DFF, DM, DFF, W1T + (size_t)l * DFF * DM, scr, r, lane, modl + 3 * DM, BIAS1 + (size_t)l * DFF); continue; } r -= I_1;
            if (r < I_2) { transpose_item<false, false>(args.w2 + (size_t)l * DFF * DM, DFF, DM, W2T + (size_t)l * DM * DFF, scr, r, lane); continue; } r -= I_2;
            const int gq = r / I_F; r -= gq * I_F;
            transpose_item<false, false, false>(args.w_f + (size_t)(l * 4 + gq) * 512 * 512, 512, 512, WFRAW + (size_t)(l * 4 + gq) * 512 * 512, scr, r, lane);
        }
    }
    SEAM(2);

    float* SLAB = (float*)(ws + WS_SLAB); float* XB = (float*)(ws + WS_XB);
    float* XWC = XW + (size_t)SEQ * DM;
    for (int l = 0; l < DEPTH; ++l) {
        const int pb = NPH_PRO + l * NPH_LAYER;
        const bool cact = (l != DEPTH - 1);
        const float* modl = MOD + (size_t)(l * 2 + 0) * (NMOD * DM);
        const float* modc = MOD + (size_t)(l * 2 + 1) * (NMOD * DM);
        const float* xlat = l == 0 ? args.x : XW;
        for (int rep = 0; rep < NREP(2); ++rep) if (EN(2) && IN(pb + 0)) {
            LANEVARS
            const float* g = args.g_mix + (size_t)l * DM;
            if (l == 0) {
                for (int m = gw; m < SEQ; m += NGW) scale_row(args.x + (size_t)m * DM, GAM, HX + (size_t)m * DM, SSQ + m, lane);
                for (int r = gw; r < CTX; r += NGW) norm_mod_row(args.ctx + (size_t)r * DM, g, modc + 1 * DM, modc + 0 * DM, HX + (size_t)(SEQ + r) * DM, lane);
                __syncthreads();
                { pg8::Gemm gg{512, 1024u, 1024u, (size_t)128 * 1024, (size_t)128 * 1024};
                  pg8::SchedWf S{G, bx, (const char*)WFRAW, (const char*)CS}; pg8::EpiWf E{WFT};
                  pg8::gemm_phase<pg8::EpiWf, pg8::SchedWf>(lds, gg, S, E); }
            } else { for (int r = bx; r < CTX; r += G)
                       ctx_fold_norm_row<16>((LAS float*)lds, XWC + (size_t)r * DM, XWC + (size_t)r * DM, SLAB + (size_t)r * DM, (size_t)256 * DM, modc - 2 * (NMOD * DM) + 5 * DM,
                                             g, modc + 1 * DM, modc + 0 * DM, HX + (size_t)(SEQ + r) * DM, lane, wave); }
        }
        SEAM(pb + 0);
        for (int rep = 0; rep < NREP(3); ++rep) if (EN(3) && IN(pb + 1)) {
            { pg8::Gemm g{DM, (unsigned)(DM * 2), 128u, (size_t)128 * DM * 2, (size_t)128 * 128, 128, (size_t)256 * 64 * 2};
              pg8::SchedStd S; S.init(SEQ / 256, INW / 256, G, bx, HX, (size_t)256 * DM * 2, WIN + (size_t)l * INW * DM, (size_t)256 * DM * 2);
              pg8::EpiInproj E{PX, COS, SIN, SSQ + (size_t)(l * 2 + 0) * SEQ, BIASIN + (size_t)l * INW};
              pg8::gemm_phase<pg8::EpiInproj, pg8::SchedStd>(lds, g, S, E); }
            { const int nks = cact ? 8 : 16, kp = DM / nks, ntile = cact ? 20 : 4, pn0 = cact ? 0 : 8;
              pg8::Gemm g{kp, (unsigned)(DM * 2), 128u, (size_t)128 * DM * 2, (size_t)128 * 128, 128, (size_t)256 * 64 * 2};
              pg8::SchedPiece S{G, bx, ntile * nks, nks, pn0, (const char*)(HX + (size_t)SEQ * DM), (const char*)(WIN + (size_t)l * INW * DM), (size_t)256 * DM * 2, (size_t)(kp / 64) * 32768, (size_t)kp * 2};
              pg8::EpiSlab E{SLAB, INW};
              pg8::gemm_phase<pg8::EpiSlab, pg8::SchedPiece>(lds, g, S, E); }
        }
        SEAM(pb + 1);
        for (int rep = 0; rep < NREP(4); ++rep) if (EN(4) && IN(pb + 2)) {
            LANEVARS
            const int nks = cact ? 8 : 16, c4lo = cact ? 0 : K_LO / 4, c4n = cact ? INW / 4 : 1024 / 4;
            for (int i = bx * (NWAVES * 64) + tid; i < 256 * c4n; i += G * NWAVES * 64) {
                const int r = i / c4n, cv = (c4lo + i % c4n) * 4;
                f32x4 a = (f32x4){0.f, 0.f, 0.f, 0.f};
                for (int ks = 0; ks < nks; ++ks) a += *(const f32x4*)(SLAB + ((size_t)ks * 256 + r) * INW + cv);
                int ct = cv;
                if (cv < K_LO + 512) { const int v = cv & 127, wc = v >> 5, fq = (v >> 3) & 3, n = (v >> 2) & 1; ct = (cv & ~127) + 64 * (wc >> 1) + 32 * n + 16 * (wc & 1) + 4 * fq; }
                *(u32x2*)(PX + (size_t)(SEQ + r) * INW + ct) = pg8::pack4(a);
            }
        }
        SEAM(pb + 2);
        for (int rep = 0; rep < NREP(5); ++rep) if (EN(5) && IN(pb + 3)) {
            const float* sk = args.sink + l * NHEAD;
            const int nitems = cact ? 1040 : 1024;
            for (int it = bx; it < nitems; it += G) {
                int qrow0, ntile, w0; const int kvh = (it >> 1) & 3, hp = it & 1;
                if (it < 1024) { const int n = it >> 3; w0 = n == 0 ? 0 : 128 * (n - 1); const int w1 = n == 127 ? SEQ : 128 * (n + 2); qrow0 = 128 * n; ntile = 4 + (w1 - w0) / 64; }
                else { qrow0 = SEQ + 128 * ((it - 1024) >> 3); ntile = 4; w0 = 0; }
                att::attn_item((LAS char*)lds, PX, MIX, SSAF + (size_t)(l * 2 + 0) * MT, sk, qrow0, kvh, hp, ntile, w0);
            }
            { pg8::Gemm g{512, 2048u, (unsigned)(128 * INW * 2), (size_t)128 * 2048, (size_t)INW * 2};
              pg8::SchedGa S{G, bx, (const char*)(WFT + (size_t)l * 4 * 512 * 1024), (const char*)(PX + F_LO)}; pg8::EpiGa E{ZT2};
              pg8::gemm_phase<pg8::EpiGa, pg8::SchedGa>(lds, g, S, E); }
            if (cact) {
              pg8::Gemm g{512, 2048u, (unsigned)(INW * 2), (size_t)128 * 2048, (size_t)128 * INW * 2};
              pg8::SchedGaCtx S{G, bx, (const char*)(WFT + (size_t)l * 4 * 512 * 1024), (const char*)(PX + F_LO)}; pg8::EpiGaCtx E{ZTC};
              pg8::gemm_phase<pg8::EpiGaCtx, pg8::SchedGaCtx>(lds, g, S, E); }
        }
        SEAM(pb + 3);
        for (int rep = 0; rep < NREP(6); ++rep) if (EN(6) && IN(pb + 4)) {
            { pg8::Gemm g{256, 512u, 512u, (size_t)128 * 512, (size_t)128 * 512};
              pg8::SchedN S{G, bx, 1024, (const char*)FM1, (const char*)ZT2, (size_t)256 * 512}; pg8::EpiGb E{Y2, TW};
              pg8::gemm_phase<pg8::EpiGb, pg8::SchedN>(lds, g, S, E); }
            if (cact) {
              pg8::Gemm g{512, 1024u, 1024u, (size_t)128 * 1024, (size_t)128 * 1024};
              pg8::SchedN S{G, bx, 8, (const char*)FC, (const char*)ZTC, (size_t)256 * 1024}; pg8::EpiGctx E{MIX, SSAF + (size_t)(l * 2 + 1) * MT};
              pg8::gemm_phase<pg8::EpiGctx, pg8::SchedN>(lds, g, S, E); }
        }
        SEAM(pb + 4);
        for (int rep = 0; rep < NREP(7); ++rep) if (EN(7) && IN(pb + 5)) {
            pg8::Gemm g{256, 512u, 512u, (size_t)128 * 512, (size_t)128 * 512};
            pg8::SchedN S{G, bx, 1024, (const char*)FM2, (const char*)Y2, (size_t)256 * 512}; pg8::EpiGc E{MIX, SSAF + (size_t)(l * 2 + 1) * MT};
            pg8::gemm_phase<pg8::EpiGc, pg8::SchedN>(lds, g, S, E);
        }
        SEAM(pb + 5);
        for (int rep = 0; rep < NREP(9); ++rep) if (EN(9) && IN(pb + 6)) {
            { pg8::Gemm g{DM, (unsigned)(DM * 2), 128u, (size_t)128 * DM * 2, (size_t)128 * 128, 128, (size_t)256 * 64 * 2};
              pg8::SchedStd S; S.init(SEQ / 256, DM / 256, G, bx, MIX, (size_t)256 * DM * 2, WOUT + (size_t)l * DM * DM, (size_t)256 * DM * 2);
              pg8::EpiResid<true> E{xlat, XB, modl + 2 * DM, GAM + (size_t)(l * 2 + 1) * DM, HX, SSQ + (size_t)(l * 2 + 1) * SEQ, SSAF + (size_t)(l * 2 + 0) * MT, SSAF + (size_t)(l * 2 + 1) * MT};
              pg8::gemm_phase<pg8::EpiResid<true>, pg8::SchedStd>(lds, g, S, E); }
            if (cact) {
              pg8::Gemm g{512, (unsigned)(DM * 2), 128u, (size_t)128 * DM * 2, (size_t)128 * 128, 128, (size_t)256 * 64 * 2};
              pg8::SchedPiece S{G, bx, 16 * 8, 8, 0, (const char*)(MIX + (size_t)SEQ * DM), (const char*)(WOUT + (size_t)l * DM * DM), (size_t)256 * DM * 2, (size_t)8 * 32768, (size_t)512 * 2};
              pg8::EpiSlab E{SLAB, DM};
              pg8::gemm_phase<pg8::EpiSlab, pg8::SchedPiece>(lds, g, S, E); }
        }
        SEAM(pb + 6);
        for (int rep = 0; rep < NREP(10); ++rep) if (EN(10) && IN(pb + 7)) {
            LANEVARS
            const float* g = args.g_mlp + (size_t)l * DM;
            if (cact) { for (int r = bx; r < CTX; r += G) {
                            const float ra = 1.0f / sqrtf(SSAF[(size_t)(l * 2 + 0) * MT + SEQ + r] * (1.0f / QW) + EPS), rf = 1.0f / sqrtf(SSAF[(size_t)(l * 2 + 1) * MT + SEQ + r] * (1.0f / FW) + EPS);
                            ctx_fold_norm_row<8>((LAS float*)lds, (l == 0 ? args.ctx : XWC) + (size_t)r * DM, XWC + (size_t)r * DM, SLAB + (size_t)r * DM, (size_t)256 * DM, modc + 2 * DM,
                                                 g, modc + 4 * DM, modc + 3 * DM, HX + (size_t)(SEQ + r) * DM, lane, wave, ra, rf); } }
        }
        SEAM(pb + 7);
        for (int rep = 0; rep < NREP(11); ++rep) if (EN(11) && IN(pb + 8)) {
            { pg8::Gemm g{DM, (unsigned)(DM * 2), 128u, (size_t)128 * DM * 2, (size_t)128 * 128, 128, (size_t)256 * 64 * 2};
              pg8::SchedStd S; S.init(SEQ / 256, DFF / 256, G, bx, HX, (size_t)256 * DM * 2, W1T + (size_t)l * DFF * DM, (size_t)256 * DM * 2);
              pg8::EpiRelu2 E{HB, SSQ + (size_t)(l * 2 + 1) * SEQ, BIAS1 + (size_t)l * DFF};
              pg8::gemm_phase<pg8::EpiRelu2, pg8::SchedStd>(lds, g, S, E); }
            if (cact) {
              pg8::Gemm g{1024, (unsigned)(DM * 2), 128u, (size_t)128 * DM * 2, (size_t)128 * 128, 128, (size_t)256 * 64 * 2};
              pg8::SchedPiece S{G, bx, 64 * 4, 4, 0, (const char*)(HX + (size_t)SEQ * DM), (const char*)(W1T + (size_t)l * DFF * DM), (size_t)256 * DM * 2, (size_t)16 * 32768, (size_t)1024 * 2};
              pg8::EpiSlab E{SLAB, DFF};
              pg8::gemm_phase<pg8::EpiSlab, pg8::SchedPiece>(lds, g, S, E); }
        }
        SEAM(pb + 8);
        if (EN(12) && IN(pb + 9) && cact) {
            LANEVARS
            for (int i = bx * (NWAVES * 64) + tid; i < 256 * (DFF / 4); i += G * NWAVES * 64) {
                const int r = i / (DFF / 4), c4 = (i % (DFF / 4)) * 4;
                f32x4 a = (f32x4){0.f, 0.f, 0.f, 0.f};
#pragma unroll
                for (int ks = 0; ks < 4; ++ks) a += *(const f32x4*)(SLAB + ((size_t)ks * 256 + r) * DFF + c4);
#pragma unroll
                for (int e = 0; e < 4; ++e) { const float t = fmaxf(a[e], 0.f); a[e] = t * t; }
                *(u32x2*)(HB + ((size_t)(64 * 256 + (c4 >> 6)) * 256 + r) * 64 + (c4 & 63)) = pg8::pack4(a);
            }
        }
        SEAM(pb + 9);
        for (int rep = 0; rep < NREP(13); ++rep) if (EN(13) && IN(pb + 10)) {
            { pg8::Gemm g{DFF, 128u, 128u, (size_t)128 * 128, (size_t)128 * 128, (size_t)256 * 64 * 2, (size_t)256 * 64 * 2};
              pg8::SchedStd S; S.init(SEQ / 256, DM / 256, G, bx, HB, (size_t)256 * DFF * 2, W2T + (size_t)l * DM * DFF, (size_t)256 * DFF * 2);
              pg8::EpiResid<false> E{XB, XW, modl + 5 * DM, l < DEPTH - 1 ? GAM + (size_t)((l + 1) * 2 + 0) * DM : nullptr, HX, SSQ + (size_t)((l + 1 < DEPTH ? l + 1 : l) * 2 + 0) * SEQ, nullptr, nullptr};
              pg8::gemm_phase<pg8::EpiResid<false>, pg8::SchedStd>(lds, g, S, E); }
            if (cact) {
              pg8::Gemm g{1024, 128u, 128u, (size_t)128 * 128, (size_t)128 * 128, (size_t)256 * 64 * 2, (size_t)256 * 64 * 2};
              pg8::SchedPiece S{G, bx, 16 * 16, 16, 0, (const char*)(HB + (size_t)SEQ * DFF), (const char*)(W2T + (size_t)l * DM * DFF), (size_t)256 * DFF * 2, (size_t)16 * 32768, (size_t)16 * 32768};
              pg8::EpiSlab E{SLAB, DM};
              pg8::gemm_phase<pg8::EpiSlab, pg8::SchedPiece>(lds, g, S, E); }
        }
        SEAM(pb + 10);
    }
    if (EN(14) && IN(NPH - 1)) {
        LANEVARS
        for (int m = gw; m < SEQ; m += NGW) norm_final_row(XW + (size_t)m * DM, args.g_final, args.out + (size_t)m * DM, lane);
    }
#undef IN
#undef SEAM
#undef GRID_BAR
}

extern "C" void kernel_launch(void* const* d_in, const int* in_sizes, int n_in, void* d_out, int out_size, void* d_ws, size_t ws_size, hipStream_t stream) {
    static int grid = 0;
    if (grid == 0) {
        if (n_in != 18 || out_size != SEQ * DM || ws_size < WS_END) { fprintf(stderr, "kernel_launch: unexpected shapes: n_in %d out %d ws %zu (need %zu)\n", n_in, out_size, ws_size, (size_t)WS_END); grid = -1; return; }
        int dev = 0, cus = 0, per_cu = 0;
        if (hipGetDevice(&dev) != hipSuccess || hipDeviceGetAttribute(&cus, hipDeviceAttributeMultiprocessorCount, dev) != hipSuccess) { grid = -1; return; }
        if (hipFuncSetAttribute((const void*)fwd_kernel, hipFuncAttributeMaxDynamicSharedMemorySize, LDS_BYTES) != hipSuccess) { fprintf(stderr, "kernel_launch: hipFuncSetAttribute failed\n"); grid = -1; return; }
        if (hipOccupancyMaxActiveBlocksPerMultiprocessor(&per_cu, (const void*)fwd_kernel, NWAVES * 64, LDS_BYTES) != hipSuccess || per_cu < 1) { fprintf(stderr, "kernel_launch: occupancy query says %d\n", per_cu); }
        (void)hipGetLastError();
        grid = cus;
    }
    if (grid < 0) return;
    (void)hipMemsetAsync((char*)d_ws + WS_CTL, 0, CTL_ZERO_BYTES, stream);
    Args a{};
    a.x = (const float*)d_in[0]; a.c = (const float*)d_in[1]; a.ctx = (const float*)d_in[2]; a.c_ctx = (const float*)d_in[3];
    a.ada_a = (const float*)d_in[4]; a.ada_b = (const float*)d_in[5]; a.ada_bias = (const float*)d_in[6]; a.g_mix = (const float*)d_in[7];
    a.w_in = (const float*)d_in[8]; a.sink = (const float*)d_in[9]; a.w_f = (const float*)d_in[10]; a.g_attn = (const float*)d_in[11];
    a.g_four = (const float*)d_in[12]; a.w_out = (const float*)d_in[13]; a.g_mlp = (const float*)d_in[14]; a.w1 = (const float*)d_in[15];
    a.w2 = (const float*)d_in[16]; a.g_final = (const float*)d_in[17];
    a.out = (float*)d_out; a.ws = (unsigned char*)d_ws;
#if MK_PER_PHASE
    for (int p = 0; p < NPH; ++p) { a.ph_lo = p; a.ph_hi = p + 1; hipLaunchKernelGGL(fwd_kernel, dim3(grid), dim3(NWAVES * 64), LDS_BYTES, stream, a); }
#else
    a.ph_lo = 0; a.ph_hi = NPH;
    hipLaunchKernelGGL(fwd_kernel, dim3(grid), dim3(NWAVES * 64), LDS_BYTES, stream, a);
#endif
    const hipError_t le = hipPeekAtLastError();
    if (le != hipSuccess) fprintf(stderr, "kernel_launch: launch failed: %s\n", hipGetErrorName(le));
}
```
